# Optimizing an MI355X kernel written in HIP

```python
import math
import jax
import jax.numpy as jnp
from jax import lax
import numpy as np

D_MODEL = 1024
BATCH = 8
SEQ = 2048
DEPTH = 4

GRID_W = 64
CTX_LEN = 256
N_MIXERS = 4
GROUP_W = 256
CHUNK = 64
Q_BLOCK = 128
ROPE_BASE = 10000.0
MLA_HEADS = 4
MLA_NOPE = 64
MLA_ROPE = 32
MLA_V = 64
MLA_Q_LORA = 256
MLA_KV_LORA = 128
GLA_HEADS = 4
GLA_DK = 32
GLA_DV = 64
GLA_GATE_RANK = 16
GLA_GATE_NORM = 16.0
SSD_HEADS = 4
SSD_HEADDIM = 64
SSD_GROUPS = 2
SSD_STATE = 128
SSD_CONV = 3
RET_HEADS = 4
RET_DK = 32
RET_DV = 64
PEER_HEADS = 8
PEER_NKEYS = 128
PEER_EXPERTS = PEER_NKEYS * PEER_NKEYS
PEER_DKEY = 256
PEER_TOPK = 16
PEER_TOKEN_BLOCK = 128
DEEPNORM_ALPHA = (2 * DEPTH) ** 0.25
DEEPNORM_BETA = (8 * DEPTH) ** -0.25

SSD_BC = SSD_GROUPS * SSD_STATE
SSD_XBC = SSD_HEADS * SSD_HEADDIM + 2 * SSD_BC
MLA_SIZES = (MLA_Q_LORA, MLA_KV_LORA, MLA_ROPE)
GLA_SIZES = (GLA_HEADS * GLA_DK, GLA_HEADS * GLA_DK, GLA_HEADS * GLA_DV, GLA_HEADS * GLA_DV, GLA_GATE_RANK, GLA_GATE_RANK)
SSD_SIZES = (SSD_HEADS * SSD_HEADDIM, SSD_XBC, SSD_HEADS, SSD_HEADS)
RET_SIZES = (RET_HEADS * RET_DK, RET_HEADS * RET_DK, RET_HEADS * RET_DV, RET_HEADS * RET_DV)
IN_SIZES = MLA_SIZES + GLA_SIZES + SSD_SIZES + RET_SIZES
D_IN = sum(IN_SIZES)

kernel_name = 'hybrid_mla_gla_ssd_retnet_peer_dit'

F32 = jnp.float32


def layer_norm(x, g, b, eps=1e-5):
    xf = x.astype(F32)
    mu = xf.mean(-1, keepdims=True)
    xc = xf - mu
    var = jnp.mean(xc * xc, -1, keepdims=True)
    return (xc * lax.rsqrt(var + eps) * g + b).astype(x.dtype)


def rms_norm(x, g, eps=1e-6):
    xf = x.astype(F32)
    return (xf * lax.rsqrt(jnp.mean(xf * xf, -1, keepdims=True) + eps) * g).astype(x.dtype)


def head_norm(o, centre):
    of = o.astype(F32)
    if centre:
        of = of - of.mean(-1, keepdims=True)
    return (of * lax.rsqrt(jnp.mean(of * of, -1, keepdims=True) + 1e-6)).astype(o.dtype)


def modulate(x, shift, scale):
    return x * (1 + scale) + shift


def split_cols(p, sizes):
    return jnp.split(p, np.cumsum(sizes)[:-1].tolist(), axis=-1)


def partition(pieces):
    a = len(MLA_SIZES)
    b = a + len(GLA_SIZES)
    s = b + len(SSD_SIZES)
    return pieces[:a], pieces[a:b], pieces[b:s], pieces[s:]


def to_heads(t, h):
    b, l, _ = t.shape
    return t.reshape(b, l, h, -1).transpose(0, 2, 1, 3)


def merge_heads(t):
    b, h, l, d = t.shape
    return t.transpose(0, 2, 1, 3).reshape(b, l, h * d)


def rope_tables(pos, dim):
    half = dim // 2
    freqs = ROPE_BASE ** (-jnp.arange(half, dtype=F32) / half)
    ang = pos.astype(F32)[:, None] * freqs
    return jnp.cos(ang), jnp.sin(ang)


def rotate(x, tab):
    cos, sin = tab
    cos = cos.astype(x.dtype)
    sin = sin.astype(x.dtype)
    h = x.shape[-1] // 2
    x1, x2 = x[..., :h], x[..., h:]
    return jnp.concatenate([x1 * cos - x2 * sin, x1 * sin + x2 * cos], -1)


def axial_rope(x, axial):
    h = x.shape[-1] // 2
    return jnp.concatenate([rotate(x[..., :h], axial[0]), rotate(x[..., h:], axial[1])], -1)


def attention(q, k, v):
    s = jnp.einsum('bhqd,bhkd->bhqk', q, k).astype(F32) * (q.shape[-1] ** -0.5)
    return jnp.einsum('bhqk,bhkv->bhqv', jax.nn.softmax(s, axis=-1).astype(v.dtype), v)


def blocked_attention(q, k, v):
    b, h, l, d = q.shape
    nb = l // Q_BLOCK
    qb = q.reshape(b, h, nb, Q_BLOCK, d).transpose(2, 0, 1, 3, 4)
    ob = lax.map(lambda qq: attention(qq, k, v), qb)
    return ob.transpose(1, 2, 0, 3, 4).reshape(b, h, l, -1)


def chunk_scan(q, k, v, lg, s0):
    b, h, l, _ = k.shape
    n = l // CHUNK
    dt = v.dtype
    mask = jnp.tril(jnp.ones((CHUNK, CHUNK), bool))[:, :, None]

    def chunks(t):
        return t.reshape(b, h, n, CHUNK, t.shape[-1]).transpose(2, 0, 1, 3, 4)

    def step(s, inp):
        qc, kc, vc, gc = inp
        cum = jnp.cumsum(gc.astype(F32), axis=2)
        last = cum[:, :, -1:]
        inter = jnp.einsum('bhik,bhkv->bhiv', qc * jnp.exp(cum).astype(dt), s)
        decay = jnp.exp(jnp.where(mask, cum[:, :, :, None] - cum[:, :, None], -jnp.inf)).astype(dt)
        if gc.shape[-1] == 1:
            att = jnp.einsum('bhik,bhjk->bhij', qc, kc) * decay[..., 0]
        else:
            att = jnp.einsum('bhik,bhjk,bhijk->bhij', qc, kc, decay)
        o = inter + jnp.einsum('bhij,bhjv->bhiv', att, vc)
        s = jnp.exp(last[:, :, 0])[..., None].astype(dt) * s + jnp.einsum('bhjk,bhjv->bhkv', kc * jnp.exp(last - cum).astype(dt), vc)
        return s, o

    s_fin, o = lax.scan(step, s0, (chunks(q), chunks(k), chunks(v), chunks(lg)))
    return o.transpose(1, 2, 0, 3, 4).reshape(b, h, l, -1), s_fin


def final_state(k, v, lg):
    cum = jnp.cumsum(lg.astype(F32), axis=2)
    return jnp.einsum('bhjk,bhjv->bhkv', k * jnp.exp(cum[:, :, -1:] - cum).astype(v.dtype), v)


def bidir_scan(lat_dirs, ctx_dirs, need_ctx):
    out_lat, out_ctx = [], []
    for d, (lat, ctxd) in enumerate(zip(lat_dirs, ctx_dirs)):
        flip = (lambda t: jnp.flip(t, axis=2)) if d == 1 else (lambda t: t)
        qc, kc, vc, gc = (None if t is None else flip(t) for t in ctxd)
        if need_ctx:
            s0 = jnp.zeros(kc.shape[:2] + (kc.shape[-1], vc.shape[-1]), vc.dtype)
            oc, state = chunk_scan(qc, kc, vc, gc, s0)
            out_ctx.append(flip(oc))
        else:
            state = final_state(kc, vc, gc)
        ql, kl, vl, gl = (flip(t) for t in lat)
        ol, _ = chunk_scan(ql, kl, vl, gl, state)
        out_lat.append(flip(ol))
    return out_lat[0] + out_lat[1], (out_ctx[0] + out_ctx[1] if need_ctx else None)


def mla_q(c_q, g_q, w_uq, axial):
    q = to_heads(rms_norm(c_q, g_q) @ w_uq, MLA_HEADS)
    if axial is None:
        return q
    return jnp.concatenate([q[..., :MLA_NOPE], axial_rope(q[..., MLA_NOPE:], axial)], -1)


def mla_kv(c_kv, k_rope, g_kv, w_uk, w_uv, axial):
    kv = rms_norm(c_kv, g_kv)
    k_nope = to_heads(kv @ w_uk, MLA_HEADS)
    v = to_heads(kv @ w_uv, MLA_HEADS)
    if axial is not None:
        k_rope = axial_rope(k_rope, axial)
    k_rope = jnp.broadcast_to(k_rope[:, None], k_nope.shape[:3] + (MLA_ROPE,))
    return jnp.concatenate([k_nope, k_rope], -1), v


def mla_mixer(pl, pc, g_q, w_uq, g_kv, w_uk, w_uv, axial, need_ctx):
    cq_l, ckv_l, kr_l = pl
    cq_c, ckv_c, kr_c = pc
    k_c, v_c = mla_kv(ckv_c, kr_c, g_kv, w_uk, w_uv, None)
    k_l, v_l = mla_kv(ckv_l, kr_l, g_kv, w_uk, w_uv, axial)
    q_l = mla_q(cq_l, g_q, w_uq, axial)
    o_l = blocked_attention(q_l, jnp.concatenate([k_c, k_l], 2), jnp.concatenate([v_c, v_l], 2))
    o_c = merge_heads(attention(mla_q(cq_c, g_q, w_uq, None), k_c, v_c)) if need_ctx else None
    return merge_heads(o_l), o_c


def gla_prep(p, w_gf, b_gf, w_gb, b_gb, with_q):
    q, k, v, r, lr_f, lr_b = p
    q = (to_heads(q, GLA_HEADS) * GLA_DK ** -0.5) if with_q else None
    k = to_heads(k, GLA_HEADS)
    v = to_heads(v, GLA_HEADS)

    def log_gate(lr, w, b):
        return to_heads(jax.nn.log_sigmoid((lr @ w + b).astype(F32)) / GLA_GATE_NORM, GLA_HEADS)

    return (q, k, v, log_gate(lr_f, w_gf, b_gf)), (q, k, v, log_gate(lr_b, w_gb, b_gb)), r


def gla_mixer(pl, pc, w_gf, b_gf, w_gb, b_gb, g_out, need_ctx):
    lat_f, lat_b, r_l = gla_prep(pl, w_gf, b_gf, w_gb, b_gb, True)
    ctx_f, ctx_b, r_c = gla_prep(pc, w_gf, b_gf, w_gb, b_gb, need_ctx)
    o_l, o_c = bidir_scan((lat_f, lat_b), (ctx_f, ctx_b), need_ctx)

    def out(o, r):
        return merge_heads(head_norm(o, False)) * g_out * jax.nn.silu(r)

    return out(o_l, r_l), (out(o_c, r_c) if need_ctx else None)


def depthwise_conv(x, w, b):
    pad = w.shape[0] // 2
    y = lax.conv_general_dilated(x, w[:, None, :], (1,), [(pad, pad)],
                                 dimension_numbers=('NWC', 'WIO', 'NWC'), feature_group_count=x.shape[-1])
    return y + b


def ssd_prep(p, conv_w, conv_b, dtb_f, dtb_b, alog_f, alog_b, with_q):
    z, xbc, dt_f, dt_b = p
    xbc = jax.nn.silu(depthwise_conv(xbc, conv_w, conv_b))
    xs, bm, cm = split_cols(xbc, (SSD_HEADS * SSD_HEADDIM, SSD_BC, SSD_BC))
    rep = SSD_HEADS // SSD_GROUPS
    xh = to_heads(xs, SSD_HEADS)
    bh = jnp.repeat(to_heads(bm, SSD_GROUPS), rep, axis=1)
    ch = jnp.repeat(to_heads(cm, SSD_GROUPS), rep, axis=1) if with_q else None

    def direction(dt_raw, dt_bias, a_log):
        dt = jax.nn.softplus(dt_raw.astype(F32) + dt_bias).transpose(0, 2, 1)[..., None]
        la = dt * -jnp.exp(a_log.astype(F32))[:, None, None]
        return (ch, bh * dt.astype(bh.dtype), xh, la)

    return direction(dt_f, dtb_f, alog_f), direction(dt_b, dtb_b, alog_b), xh, z


def ssd_mixer(pl, pc, conv_w, conv_b, dtb_f, dtb_b, alog_f, alog_b, d_skip, g_out, need_ctx):
    lat_f, lat_b, x_l, z_l = ssd_prep(pl, conv_w, conv_b, dtb_f, dtb_b, alog_f, alog_b, True)
    ctx_f, ctx_b, x_c, z_c = ssd_prep(pc, conv_w, conv_b, dtb_f, dtb_b, alog_f, alog_b, need_ctx)
    o_l, o_c = bidir_scan((lat_f, lat_b), (ctx_f, ctx_b), need_ctx)

    def out(o, xh, z):
        y = merge_heads(o + d_skip[:, None, None] * xh)
        return rms_norm(y * jax.nn.silu(z), g_out)

    return out(o_l, x_l, z_l), (out(o_c, x_c, z_c) if need_ctx else None)


def ret_log_decay():
    return jnp.log1p(-jnp.exp2(-5.0 - jnp.arange(RET_HEADS, dtype=F32)))


def ret_prep(p, rope, with_q):
    q, k, v, g = p
    q = to_heads(q, RET_HEADS) if with_q else None
    k = to_heads(k, RET_HEADS) * RET_DK ** -0.5
    if rope is not None:
        q = rotate(q, rope)
        k = rotate(k, rope)
    v = to_heads(v, RET_HEADS)
    la = jnp.broadcast_to(ret_log_decay()[:, None, None], (k.shape[0], RET_HEADS, k.shape[2], 1))
    d = (q, k, v, la)
    return (d, d), g


def ret_mixer(pl, pc, rope, need_ctx):
    lat, g_l = ret_prep(pl, rope, True)
    ctx_d, g_c = ret_prep(pc, None, need_ctx)
    o_l, o_c = bidir_scan(lat, ctx_d, need_ctx)

    def out(o, g):
        return merge_heads(head_norm(o, True)) * jax.nn.silu(g)

    return out(o_l, g_l), (out(o_c, g_c) if need_ctx else None)


def peer(x, w_q, sub_keys, u_tab, v_tab):
    b, l, d = x.shape
    t = x.reshape(-1, d)
    nb = t.shape[0] // PEER_TOKEN_BLOCK
    half = PEER_DKEY // 2

    def block(xb):
        q = (xb @ w_q).reshape(xb.shape[0], PEER_HEADS, PEER_DKEY)
        s1 = jnp.einsum('thd,kd->thk', q[..., :half], sub_keys[0]).astype(F32)
        s2 = jnp.einsum('thd,kd->thk', q[..., half:], sub_keys[1]).astype(F32)
        v1, i1 = lax.top_k(s1, PEER_TOPK)
        v2, i2 = lax.top_k(s2, PEER_TOPK)
        cand = (v1[..., :, None] + v2[..., None, :]).reshape(xb.shape[0], PEER_HEADS, PEER_TOPK * PEER_TOPK)
        vs, ci = lax.top_k(cand, PEER_TOPK)
        e = (jnp.take_along_axis(i1, ci // PEER_TOPK, -1) * PEER_NKEYS
             + jnp.take_along_axis(i2, ci % PEER_TOPK, -1))
        gate = jax.nn.softmax(vs, axis=-1).astype(xb.dtype)
        u = jnp.take(u_tab, e, axis=0)
        vv = jnp.take(v_tab, e, axis=0)
        act = jax.nn.gelu(jnp.einsum('td,thkd->thk', xb, u), approximate=False) * gate
        return jnp.einsum('thk,thkd->td', act, vv)

    out = lax.map(block, t.reshape(nb, PEER_TOKEN_BLOCK, d))
    return out.reshape(b, l, d)


def setup_inputs(seed: int = 0) -> dict:
    key = jax.random.key(seed)
    ks = iter(jax.random.split(key, 40))

    def nrm(shape, scale):
        return jax.random.normal(next(ks), shape, F32) * scale

    def gain(shape):
        return 1.0 + nrm(shape, 0.02)

    def dt_bias():
        dt = jnp.exp(jax.random.uniform(next(ks), (DEPTH, SSD_HEADS), F32) * (math.log(0.1) - math.log(0.001)) + math.log(0.001))
        return dt + jnp.log(-jnp.expm1(-dt))

    def a_log():
        return jnp.log(jax.random.uniform(next(ks), (DEPTH, SSD_HEADS), F32, 1.0, 16.0))

    L = DEPTH
    D = D_MODEL
    D_MIX = N_MIXERS * GROUP_W
    return {
        'x': nrm((BATCH, SEQ, D), 1.0),
        'c': nrm((BATCH, D), 1.0),
        'ctx': nrm((BATCH, CTX_LEN, D), 1.0),
        'c_ctx': nrm((D,), 1.0),
        'w_ada': nrm((L, D, 6 * D), D ** -0.5),
        'b_ada': nrm((L, 6 * D), 0.02),
        'w_in': nrm((L, D, D_IN), D ** -0.5),
        'mla_g_q': gain((L, MLA_Q_LORA)),
        'mla_w_uq': nrm((L, MLA_Q_LORA, MLA_HEADS * (MLA_NOPE + MLA_ROPE)), MLA_Q_LORA ** -0.5),
        'mla_g_kv': gain((L, MLA_KV_LORA)),
        'mla_w_uk': nrm((L, MLA_KV_LORA, MLA_HEADS * MLA_NOPE), MLA_KV_LORA ** -0.5),
        'mla_w_uv': nrm((L, MLA_KV_LORA, MLA_HEADS * MLA_V), MLA_KV_LORA ** -0.5),
        'gla_w_gf': nrm((L, GLA_GATE_RANK, GLA_HEADS * GLA_DK), GLA_GATE_RANK ** -0.5),
        'gla_b_gf': nrm((L, GLA_HEADS * GLA_DK), 0.02),
        'gla_w_gb': nrm((L, GLA_GATE_RANK, GLA_HEADS * GLA_DK), GLA_GATE_RANK ** -0.5),
        'gla_b_gb': nrm((L, GLA_HEADS * GLA_DK), 0.02),
        'gla_g': gain((L, GLA_HEADS * GLA_DV)),
        'ssd_conv_w': nrm((L, SSD_CONV, SSD_XBC), SSD_CONV ** -0.5),
        'ssd_conv_b': nrm((L, SSD_XBC), 0.02),
        'ssd_dt_bias_f': dt_bias(),
        'ssd_dt_bias_b': dt_bias(),
        'ssd_a_log_f': a_log(),
        'ssd_a_log_b': a_log(),
        'ssd_d': gain((L, SSD_HEADS)),
        'ssd_g': gain((L, SSD_HEADS * SSD_HEADDIM)),
        'w_out': nrm((L, D_MIX, D), DEEPNORM_BETA * D_MIX ** -0.5),
        'ln1_g': gain((L, D)),
        'ln1_b': nrm((L, D), 0.02),
        'peer_w_q': nrm((L, D, PEER_HEADS * PEER_DKEY), D ** -0.5),
        'peer_keys': nrm((L, 2, PEER_NKEYS, PEER_DKEY // 2), (PEER_DKEY // 2) ** -0.5),
        'peer_u': nrm((L, PEER_EXPERTS, D), D ** -0.5),
        'peer_v': nrm((L, PEER_EXPERTS, D), DEEPNORM_BETA * PEER_HEADS ** -0.5),
        'ln2_g': gain((L, D)),
        'ln2_b': nrm((L, D), 0.02),
    }


def reference(x, c, ctx, c_ctx, w_ada, b_ada, w_in, mla_g_q, mla_w_uq, mla_g_kv, mla_w_uk, mla_w_uv,
              gla_w_gf, gla_b_gf, gla_w_gb, gla_b_gb, gla_g, ssd_conv_w, ssd_conv_b, ssd_dt_bias_f,
              ssd_dt_bias_b, ssd_a_log_f, ssd_a_log_b, ssd_d, ssd_g, w_out, ln1_g, ln1_b, peer_w_q,
              peer_keys, peer_u, peer_v, ln2_g, ln2_b):
    seq = x.shape[1]
    rows = seq // GRID_W
    row = jnp.repeat(jnp.arange(rows), GRID_W)
    col = jnp.tile(jnp.arange(GRID_W), rows)
    axial = (rope_tables(row, MLA_ROPE // 2), rope_tables(col, MLA_ROPE // 2))
    ret_rope = rope_tables(jnp.arange(seq), RET_DK)
    s_lat = jax.nn.silu(c)
    s_ctx = jax.nn.silu(c_ctx)
    xc = ctx
    for i in range(DEPTH):
        need_ctx = i < DEPTH - 1
        mod = [t[:, None, :] for t in jnp.split(s_lat @ w_ada[i] + b_ada[i], 6, axis=-1)]
        mod_c = jnp.split(s_ctx @ w_ada[i] + b_ada[i], 6, axis=-1)
        p_mla, p_gla, p_ssd, p_ret = partition(split_cols(modulate(x, mod[0], mod[1]) @ w_in[i], IN_SIZES))
        c_mla, c_gla, c_ssd, c_ret = partition(split_cols(modulate(xc, mod_c[0], mod_c[1]) @ w_in[i], IN_SIZES))
        outs = (
            mla_mixer(p_mla, c_mla, mla_g_q[i], mla_w_uq[i], mla_g_kv[i], mla_w_uk[i], mla_w_uv[i], axial, need_ctx),
            gla_mixer(p_gla, c_gla, gla_w_gf[i], gla_b_gf[i], gla_w_gb[i], gla_b_gb[i], gla_g[i], need_ctx),
            ssd_mixer(p_ssd, c_ssd, ssd_conv_w[i], ssd_conv_b[i], ssd_dt_bias_f[i], ssd_dt_bias_b[i],
                      ssd_a_log_f[i], ssd_a_log_b[i], ssd_d[i], ssd_g[i], need_ctx),
            ret_mixer(p_ret, c_ret, ret_rope, need_ctx),
        )
        y = jnp.concatenate([o[0] for o in outs], -1) @ w_out[i]
        x = layer_norm(DEEPNORM_ALPHA * x + mod[2] * y, ln1_g[i], ln1_b[i])
        f = peer(modulate(x, mod[3], mod[4]), peer_w_q[i], peer_keys[i], peer_u[i], peer_v[i])
        x = layer_norm(DEEPNORM_ALPHA * x + mod[5] * f, ln2_g[i], ln2_b[i])
        if need_ctx:
            yc = jnp.concatenate([o[1] for o in outs], -1) @ w_out[i]
            xc = layer_norm(DEEPNORM_ALPHA * xc + mod_c[2] * yc, ln1_g[i], ln1_b[i])
            fc = peer(modulate(xc, mod_c[3], mod_c[4]), peer_w_q[i], peer_keys[i], peer_u[i], peer_v[i])
            xc = layer_norm(DEEPNORM_ALPHA * xc + mod_c[5] * fc, ln2_g[i], ln2_b[i])
    return x
```

```cpp
#include <hip/hip_runtime.h>
#include <hip/hip_cooperative_groups.h>
#include <cstdio>
namespace cg = cooperative_groups;

#define DEV __device__ __forceinline__
typedef unsigned short u16;
typedef unsigned int u32;
typedef short bf16x8 __attribute__((ext_vector_type(8)));
typedef float f32x4 __attribute__((ext_vector_type(4)));
typedef unsigned int u32x4 __attribute__((ext_vector_type(4)));

#define T_ALL 18432
#define T_LAT 16384
#define LDP 3072
#define ALPHA 1.681792830507429f
#define NTHR 256
#ifndef PROBE_REP
#define PROBE_REP 0
#endif

constexpr size_t al(size_t x) { return (x + 255) & ~(size_t)255; }
constexpr size_t O_MOD = 0;
constexpr size_t O_AXC = al(O_MOD + 4ull * 9 * 6144 * 4);
constexpr size_t O_AXS = al(O_AXC + 64 * 8 * 4);
constexpr size_t O_RC = al(O_AXS + 64 * 8 * 4);
constexpr size_t O_RS = al(O_RC + 2048 * 16 * 4);
constexpr size_t O_WINT = al(O_RS + 2048 * 16 * 4);
constexpr size_t O_WUQT = al(O_WINT + 4ull * 3072 * 1024 * 2);
constexpr size_t O_WUKVT = al(O_WUQT + 4ull * 384 * 256 * 2);
constexpr size_t O_WOUTT = al(O_WUKVT + 4ull * 512 * 128 * 2);
constexpr size_t O_WQBF = al(O_WOUTT + 4ull * 1024 * 1024 * 2);
constexpr size_t O_KEYBF = al(O_WQBF + 4ull * 1024 * 2048 * 2);
constexpr size_t O_WPT = al(O_KEYBF + 4ull * 2 * 128 * 128 * 2);
constexpr size_t O_UBF = al(O_WPT + 4ull * 2048 * 1024 * 2);
constexpr size_t O_VBF = al(O_UBF + 4ull * 16384 * 1024);
constexpr size_t O_USC = al(O_VBF + 4ull * 16384 * 1024);
constexpr size_t O_VSC = al(O_USC + 4ull * 16384 * 4);
constexpr size_t O_XCUR = al(O_VSC + 4ull * 16384 * 4);
constexpr size_t O_XMOD = al(O_XCUR + (size_t)T_ALL * 1024 * 4);
constexpr size_t O_MIX = al(O_XMOD + (size_t)T_ALL * 1024 * 2);
constexpr size_t O_P = al(O_MIX + (size_t)T_ALL * 1024 * 2);
constexpr size_t O_QB = al(O_P + (size_t)T_ALL * 2048 * 4);
constexpr size_t O_KN = al(O_QB + (size_t)T_ALL * 384 * 2);
constexpr size_t O_VT = al(O_KN + (size_t)T_ALL * 256 * 2);
constexpr size_t O_KR = al(O_VT + 8ull * 4 * 64 * 2304 * 2);
constexpr size_t O_LGG = al(O_KR + (size_t)T_ALL * 32 * 2);
constexpr size_t O_XBC = al(O_LGG + 2ull * T_ALL * 128 * 4);
constexpr size_t O_DT = al(O_XBC + (size_t)T_ALL * 768 * 2);
constexpr size_t O_LA = al(O_DT + 2ull * T_ALL * 4 * 4);
constexpr size_t O_QKR = al(O_LA + 2ull * T_ALL * 4 * 4);
constexpr size_t O_SLOC = al(O_QKR + (size_t)T_ALL * 256 * 2);
constexpr size_t SLOC_G = 0, SLOC_S = 2304ull * 2048, SLOC_R = SLOC_S + 2304ull * 8192;
constexpr size_t O_DEC = al(O_SLOC + (SLOC_R + 2304ull * 2048) * 4);
constexpr size_t DEC_G = 0, DEC_S = 2304 * 32, DEC_R = DEC_S + 2304;
constexpr size_t O_SIN = al(O_DEC + (DEC_R + 2304) * 4);
constexpr size_t O_SSQ = al(O_SIN + (SLOC_R + 2304ull * 2048) * 2);
constexpr size_t O_BAR = al(O_SSQ + (size_t)T_ALL * 4 * 4);
constexpr size_t WS_TOTAL = al(O_BAR + 3456 * 4);

struct P {
  const float* in[34];
  float* out;
  char* ws;
};

DEV u16 f2bf_sw(float f) { u32 u = __float_as_uint(f); u += 0x7fffu + ((u >> 16) & 1u); return (u16)(u >> 16); }
DEV float bf2f(u16 h) { return __uint_as_float(((u32)h) << 16); }
typedef float f32x2_t __attribute__((ext_vector_type(2)));
typedef __bf16 bf16x2_t __attribute__((ext_vector_type(2)));
DEV u32 pack2(float a, float b) {
  f32x2_t v = {a, b};
  bf16x2_t r = __builtin_convertvector(v, bf16x2_t);
  return __builtin_bit_cast(u32, r);
}
DEV u16 f2bf(float f) { return (u16)(pack2(f, 0.f) & 0xffffu); }
DEV float lo2f(u32 w) { return __uint_as_float(w << 16); }
DEV float hi2f(u32 w) { return __uint_as_float(w & 0xffff0000u); }
DEV float silu_f(float x) { return x / (1.f + __expf(-x)); }
DEV float softplus_f(float x) { return fmaxf(x, 0.f) + log1pf(expf(-fabsf(x))); }
DEV int modrow_of(int row) { return row < T_LAT ? (row >> 11) : 8; }
DEV int tpos_of(int row) { return row < T_LAT ? (row & 2047) : ((row - T_LAT) & 255); }
DEV int chunk_row0(int b, int gc) { return gc < 4 ? (T_LAT + b * 256 + gc * 64) : (b * 2048 + (gc - 4) * 64); }
DEV f32x4 mfma16(bf16x8 a, bf16x8 b, f32x4 c) { return __builtin_amdgcn_mfma_f32_16x16x32_bf16(a, b, c, 0, 0, 0); }
DEV float xor16_sum(float v) {
  v += __shfl_xor(v, 1, 64); v += __shfl_xor(v, 2, 64); v += __shfl_xor(v, 4, 64); v += __shfl_xor(v, 8, 64); return v;
}
DEV float xor16_max(float v) {
  v = fmaxf(v, __shfl_xor(v, 1, 64)); v = fmaxf(v, __shfl_xor(v, 2, 64)); v = fmaxf(v, __shfl_xor(v, 4, 64)); v = fmaxf(v, __shfl_xor(v, 8, 64)); return v;
}
#define OPAQUE_Z int zz; asm volatile("s_mov_b32 %0, 0" : "=s"(zz))
DEV float wave_sum(float v) {
  v += __shfl_xor(v, 1, 64); v += __shfl_xor(v, 2, 64); v += __shfl_xor(v, 4, 64); v += __shfl_xor(v, 8, 64);
  v += __shfl_xor(v, 16, 64); v += __shfl_xor(v, 32, 64); return v;
}

DEV void unpack8(u32x4 w, float* o) {
  o[0] = lo2f(w[0]); o[1] = hi2f(w[0]); o[2] = lo2f(w[1]); o[3] = hi2f(w[1]);
  o[4] = lo2f(w[2]); o[5] = hi2f(w[2]); o[6] = lo2f(w[3]); o[7] = hi2f(w[3]);
}
DEV u32x4 pack8(const float* o) {
  u32x4 w; w[0] = pack2(o[0], o[1]); w[1] = pack2(o[2], o[3]); w[2] = pack2(o[4], o[5]); w[3] = pack2(o[6], o[7]); return w;
}


DEV void sincos_rev(double ang, float& c, float& s) {
  double rev = ang * 0.15915494309189533576888;
  rev -= floor(rev + 0.5);
  double x = rev * 6.28318530717958647692;
  double x2 = x * x;
  double sv = 1.0, cv = 1.0;
  double ts = 1.0, tc = 1.0;
  sv = 0.0; cv = 0.0;
  double term = 1.0;
  double cterm = 1.0, sterm = 1.0;
  cv = 1.0; sv = 1.0;
#pragma unroll
  for (int n = 1; n <= 13; n++) {
    cterm *= -x2 / (double)((2 * n - 1) * (2 * n));
    sterm *= -x2 / (double)((2 * n) * (2 * n + 1));
    cv += cterm; sv += sterm;
  }
  (void)ts; (void)tc; (void)term;
  c = (float)cv; s = (float)(sv * x);
}

__device__ __forceinline__ void ph_mod(const P& p, char* smem) {
  OPAQUE_Z;
  float* MOD = (float*)(p.ws + zz + O_MOD);
  float* sS = (float*)smem;
  float* red = sS + 9 * 1024;
  const int tid = (threadIdx.x + zz);
  for (int i = tid; i < 9 * 1024; i += NTHR) {
    int r = i >> 10, k = i & 1023;
    float v = (r < 8) ? p.in[1][r * 1024 + k] : p.in[3][k];
    sS[i] = v / (1.f + expf(-v));
  }
  __syncthreads();
  for (int task = (blockIdx.x + zz); task < 4 * 96; task += (gridDim.x + zz)) {
    int l = task / 96, n0 = (task % 96) * 64;
    int col = tid & 63, ks = tid >> 6;
    const float* w = p.in[4] + (size_t)l * 1024 * 6144 + (size_t)(ks * 256) * 6144 + n0 + col;
    float acc[9];
#pragma unroll
    for (int r = 0; r < 9; r++) acc[r] = 0.f;
#pragma unroll 16
    for (int k = 0; k < 256; k++) {
      float wv = w[(size_t)k * 6144];
      const float* s = sS + ks * 256 + k;
#pragma unroll
      for (int r = 0; r < 9; r++) acc[r] += s[r * 1024] * wv;
    }
#pragma unroll
    for (int r = 0; r < 9; r++) red[(ks * 9 + r) * 64 + col] = acc[r];
    __syncthreads();
    for (int i = tid; i < 576; i += NTHR) {
      int r = i >> 6, c = i & 63;
      float v = red[(0 * 9 + r) * 64 + c] + red[(1 * 9 + r) * 64 + c] + red[(2 * 9 + r) * 64 + c] + red[(3 * 9 + r) * 64 + c] +
                p.in[5][l * 6144 + n0 + c];
      MOD[(size_t)(l * 9 + r) * 6144 + n0 + c] = v;
    }
    __syncthreads();
  }
  float* AXC = (float*)(p.ws + zz + O_AXC); float* AXS = (float*)(p.ws + zz + O_AXS);
  float* RC = (float*)(p.ws + zz + O_RC); float* RS = (float*)(p.ws + zz + O_RS);
  int gt = (blockIdx.x + zz) * NTHR + tid, gs = (gridDim.x + zz) * NTHR;
  for (int i = gt; i < 64 * 8 + 2048 * 16; i += gs) {
    if (i < 512) {
      int pos = i >> 3, f = i & 7;
      float fr = expf(-9.210340371976184f * (float)f / 8.f);
      float a = (float)pos * fr;
      float c, s; sincos_rev((double)a, c, s);
      AXC[i] = c; AXS[i] = s;
    } else {
      int j = i - 512; int pos = j >> 4, f = j & 15;
      float fr = expf(-9.210340371976184f * (float)f / 16.f);
      float a = (float)pos * fr;
      float c, s; sincos_rev((double)a, c, s);
      RC[j] = c; RS[j] = s;
    }
  }
}

__device__ __forceinline__ void transpose_cvt(const float* src, int K, int N, u16* dst, const float* gk, char* smem, int glo = 0, int ghi = 1 << 30) {
  OPAQUE_Z;
  float* tile = (float*)smem;
  const int tid = (threadIdx.x + zz);
  int nt_n = (N + 63) / 64, nt_k = K / 64;
  for (int t = (blockIdx.x + zz); t < nt_n * nt_k; t += (gridDim.x + zz)) {
    int k0 = (t / nt_n) * 64, n0 = (t % nt_n) * 64;
    float v[16];
#pragma unroll
    for (int it = 0; it < 16; it++) {
      int i = tid + it * NTHR; int kk = i >> 6, nn = i & 63;
      v[it] = (n0 + nn < N) ? src[(size_t)(k0 + kk) * N + n0 + nn] : 0.f;
    }
    __syncthreads();
#pragma unroll
    for (int it = 0; it < 16; it++) {
      int i = tid + it * NTHR; int kk = i >> 6, nn = i & 63;
      float x = v[it];
      if (gk && (k0 + kk) >= glo && (k0 + kk) < ghi) x *= gk[k0 + kk - glo];
      tile[kk * 65 + nn] = x;
    }
    __syncthreads();
#pragma unroll
    for (int it = 0; it < 8; it++) {
      int i = tid + it * NTHR; int nn = i >> 5, kp = (i & 31) * 2;
      if (n0 + nn < N) *(u32*)(dst + (size_t)(n0 + nn) * K + k0 + kp) = pack2(tile[kp * 65 + nn], tile[(kp + 1) * 65 + nn]);
    }
  }
}

__device__ __forceinline__ void cvt_flat(const float* __restrict__ src, u16* __restrict__ dst, size_t n) {
  OPAQUE_Z;
  size_t gt = (size_t)(blockIdx.x + zz) * NTHR + (threadIdx.x + zz), gs = (size_t)(gridDim.x + zz) * NTHR;
  size_t n8 = n >> 3;
#pragma unroll 4
  for (size_t i = gt; i < n8; i += gs) {
    float4 a = ((const float4*)src)[2 * i], b = ((const float4*)src)[2 * i + 1];
    uint4 o; o.x = pack2(a.x, a.y); o.y = pack2(a.z, a.w); o.z = pack2(b.x, b.y); o.w = pack2(b.z, b.w);
    ((uint4*)dst)[i] = o;
  }
}

__device__ __forceinline__ void cvt_fp8_rows(const float* src, unsigned char* dst, float* sc, int nrows) {
  OPAQUE_Z;
  const int lane = (threadIdx.x + zz) & 63;
  int gw = ((blockIdx.x + zz) * NTHR + (threadIdx.x + zz)) >> 6, nw = ((gridDim.x + zz) * NTHR) >> 6;
  for (int row0 = gw; row0 < nrows; row0 += 4 * nw) {
    f32x4 v[4][4];
#pragma unroll
    for (int u = 0; u < 4; u++) {
      int row = row0 + u * nw;
      if (row < nrows) {
        const f32x4* s4 = (const f32x4*)(src + (size_t)row * 1024 + lane * 16);
#pragma unroll
        for (int i = 0; i < 4; i++) v[u][i] = s4[i];
      } else {
#pragma unroll
        for (int i = 0; i < 4; i++) v[u][i] = (f32x4){0.f, 0.f, 0.f, 0.f};
      }
    }
#pragma unroll
    for (int u = 0; u < 4; u++) {
      int row = row0 + u * nw;
      float am = 0.f;
#pragma unroll
      for (int i = 0; i < 4; i++)
#pragma unroll
        for (int e = 0; e < 4; e++) am = fmaxf(am, fabsf(v[u][i][e]));
      am = fmaxf(am, __shfl_xor(am, 1, 64)); am = fmaxf(am, __shfl_xor(am, 2, 64)); am = fmaxf(am, __shfl_xor(am, 4, 64));
      am = fmaxf(am, __shfl_xor(am, 8, 64)); am = fmaxf(am, __shfl_xor(am, 16, 64)); am = fmaxf(am, __shfl_xor(am, 32, 64));
      float q = am > 0.f ? 240.f / am : 1.f;
      float qi = am > 0.f ? am * (1.f / 240.f) : 1.f;
      u32x4 o;
#pragma unroll
      for (int i = 0; i < 4; i++) {
        int w = 0;
        w = __builtin_amdgcn_cvt_pk_fp8_f32(v[u][i][0] * q, v[u][i][1] * q, w, false);
        w = __builtin_amdgcn_cvt_pk_fp8_f32(v[u][i][2] * q, v[u][i][3] * q, w, true);
        o[i] = (u32)w;
      }
      if (row < nrows) {
        *(u32x4*)(dst + (size_t)row * 1024 + lane * 16) = o;
        if (lane == 0) sc[row] = qi;
      }
    }
  }
}

__device__ __forceinline__ void ph_convert(const P& p, char* smem) {
  OPAQUE_Z;
  for (int l = 0; l < 4; l++) {
    transpose_cvt(p.in[6] + (size_t)l * 1024 * 3016, 1024, 3016, (u16*)(p.ws + zz + O_WINT) + (size_t)l * 3072 * 1024, nullptr, smem);
    transpose_cvt(p.in[8] + (size_t)l * 256 * 384, 256, 384, (u16*)(p.ws + zz + O_WUQT) + (size_t)l * 384 * 256, p.in[7] + l * 256, smem);
    transpose_cvt(p.in[10] + (size_t)l * 128 * 256, 128, 256, (u16*)(p.ws + zz + O_WUKVT) + (size_t)l * 512 * 128, p.in[9] + l * 128, smem);
    transpose_cvt(p.in[11] + (size_t)l * 128 * 256, 128, 256, (u16*)(p.ws + zz + O_WUKVT) + (size_t)l * 512 * 128 + 256 * 128, p.in[9] + l * 128, smem);
    transpose_cvt(p.in[25] + (size_t)l * 1024 * 1024, 1024, 1024, (u16*)(p.ws + zz + O_WOUTT) + (size_t)l * 1024 * 1024, p.in[24] + l * 256, smem, 512, 768);
  }
  {
    int gt = (blockIdx.x + zz) * NTHR + (threadIdx.x + zz), gs = (gridDim.x + zz) * NTHR;
    for (int i = gt; i < 4 * 56 * 1024; i += gs) {
      int l = i / (56 * 1024), r = i % (56 * 1024);
      ((u16*)(p.ws + zz + O_WINT))[(size_t)l * 3072 * 1024 + (size_t)3016 * 1024 + r] = 0;
    }
  }
  cvt_flat(p.in[28], (u16*)(p.ws + zz + O_WQBF), 4ull * 1024 * 2048);
  cvt_flat(p.in[29], (u16*)(p.ws + zz + O_KEYBF), 4ull * 2 * 128 * 128);
  cvt_fp8_rows(p.in[30], (unsigned char*)(p.ws + zz + O_UBF), (float*)(p.ws + zz + O_USC), 4 * 16384);
  cvt_fp8_rows(p.in[31], (unsigned char*)(p.ws + zz + O_VBF), (float*)(p.ws + zz + O_VSC), 4 * 16384);
}

template <int HOOK>
__device__ __forceinline__ void gemm_tile(const u16* __restrict__ A, int lda, const u16* __restrict__ B, int ldb, int K, char* smem, const float* ssq = nullptr) {
  OPAQUE_Z;
  u16* sA = (u16*)smem;
  u16* sB = sA + 128 * 72;
  const int tid = (threadIdx.x + zz), lane = tid & 63, wave = tid >> 6;
  const int wm = (wave >> 1) * 64, wn = (wave & 1) * 64;
  const int lr = lane & 15, lq = lane >> 4;
  f32x4 acc[4][4];
#pragma unroll
  for (int i = 0; i < 4; i++)
#pragma unroll
    for (int j = 0; j < 4; j++) acc[i][j] = (f32x4){0.f, 0.f, 0.f, 0.f};
  u32x4 ra[4], rb[4];
  float rs[4];
  if (HOOK) {
#pragma unroll
    for (int i = 0; i < 4; i++) {
      int row = (tid + i * NTHR) >> 3;
      float4 q = *(const float4*)(ssq + (size_t)row * 4);
      rs[i] = rsqrtf((q.x + q.y + q.z + q.w) * (1.f / 256.f) + 1e-6f);
    }
  }
#pragma unroll
  for (int i = 0; i < 4; i++) {
    int id = tid + i * NTHR; int row = id >> 3, ch = id & 7;
    ra[i] = *(const u32x4*)(A + (size_t)row * lda + ch * 8);
    rb[i] = *(const u32x4*)(B + (size_t)row * ldb + ch * 8);
  }
#pragma unroll 1
  for (int k0 = 0; k0 < K; k0 += 64) {
    __syncthreads();
    if (HOOK && k0 >= 512 && k0 < 768) {
#pragma unroll
      for (int i = 0; i < 4; i++) {
        float t8[8];
        unpack8(ra[i], t8);
#pragma unroll
        for (int e = 0; e < 8; e++) t8[e] *= rs[i];
        ra[i] = pack8(t8);
      }
    }
#pragma unroll
    for (int i = 0; i < 4; i++) {
      int id = tid + i * NTHR; int row = id >> 3, ch = id & 7;
      *(u32x4*)(sA + row * 72 + ch * 8) = ra[i];
      *(u32x4*)(sB + row * 72 + ch * 8) = rb[i];
    }
    __syncthreads();
    if (k0 + 64 < K) {
#pragma unroll
      for (int i = 0; i < 4; i++) {
        int id = tid + i * NTHR; int row = id >> 3, ch = id & 7;
        ra[i] = *(const u32x4*)(A + (size_t)row * lda + k0 + 64 + ch * 8);
        rb[i] = *(const u32x4*)(B + (size_t)row * ldb + k0 + 64 + ch * 8);
      }
    }
#pragma unroll
    for (int kk = 0; kk < 64; kk += 32) {
      bf16x8 af[4], bfr[4];
#pragma unroll
      for (int i = 0; i < 4; i++) af[i] = *(const bf16x8*)(sA + (wm + i * 16 + lr) * 72 + kk + lq * 8);
#pragma unroll
      for (int j = 0; j < 4; j++) bfr[j] = *(const bf16x8*)(sB + (wn + j * 16 + lr) * 72 + kk + lq * 8);
      __builtin_amdgcn_s_setprio(1);
#pragma unroll
      for (int i = 0; i < 4; i++)
#pragma unroll
        for (int j = 0; j < 4; j++) acc[i][j] = mfma16(af[i], bfr[j], acc[i][j]);
      __builtin_amdgcn_s_setprio(0);
    }
  }
  __syncthreads();
  float* sC = (float*)smem;
#pragma unroll
  for (int i = 0; i < 4; i++)
#pragma unroll
    for (int j = 0; j < 4; j++)
#pragma unroll
      for (int r = 0; r < 4; r++) sC[(wm + i * 16 + lq * 4 + r) * 128 + wn + j * 16 + lr] = acc[i][j][r];
  __syncthreads();
}

enum { EPI_BF16 = 0, EPI_F32 = 1, EPI_Q = 2, EPI_KV = 3, EPI_OUT = 4 };

template <int EPI>
__device__ __forceinline__ void gemm_phase(const P& p, int l, const u16* A, int lda, const u16* Bt, int ldb, int K, int mtiles, int ntiles,
                           void* outp, int ldo, char* smem) {
  OPAQUE_Z;
  const int tid = (threadIdx.x + zz);
  float* sC = (float*)smem;
  for (int t = (blockIdx.x + zz); t < mtiles * ntiles; t += (gridDim.x + zz)) {
    int mt = t / ntiles, nt = t % ntiles;
    int m0 = mt * 128, n0 = nt * 128;
    gemm_tile<(EPI == EPI_OUT) ? 1 : 0>(A + (size_t)m0 * lda, lda, Bt + (size_t)n0 * ldb, ldb, K, smem, (const float*)(p.ws + zz + O_SSQ) + (size_t)m0 * 4);
    if (EPI == EPI_BF16) {
      u16* out = (u16*)outp;
      for (int i = tid; i < 128 * 32; i += NTHR) {
        int r = i >> 5, c4 = (i & 31) * 4;
        float4 v = *(const float4*)(sC + r * 128 + c4);
        uint2 o; o.x = pack2(v.x, v.y); o.y = pack2(v.z, v.w);
        *(uint2*)(out + (size_t)(m0 + r) * ldo + n0 + c4) = o;
      }
    } else if (EPI == EPI_F32) {
      float* out = (float*)outp;
      for (int i = tid; i < 128 * 32; i += NTHR) {
        int r = i >> 5, c4 = (i & 31) * 4;
        *(float4*)(out + (size_t)(m0 + r) * ldo + n0 + c4) = *(const float4*)(sC + r * 128 + c4);
      }
    } else if (EPI == EPI_OUT) {
      float* xc = (float*)(p.ws + zz + O_XCUR);
      const float* MOD = (const float*)(p.ws + zz + O_MOD);
#pragma unroll 1
      for (int i0 = tid; i0 < 128 * 32; i0 += 4 * NTHR) {
        float4 xv4[4], gg4[4];
#pragma unroll
        for (int u = 0; u < 4; u++) {
          int i = i0 + u * NTHR; int r = i >> 5, c4 = (i & 31) * 4; int row = m0 + r;
          gg4[u] = *(const float4*)(MOD + (size_t)(l * 9 + modrow_of(row)) * 6144 + 2 * 1024 + n0 + c4);
          xv4[u] = *(const float4*)(xc + (size_t)row * 1024 + n0 + c4);
        }
#pragma unroll
        for (int u = 0; u < 4; u++) {
          int i = i0 + u * NTHR; int r = i >> 5, c4 = (i & 31) * 4; int row = m0 + r;
          float4 v = *(const float4*)(sC + r * 128 + c4);
          float4 xv = xv4[u], gg = gg4[u];
          xv.x = ALPHA * xv.x + gg.x * v.x; xv.y = ALPHA * xv.y + gg.y * v.y;
          xv.z = ALPHA * xv.z + gg.z * v.z; xv.w = ALPHA * xv.w + gg.w * v.w;
          *(float4*)(xc + (size_t)row * 1024 + n0 + c4) = xv;
        }
      }
    } else if (EPI == EPI_Q || EPI == EPI_KV) {
      const u16* Pm = (const u16*)(p.ws + zz + O_P);
      for (int i = tid; i < 128 * 32; i += NTHR) {
        int r = i >> 5, sub = i & 31, c4 = sub * 4;
        int row = m0 + r;
        float ss = 0.f;
        if (EPI == EPI_Q) {
          uint4 w = *(const uint4*)(Pm + (size_t)row * LDP + sub * 8);
          float a;
          a = lo2f(w.x); ss += a * a; a = hi2f(w.x); ss += a * a; a = lo2f(w.y); ss += a * a; a = hi2f(w.y); ss += a * a;
          a = lo2f(w.z); ss += a * a; a = hi2f(w.z); ss += a * a; a = lo2f(w.w); ss += a * a; a = hi2f(w.w); ss += a * a;
        } else {
          uint2 w = *(const uint2*)(Pm + (size_t)row * LDP + 256 + sub * 4);
          float a;
          a = lo2f(w.x); ss += a * a; a = hi2f(w.x); ss += a * a; a = lo2f(w.y); ss += a * a; a = hi2f(w.y); ss += a * a;
        }
        ss += __shfl_xor(ss, 1, 64); ss += __shfl_xor(ss, 2, 64); ss += __shfl_xor(ss, 4, 64);
        ss += __shfl_xor(ss, 8, 64); ss += __shfl_xor(ss, 16, 64);
        float rinv = (EPI == EPI_Q) ? rsqrtf(ss * (1.f / 256.f) + 1e-6f) * (0.10206207261596577f * 1.4426950408889634f)
                                    : rsqrtf(ss * (1.f / 128.f) + 1e-6f);
        float4 v = *(float4*)(sC + r * 128 + c4);
        v.x *= rinv; v.y *= rinv; v.z *= rinv; v.w *= rinv;
        *(float4*)(sC + r * 128 + c4) = v;
      }
      __syncthreads();
      if (EPI == EPI_Q) {
        u16* out = (u16*)(p.ws + zz + O_QB);
        const float* AXC = (const float*)(p.ws + zz + O_AXC); const float* AXS = (const float*)(p.ws + zz + O_AXS);
        for (int i = tid; i < 128 * 128; i += NTHR) {
          int r = i >> 7, c = i & 127;
          int row = m0 + r, col = n0 + c;
          float v = sC[r * 128 + c];
          int hc = col % 96;
          if (row < T_LAT && hc >= 64) {
            int d = hc - 64; int sub = d >> 4, dd = d & 15, f = dd & 7; bool first = dd < 8;
            int t = row & 2047;
            int pos = sub == 0 ? (t >> 6) : (t & 63);
            float cs = AXC[pos * 8 + f], sn = AXS[pos * 8 + f];
            float other = sC[r * 128 + (first ? c + 8 : c - 8)];
            v = first ? (v * cs - other * sn) : (other * sn + v * cs);
          }
          out[(size_t)row * 384 + col] = f2bf(v);
        }
      } else {
        if (nt < 2) {
          u16* out = (u16*)(p.ws + zz + O_KN);
          for (int i = tid; i < 128 * 32; i += NTHR) {
            int r = i >> 5, c4 = (i & 31) * 4;
            float4 v = *(const float4*)(sC + r * 128 + c4);
            uint2 o; o.x = pack2(v.x, v.y); o.y = pack2(v.z, v.w);
            *(uint2*)(out + (size_t)(m0 + r) * 256 + n0 + c4) = o;
          }
        } else {
          u16* VT = (u16*)(p.ws + zz + O_VT);
          int b, pos0;
          if (m0 < T_LAT) { b = m0 >> 11; pos0 = 256 + (m0 & 2047); } else { b = (m0 - T_LAT) >> 8; pos0 = (m0 - T_LAT) & 255; }
          for (int i = tid; i < 128 * 16; i += NTHR) {
            int c = i >> 4, r8 = (i & 15) * 8;
            int vc = (nt - 2) * 128 + c; int h = vc >> 6, dv = vc & 63;
            uint4 o;
            o.x = pack2(sC[(r8 + 0) * 128 + c], sC[(r8 + 1) * 128 + c]);
            o.y = pack2(sC[(r8 + 2) * 128 + c], sC[(r8 + 3) * 128 + c]);
            o.z = pack2(sC[(r8 + 4) * 128 + c], sC[(r8 + 5) * 128 + c]);
            o.w = pack2(sC[(r8 + 6) * 128 + c], sC[(r8 + 7) * 128 + c]);
            *(uint4*)(VT + ((size_t)((b * 4 + h) * 64 + dv)) * 2304 + pos0 + r8) = o;
          }
        }
      }
    }
  }
}

__device__ __forceinline__ void ph_fold(const P& p, char* smem) {
  OPAQUE_Z;
  const int tid = (threadIdx.x + zz);
  float* sC = (float*)smem;
  for (int t = (blockIdx.x + zz); t < 4 * 16 * 8; t += (gridDim.x + zz)) {
    int l = t >> 7, hj = (t >> 3) & 15, kt = t & 7;
    int j = hj & 1;
    const u16* A = (const u16*)(p.ws + zz + O_KEYBF) + (size_t)(l * 2 + j) * 128 * 128;
    const u16* B = (const u16*)(p.ws + zz + O_WQBF) + (size_t)l * 1024 * 2048 + (size_t)(kt * 128) * 2048 + hj * 128;
    gemm_tile<0>(A, 128, B, 2048, 128, smem);
    u16* out = (u16*)(p.ws + zz + O_WPT) + (size_t)l * 2048 * 1024 + (size_t)(hj * 128) * 1024 + kt * 128;
    for (int i = tid; i < 128 * 32; i += NTHR) {
      int r = i >> 5, c4 = (i & 31) * 4;
      float4 v = *(const float4*)(sC + r * 128 + c4);
      uint2 o; o.x = pack2(v.x, v.y); o.y = pack2(v.z, v.w);
      *(uint2*)(out + (size_t)r * 1024 + c4) = o;
    }
  }
}

__device__ __forceinline__ void ph_xinit(const P& p) {
  OPAQUE_Z;
  float* xc = (float*)(p.ws + zz + O_XCUR);
  u16* xm = (u16*)(p.ws + zz + O_XMOD);
  const float* MOD = (const float*)(p.ws + zz + O_MOD);
  size_t gt = (size_t)(blockIdx.x + zz) * NTHR + (threadIdx.x + zz), gs = (size_t)(gridDim.x + zz) * NTHR;
  for (size_t i0 = gt; i0 < (size_t)T_ALL * 256; i0 += 4 * gs) {
    float4 vv[4];
#pragma unroll
    for (int u = 0; u < 4; u++) {
      size_t i = i0 + u * gs;
      vv[u] = make_float4(0.f, 0.f, 0.f, 0.f);
      if (i < (size_t)T_ALL * 256) {
        int row = (int)(i >> 8), c4 = (int)(i & 255) * 4;
        vv[u] = (row < T_LAT) ? *(const float4*)(p.in[0] + (size_t)row * 1024 + c4)
                              : *(const float4*)(p.in[2] + (size_t)(row - T_LAT) * 1024 + c4);
      }
    }
#pragma unroll
    for (int u = 0; u < 4; u++) {
      size_t i = i0 + u * gs;
      if (i < (size_t)T_ALL * 256) {
        int row = (int)(i >> 8), c4 = (int)(i & 255) * 4;
        float4 v = vv[u];
        *(float4*)(xc + (size_t)row * 1024 + c4) = v;
        const float* m = MOD + (size_t)(0 * 9 + modrow_of(row)) * 6144;
        float4 sh = *(const float4*)(m + c4), sc = *(const float4*)(m + 1024 + c4);
        uint2 o; o.x = pack2(v.x * (1.f + sc.x) + sh.x, v.y * (1.f + sc.y) + sh.y);
        o.y = pack2(v.z * (1.f + sc.z) + sh.z, v.w * (1.f + sc.w) + sh.w);
        *(uint2*)(xm + (size_t)row * 1024 + c4) = o;
      }
    }
  }
}

__device__ __forceinline__ void ph_prep(const P& p, int l, char* smem) {
  OPAQUE_Z;
  const u16* Pm = (const u16*)(p.ws + zz + O_P);
  const int tid = (threadIdx.x + zz);
  const int gt = (blockIdx.x + zz) * NTHR + tid, gs = (gridDim.x + zz) * NTHR;
  float* sW = (float*)smem;
  float* sBg = sW + 2 * 16 * 128;
  __syncthreads();
  for (int i = tid; i < 2 * 16 * 128; i += NTHR) sW[i] = ((i >> 11) == 0 ? p.in[12] : p.in[14])[l * 2048 + (i & 2047)];
  for (int i = tid; i < 256; i += NTHR) sBg[i] = ((i >> 7) == 0 ? p.in[13] : p.in[15])[l * 128 + (i & 127)];
  __syncthreads();
  {
    float* LG = (float*)(p.ws + zz + O_LGG);
    for (int i0 = gt; i0 < T_ALL * 32; i0 += 2 * gs) {
      u32x4 la[2], lb[2];
#pragma unroll
      for (int u = 0; u < 2; u++) {
        int i = i0 + u * gs;
        la[u] = (u32x4){0u, 0u, 0u, 0u}; lb[u] = la[u];
        if (i < T_ALL * 32) {
          int row = i >> 5, dir = (i >> 4) & 1;
          const u16* lrp = Pm + (size_t)row * LDP + 1184 + dir * 16;
          la[u] = *(const u32x4*)lrp; lb[u] = *(const u32x4*)(lrp + 8);
        }
      }
#pragma unroll
      for (int u = 0; u < 2; u++) {
        int i = i0 + u * gs;
        if (i < T_ALL * 32) {
          int row = i >> 5, dir = (i >> 4) & 1, cg = i & 15;
          float lr[16];
          unpack8(la[u], lr); unpack8(lb[u], lr + 8);
          float z[8];
#pragma unroll
          for (int c = 0; c < 8; c++) z[c] = sBg[dir * 128 + cg * 8 + c];
#pragma unroll
          for (int k = 0; k < 16; k++) {
            const float4 w0 = *(const float4*)(sW + dir * 2048 + k * 128 + cg * 8);
            const float4 w1 = *(const float4*)(sW + dir * 2048 + k * 128 + cg * 8 + 4);
            z[0] += lr[k] * w0.x; z[1] += lr[k] * w0.y; z[2] += lr[k] * w0.z; z[3] += lr[k] * w0.w;
            z[4] += lr[k] * w1.x; z[5] += lr[k] * w1.y; z[6] += lr[k] * w1.z; z[7] += lr[k] * w1.w;
          }
#pragma unroll
          for (int c = 0; c < 8; c++) z[c] = (fminf(z[c], 0.f) - log1pf(__expf(-fabsf(z[c])))) * (1.f / 16.f);
          float* o = LG + (size_t)dir * T_ALL * 128 + (size_t)row * 128 + cg * 8;
          *(float4*)o = make_float4(z[0], z[1], z[2], z[3]);
          *(float4*)(o + 4) = make_float4(z[4], z[5], z[6], z[7]);
        }
      }
    }
  }
  {
    u16* KR = (u16*)(p.ws + zz + O_KR);
    const float* AXC = (const float*)(p.ws + zz + O_AXC); const float* AXS = (const float*)(p.ws + zz + O_AXS);
    for (int row = gt; row < T_ALL; row += gs) {
      const u16* src = Pm + (size_t)row * LDP + 384;
      u32x4 w0 = *(const u32x4*)src, w1 = *(const u32x4*)(src + 8), w2 = *(const u32x4*)(src + 16), w3 = *(const u32x4*)(src + 24);
      if (row < T_LAT) {
        int t = row & 2047;
        float a[8], b[8], c[8], d[8];
        unpack8(w0, a); unpack8(w1, b); unpack8(w2, c); unpack8(w3, d);
        const float* cr = AXC + (t >> 6) * 8; const float* sr = AXS + (t >> 6) * 8;
        const float* cc = AXC + (t & 63) * 8; const float* sc = AXS + (t & 63) * 8;
#pragma unroll
        for (int f = 0; f < 8; f++) {
          float x1 = a[f], x2 = b[f]; a[f] = x1 * cr[f] - x2 * sr[f]; b[f] = x1 * sr[f] + x2 * cr[f];
          float y1 = c[f], y2 = d[f]; c[f] = y1 * cc[f] - y2 * sc[f]; d[f] = y1 * sc[f] + y2 * cc[f];
        }
        w0 = pack8(a); w1 = pack8(b); w2 = pack8(c); w3 = pack8(d);
      }
      u16* dst = KR + (size_t)row * 32;
      *(u32x4*)dst = w0; *(u32x4*)(dst + 8) = w1; *(u32x4*)(dst + 16) = w2; *(u32x4*)(dst + 24) = w3;
    }
  }
  {
    u16* XBC = (u16*)(p.ws + zz + O_XBC);
    const float* cw = p.in[17] + (size_t)l * 3 * 768; const float* cb = p.in[18] + l * 768;
    for (int i0 = gt; i0 < T_ALL * 96; i0 += 2 * gs) {
      u32x4 r0[2], rm[2], rp[2];
      const u32x4 zero = (u32x4){0u, 0u, 0u, 0u};
#pragma unroll
      for (int u = 0; u < 2; u++) {
        int i = i0 + u * gs;
        r0[u] = zero; rm[u] = zero; rp[u] = zero;
        if (i < T_ALL * 96) {
          int row = i / 96, cg = i - row * 96;
          int t = tpos_of(row); int L = row < T_LAT ? 2048 : 256;
          const u16* src = Pm + (size_t)row * LDP + 1472 + cg * 8;
          r0[u] = *(const u32x4*)src;
          if (t > 0) rm[u] = *(const u32x4*)(src - LDP);
          if (t < L - 1) rp[u] = *(const u32x4*)(src + LDP);
        }
      }
#pragma unroll
      for (int u = 0; u < 2; u++) {
        int i = i0 + u * gs;
        if (i < T_ALL * 96) {
          int row = i / 96, cg = i - row * 96;
          float x0[8], xm[8], xp[8];
          unpack8(r0[u], x0); unpack8(rm[u], xm); unpack8(rp[u], xp);
          float y[8];
#pragma unroll
          for (int c = 0; c < 8; c++) {
            float v = cw[cg * 8 + c] * xm[c] + cw[768 + cg * 8 + c] * x0[c] + cw[1536 + cg * 8 + c] * xp[c] + cb[cg * 8 + c];
            y[c] = silu_f(v);
          }
          *(u32x4*)(XBC + (size_t)row * 768 + cg * 8) = pack8(y);
        }
      }
    }
    float* DT = (float*)(p.ws + zz + O_DT); float* LA = (float*)(p.ws + zz + O_LA);
    for (int i = gt; i < 2 * T_ALL * 4; i += gs) {
      int dir = i / (T_ALL * 4); int rem = i - dir * (T_ALL * 4);
      int row = rem >> 2, h = rem & 3;
      float raw = bf2f(Pm[(size_t)row * LDP + 2240 + dir * 4 + h]);
      float bias = (dir == 0 ? p.in[19] : p.in[20])[l * 4 + h];
      float alog = (dir == 0 ? p.in[21] : p.in[22])[l * 4 + h];
      float dt = softplus_f(raw + bias);
      DT[i] = dt; LA[i] = -dt * expf(alog);
    }
  }
  {
    u16* QK = (u16*)(p.ws + zz + O_QKR);
    const float* RC = (const float*)(p.ws + zz + O_RC); const float* RS = (const float*)(p.ws + zz + O_RS);
    for (int i = gt; i < T_ALL * 8; i += gs) {
      int row = i >> 3, which = (i >> 2) & 1, h = i & 3;
      const u16* src = Pm + (size_t)row * LDP + 2248 + which * 128 + h * 32;
      float a[8], b[8], c[8], d[8];
      unpack8(*(const u32x4*)src, a); unpack8(*(const u32x4*)(src + 8), b);
      unpack8(*(const u32x4*)(src + 16), c); unpack8(*(const u32x4*)(src + 24), d);
      float sc = which == 1 ? 0.17677669529663687f : 1.f;
      if (row < T_LAT) {
        int t = row & 2047;
        const float* cs = RC + t * 16; const float* sn = RS + t * 16;
#pragma unroll
        for (int f = 0; f < 8; f++) {
          float x1 = a[f], x2 = c[f]; a[f] = x1 * cs[f] - x2 * sn[f]; c[f] = x1 * sn[f] + x2 * cs[f];
          float y1 = b[f], y2 = d[f]; b[f] = y1 * cs[8 + f] - y2 * sn[8 + f]; d[f] = y1 * sn[8 + f] + y2 * cs[8 + f];
        }
      }
#pragma unroll
      for (int f = 0; f < 8; f++) { a[f] *= sc; b[f] *= sc; c[f] *= sc; d[f] *= sc; }
      u16* dst = QK + (size_t)row * 256 + which * 128 + h * 32;
      *(u32x4*)dst = pack8(a); *(u32x4*)(dst + 8) = pack8(b); *(u32x4*)(dst + 16) = pack8(c); *(u32x4*)(dst + 24) = pack8(d);
    }
  }
}

__device__ __forceinline__ void ph_attn(const P& p, int need_ctx, char* smem) {
  OPAQUE_Z;
  const u16* QB = (const u16*)(p.ws + zz + O_QB);
  const u16* KN = (const u16*)(p.ws + zz + O_KN);
  const u16* KR = (const u16*)(p.ws + zz + O_KR);
  const u16* VT = (const u16*)(p.ws + zz + O_VT);
  u16* MIX = (u16*)(p.ws + zz + O_MIX);
  u16* sK = (u16*)smem;
  u16* sV = sK + 64 * 104;
  const int tid = (threadIdx.x + zz), lane = tid & 63, wave = tid >> 6, lr = lane & 15, lq = lane >> 4;
  int ntask = 8 * 4 * 16 + (need_ctx ? 8 * 4 * 2 : 0);
  for (int task = (blockIdx.x + zz); task < ntask; task += (gridDim.x + zz)) {
    int b, h, qrow0, nkt;
    if (task < 512) { b = task >> 6; h = (task >> 4) & 3; int qt = task & 15; qrow0 = b * 2048 + qt * 128; nkt = 36; }
    else { int t2 = task - 512; b = t2 >> 3; h = (t2 >> 1) & 3; int qt = t2 & 1; qrow0 = T_LAT + b * 256 + qt * 128; nkt = 4; }
    bf16x8 qf[2][3];
#pragma unroll
    for (int qs = 0; qs < 2; qs++) {
      const u16* qp = QB + (size_t)(qrow0 + wave * 32 + qs * 16 + lr) * 384 + h * 96 + lq * 8;
#pragma unroll
      for (int ks = 0; ks < 3; ks++) qf[qs][ks] = *(const bf16x8*)(qp + ks * 32);
    }
    f32x4 o[2][4];
    float m[2], lsum[2];
#pragma unroll
    for (int qs = 0; qs < 2; qs++) {
      m[qs] = -1e30f; lsum[qs] = 0.f;
#pragma unroll
      for (int i = 0; i < 4; i++) o[qs][i] = (f32x4){0.f, 0.f, 0.f, 0.f};
    }
    u32x4 rk[3], rv[2];
#define ATT_LOAD(kt_)                                                                                   \
  {                                                                                                     \
    int pos0_ = (kt_) * 64;                                                                             \
    int krow0_ = (pos0_ < 256) ? (T_LAT + b * 256 + pos0_) : (b * 2048 + pos0_ - 256);                  \
    _Pragma("unroll") for (int i_ = 0; i_ < 3; i_++) {                                                  \
      int id_ = tid + i_ * NTHR; int j_ = id_ / 12, ch_ = id_ - j_ * 12;                                \
      rk[i_] = (ch_ < 8) ? *(const u32x4*)(KN + (size_t)(krow0_ + j_) * 256 + h * 64 + ch_ * 8)         \
                         : *(const u32x4*)(KR + (size_t)(krow0_ + j_) * 32 + (ch_ - 8) * 8);            \
    }                                                                                                   \
    _Pragma("unroll") for (int i_ = 0; i_ < 2; i_++) {                                                  \
      int id_ = tid + i_ * NTHR; int dv_ = id_ >> 3, ch_ = id_ & 7;                                     \
      rv[i_] = *(const u32x4*)(VT + ((size_t)((b * 4 + h) * 64 + dv_)) * 2304 + pos0_ + ch_ * 8);       \
    }                                                                                                   \
  }
    ATT_LOAD(0);
#pragma unroll 1
    for (int kt = 0; kt < nkt; kt++) {
      __syncthreads();
#pragma unroll
      for (int i = 0; i < 3; i++) { int id = tid + i * NTHR; int j = id / 12, ch = id - j * 12; *(u32x4*)(sK + j * 104 + ch * 8) = rk[i]; }
#pragma unroll
      for (int i = 0; i < 2; i++) { int id = tid + i * NTHR; int dv = id >> 3, ch = id & 7; *(u32x4*)(sV + dv * 72 + ch * 8) = rv[i]; }
      __syncthreads();
      if (kt + 1 < nkt) ATT_LOAD(kt + 1);
      f32x4 s[2][4];
      __builtin_amdgcn_s_setprio(1);
#pragma unroll
      for (int nt = 0; nt < 4; nt++) {
        s[0][nt] = (f32x4){0.f, 0.f, 0.f, 0.f}; s[1][nt] = (f32x4){0.f, 0.f, 0.f, 0.f};
#pragma unroll
        for (int ks = 0; ks < 3; ks++) {
          bf16x8 kf = *(const bf16x8*)(sK + (nt * 16 + lr) * 104 + ks * 32 + lq * 8);
          s[0][nt] = mfma16(kf, qf[0][ks], s[0][nt]);
          s[1][nt] = mfma16(kf, qf[1][ks], s[1][nt]);
        }
      }
      __builtin_amdgcn_s_setprio(0);
      bf16x8 pf[2][2];
#pragma unroll
      for (int qs = 0; qs < 2; qs++) {
        float mx = s[qs][0][0];
#pragma unroll
        for (int nt = 0; nt < 4; nt++)
#pragma unroll
          for (int r = 0; r < 4; r++) mx = fmaxf(mx, s[qs][nt][r]);
        mx = fmaxf(mx, __shfl_xor(mx, 16, 64)); mx = fmaxf(mx, __shfl_xor(mx, 32, 64));
        float mn = fmaxf(m[qs], mx);
        float alpha = __builtin_amdgcn_exp2f(m[qs] - mn);
        m[qs] = mn;
        float ps = 0.f;
#pragma unroll
        for (int nt = 0; nt < 4; nt++)
#pragma unroll
          for (int r = 0; r < 4; r++) { float e = __builtin_amdgcn_exp2f(s[qs][nt][r] - mn); s[qs][nt][r] = e; ps += e; }
        lsum[qs] = lsum[qs] * alpha + ps;
#pragma unroll
        for (int nt = 0; nt < 4; nt++)
#pragma unroll
          for (int r = 0; r < 4; r++) o[qs][nt][r] *= alpha;
#pragma unroll
        for (int m2 = 0; m2 < 2; m2++) {
          u32x4 w;
          w[0] = pack2(s[qs][2 * m2][0], s[qs][2 * m2][1]); w[1] = pack2(s[qs][2 * m2][2], s[qs][2 * m2][3]);
          w[2] = pack2(s[qs][2 * m2 + 1][0], s[qs][2 * m2 + 1][1]); w[3] = pack2(s[qs][2 * m2 + 1][2], s[qs][2 * m2 + 1][3]);
          pf[qs][m2] = __builtin_bit_cast(bf16x8, w);
        }
      }
      __builtin_amdgcn_s_setprio(1);
#pragma unroll
      for (int m2 = 0; m2 < 2; m2++) {
#pragma unroll
        for (int nt = 0; nt < 4; nt++) {
          const u16* vp = sV + (nt * 16 + lr) * 72 + 32 * m2 + 4 * lq;
          uint2 lo = *(const uint2*)vp, hi = *(const uint2*)(vp + 16);
          u32x4 w; w[0] = lo.x; w[1] = lo.y; w[2] = hi.x; w[3] = hi.y;
          bf16x8 vf = __builtin_bit_cast(bf16x8, w);
          o[0][nt] = mfma16(vf, pf[0][m2], o[0][nt]);
          o[1][nt] = mfma16(vf, pf[1][m2], o[1][nt]);
        }
      }
      __builtin_amdgcn_s_setprio(0);
    }
#pragma unroll
    for (int qs = 0; qs < 2; qs++) {
      float ls = lsum[qs];
      ls += __shfl_xor(ls, 16, 64); ls += __shfl_xor(ls, 32, 64);
      float inv = 1.f / ls;
      int row = qrow0 + wave * 32 + qs * 16 + lr;
#pragma unroll
      for (int nt = 0; nt < 4; nt++) {
        uint2 w; w.x = pack2(o[qs][nt][0] * inv, o[qs][nt][1] * inv); w.y = pack2(o[qs][nt][2] * inv, o[qs][nt][3] * inv);
        *(uint2*)(MIX + (size_t)row * 1024 + h * 64 + nt * 16 + lq * 4) = w;
      }
    }
  }
}

struct MixDesc {
  const u16 *q, *k, *v;
  int qld, kld, vld, qc, kc, vc;
  int dk, hshift, g;
  float qscale;
  const float* lg;
  const float* ks;
  size_t sloc_off, dec_off;
};

DEV MixDesc get_mix(const P& p, int m) {
  OPAQUE_Z;
  MixDesc d;
  const u16* Pm = (const u16*)(p.ws + zz + O_P);
  if (m == 0) {
    d.q = Pm; d.k = Pm; d.v = Pm; d.qld = d.kld = d.vld = LDP; d.qc = 416; d.kc = 544; d.vc = 672;
    d.dk = 32; d.hshift = 0; d.g = 32; d.qscale = 0.17677669529663687f;
    d.lg = (const float*)(p.ws + zz + O_LGG); d.ks = nullptr; d.sloc_off = SLOC_G; d.dec_off = DEC_G;
  } else if (m == 1) {
    const u16* X = (const u16*)(p.ws + zz + O_XBC);
    d.q = X; d.k = X; d.v = X; d.qld = d.kld = d.vld = 768; d.qc = 512; d.kc = 256; d.vc = 0;
    d.dk = 128; d.hshift = 1; d.g = 1; d.qscale = 1.f;
    d.lg = (const float*)(p.ws + zz + O_LA); d.ks = (const float*)(p.ws + zz + O_DT); d.sloc_off = SLOC_S; d.dec_off = DEC_S;
  } else {
    const u16* X = (const u16*)(p.ws + zz + O_QKR);
    d.q = X; d.k = X; d.v = Pm; d.qld = d.kld = 256; d.vld = LDP; d.qc = 0; d.kc = 128; d.vc = 2504;
    d.dk = 32; d.hshift = 0; d.g = 1; d.qscale = 1.f;
    d.lg = nullptr; d.ks = nullptr; d.sloc_off = SLOC_R; d.dec_off = DEC_R;
  }
  return d;
}

DEV void stage_cum(const MixDesc& d, int row0, int h, float* sCum, float* sKs) {
  OPAQUE_Z;
  const int tid = (threadIdx.x + zz);
  const int g = d.g;
  if (g > 1) {
#pragma unroll
    for (int i = tid; i < 2 * 64 * 8; i += NTHR) {
      int dir = i >> 9, j = (i >> 3) & 63, c4 = (i & 7) * 4;
      *(float4*)(sCum + dir * 2048 + j * 32 + c4) =
          *(const float4*)(d.lg + (size_t)dir * T_ALL * 128 + (size_t)(row0 + j) * 128 + h * 32 + c4);
    }
  } else if (tid < 128) {
    int dir = tid >> 6, j = tid & 63;
    sCum[tid] = d.lg ? d.lg[(size_t)dir * T_ALL * 4 + (size_t)(row0 + j) * 4 + h] : log1pf(-exp2f(-5.f - (float)h));
  }
  if (tid < 128) {
    int dir = tid >> 6, j = tid & 63;
    sKs[tid] = d.ks ? d.ks[(size_t)dir * T_ALL * 4 + (size_t)(row0 + j) * 4 + h] : 1.f;
  }
  __syncthreads();
  if (g > 1) {
    if (tid < 64) {
      int dir = tid >> 5, kk = tid & 31;
      float* c = sCum + dir * 2048 + kk;
      float run = 0.f;
      if (dir == 0) {
#pragma unroll 8
        for (int j = 0; j < 64; j++) { run += c[j * 32]; c[j * 32] = run; }
      } else {
#pragma unroll 8
        for (int j = 63; j >= 0; j--) { run += c[j * 32]; c[j * 32] = run; }
      }
    }
  } else if (tid < 128) {
    int dir = tid >> 6, lane = tid & 63;
    float v = sCum[tid];
#pragma unroll
    for (int off = 1; off < 64; off <<= 1) {
      float o = dir == 0 ? __shfl_up(v, off, 64) : __shfl_down(v, off, 64);
      bool ok = dir == 0 ? (lane >= off) : (lane + off < 64);
      v += ok ? o : 0.f;
    }
    sCum[tid] = v;
  }
  __syncthreads();
}

DEV void stage_vt(const MixDesc& d, int row0, int h, u16* sVT) {
  OPAQUE_Z;
  const int tid = (threadIdx.x + zz);
  int vcol = d.vc + h * 64;
#pragma unroll
  for (int i = tid; i < 512; i += NTHR) {
    int j = i >> 3, ch = i & 7;
    u32x4 v = *(const u32x4*)(d.v + (size_t)(row0 + j) * d.vld + vcol + ch * 8);
    u16* dst = sVT + (ch * 8) * 72 + j;
    dst[0 * 72] = (u16)(v[0] & 0xffff); dst[1 * 72] = (u16)(v[0] >> 16);
    dst[2 * 72] = (u16)(v[1] & 0xffff); dst[3 * 72] = (u16)(v[1] >> 16);
    dst[4 * 72] = (u16)(v[2] & 0xffff); dst[5 * 72] = (u16)(v[2] >> 16);
    dst[6 * 72] = (u16)(v[3] & 0xffff); dst[7 * 72] = (u16)(v[3] >> 16);
  }
}

__device__ __forceinline__ void ph_scan1(const P& p, char* smem) {
  OPAQUE_Z;
  u16* sKraw = (u16*)smem;
  u16* sVT = (u16*)(smem + 16384);
  u16* sKT = (u16*)(smem + 25600);
  float* sCum = (float*)(smem + 44032);
  float* sKs = (float*)(smem + 60416);
  float* SLOC = (float*)(p.ws + zz + O_SLOC);
  float* DEC = (float*)(p.ws + zz + O_DEC);
  const int tid = (threadIdx.x + zz), lane = tid & 63, wave = tid >> 6, lr = lane & 15, lq = lane >> 4;
  for (int task = (blockIdx.x + zz); task < 3 * 8 * 36 * 4; task += (gridDim.x + zz)) {
    int m = task / 1152; int rem = task - m * 1152; int b = rem / 144; int rem2 = rem - b * 144; int gc = rem2 >> 2, h = rem2 & 3;
    MixDesc d = get_mix(p, m);
    const int dk = d.dk, g = d.g;
    int row0 = chunk_row0(b, gc);
    __syncthreads();
    int kcol = d.kc + (h >> d.hshift) * dk;
    int cpr = dk >> 3;
    {
      u32x4 kr[4];
#pragma unroll
      for (int it = 0; it < 4; it++) {
        int i = tid + it * NTHR;
        kr[it] = (u32x4){0u, 0u, 0u, 0u};
        if (i < 64 * cpr) { int j = i / cpr, ch = i - j * cpr; kr[it] = *(const u32x4*)(d.k + (size_t)(row0 + j) * d.kld + kcol + ch * 8); }
      }
#pragma unroll
      for (int it = 0; it < 4; it++) {
        int i = tid + it * NTHR;
        if (i < 64 * cpr) { int j = i / cpr, ch = i - j * cpr; *(u32x4*)(sKraw + j * dk + ch * 8) = kr[it]; }
      }
    }
    stage_vt(d, row0, h, sVT);
    stage_cum(d, row0, h, sCum, sKs);
#pragma unroll 1
    for (int dir = 0; dir < 2; dir++) {
      const float* cum = sCum + dir * 64 * g;
      const int jl = dir == 0 ? 63 : 0;
      for (int i = tid; i < 64 * cpr; i += NTHR) {
        int j = i & 63, kg = i >> 6;
        float kv[8];
        unpack8(*(const u32x4*)(sKraw + j * dk + kg * 8), kv);
        float ksj = sKs[dir * 64 + j];
        if (g > 1) {
#pragma unroll
          for (int e = 0; e < 8; e++) kv[e] *= ksj * __expf(cum[jl * 32 + kg * 8 + e] - cum[j * 32 + kg * 8 + e]);
        } else {
          float f = ksj * __expf(cum[jl] - cum[j]);
#pragma unroll
          for (int e = 0; e < 8; e++) kv[e] *= f;
        }
#pragma unroll
        for (int e = 0; e < 8; e++) sKT[(kg * 8 + e) * 72 + j] = f2bf(kv[e]);
      }
      __syncthreads();
      size_t seq = (size_t)((b * 4 + h) * 2 + dir) * 36 + gc;
      float* outS = SLOC + d.sloc_off + seq * (size_t)(dk * 64);
      int ntile = (dk >> 4) * 4;
      for (int t = wave; t < ntile; t += 4) {
        int mt = t & 3, nt = t >> 2;
        f32x4 acc = (f32x4){0.f, 0.f, 0.f, 0.f};
#pragma unroll
        for (int ks = 0; ks < 2; ks++) {
          bf16x8 a = *(const bf16x8*)(sVT + (mt * 16 + lr) * 72 + ks * 32 + lq * 8);
          bf16x8 bb = *(const bf16x8*)(sKT + (nt * 16 + lr) * 72 + ks * 32 + lq * 8);
          acc = mfma16(a, bb, acc);
        }
#pragma unroll
        for (int r = 0; r < 4; r++) outS[(mt * 16 + lq * 4 + r) * dk + nt * 16 + lr] = acc[r];
      }
      if (tid < g) DEC[d.dec_off + seq * g + tid] = __expf(cum[jl * g + tid]);
      __syncthreads();
    }
  }
}

__device__ __forceinline__ void ph_scan2(const P& p) {
  OPAQUE_Z;
  const float* SLOC = (const float*)(p.ws + zz + O_SLOC);
  u16* SIN = (u16*)(p.ws + zz + O_SIN);
  const float* DEC = (const float*)(p.ws + zz + O_DEC);
  int gt = (blockIdx.x + zz) * NTHR + (threadIdx.x + zz), gs = (gridDim.x + zz) * NTHR;
  const int NG = 64 * 2048, NS = 64 * 8192;
  for (int i = gt; i < NG + NS + NG; i += gs) {
    int m, rem;
    if (i < NG) { m = 0; rem = i; } else if (i < NG + NS) { m = 1; rem = i - NG; } else { m = 2; rem = i - NG - NS; }
    int dk = m == 1 ? 128 : 32; int g = m == 0 ? 32 : 1;
    size_t so = m == 0 ? SLOC_G : (m == 1 ? SLOC_S : SLOC_R);
    size_t dof = m == 0 ? DEC_G : (m == 1 ? DEC_S : DEC_R);
    int esz = dk * 64;
    int seq = rem / esz, e = rem - seq * esz;
    int dir = seq & 1;
    int kk = e & (dk - 1);
    int gi = g > 1 ? kk : 0;
    float run = 0.f;
#pragma unroll 1
    for (int s0 = 0; s0 < 36; s0 += 12) {
      float loc[12], dd[12]; size_t aa[12];
#pragma unroll
      for (int u = 0; u < 12; u++) {
        int s = s0 + u;
        int gc = dir == 0 ? s : (s < 4 ? 3 - s : 39 - s);
        aa[u] = so + ((size_t)seq * 36 + gc) * esz + e;
        loc[u] = SLOC[aa[u]];
        dd[u] = DEC[dof + ((size_t)seq * 36 + gc) * g + gi];
      }
#pragma unroll
      for (int u = 0; u < 12; u++) { SIN[aa[u]] = f2bf(run); run = dd[u] * run + loc[u]; }
    }
  }
}

__device__ __forceinline__ void ph_scan3(const P& p, int l, int need_ctx, char* smem) {
  OPAQUE_Z;
  const u16* SIN = (const u16*)(p.ws + zz + O_SIN);
  const u16* Pm = (const u16*)(p.ws + zz + O_P);
  const u16* XBC = (const u16*)(p.ws + zz + O_XBC);
  u16* MIX = (u16*)(p.ws + zz + O_MIX);
  float* SSQ = (float*)(p.ws + zz + O_SSQ);
  const int tid = (threadIdx.x + zz), lane = tid & 63, wave = tid >> 6, lr = lane & 15, lq = lane >> 4;
  const int gcn = need_ctx ? 36 : 32, gcb = need_ctx ? 0 : 4;
  const int per_m = 8 * gcn * 4;
  for (int task = (blockIdx.x + zz); task < 3 * per_m; task += (gridDim.x + zz)) {
    int m = task / per_m; int rem = task - m * per_m; int b = rem / (gcn * 4); int rem2 = rem - b * gcn * 4;
    int gc = gcb + (rem2 >> 2), h = rem2 & 3;
    MixDesc d = get_mix(p, m);
    const int dk = d.dk, g = d.g, ldq = dk + 8;
    u16* sQ = (u16*)smem;
    u16* sK = sQ + 64 * ldq;
    u16* sSin = sK + 64 * ldq;
    u16* sVT = sSin + 64 * ldq;
    float* sCum = (float*)(sVT + 64 * 72);
    float* sKs = sCum + 2 * 64 * g;
    u16* sQr = (u16*)(sKs + 128);
    u16* sKr = sQr + 64 * 32;
    u16* sPm = (dk == 128) ? sSin : (sKr + 64 * 32);
    int row0 = chunk_row0(b, gc);
    __syncthreads();
    int qcol = d.qc + (h >> d.hshift) * dk, kcol = d.kc + (h >> d.hshift) * dk;
    int cpr = dk >> 3;
    {
      u32x4 qr[4], kr[4];
#pragma unroll
      for (int it = 0; it < 4; it++) {
        int i = tid + it * NTHR;
        qr[it] = (u32x4){0u, 0u, 0u, 0u}; kr[it] = qr[it];
        if (i < 64 * cpr) {
          int j = i / cpr, ch = i - j * cpr;
          qr[it] = *(const u32x4*)(d.q + (size_t)(row0 + j) * d.qld + qcol + ch * 8);
          kr[it] = *(const u32x4*)(d.k + (size_t)(row0 + j) * d.kld + kcol + ch * 8);
        }
      }
#pragma unroll
      for (int it = 0; it < 4; it++) {
        int i = tid + it * NTHR;
        if (i < 64 * cpr) {
          int j = i / cpr, ch = i - j * cpr;
          if (g > 1) { *(u32x4*)(sQr + j * 32 + ch * 8) = qr[it]; *(u32x4*)(sKr + j * 32 + ch * 8) = kr[it]; }
          else { *(u32x4*)(sQ + j * ldq + ch * 8) = qr[it]; *(u32x4*)(sK + j * ldq + ch * 8) = kr[it]; }
        }
      }
    }
    stage_vt(d, row0, h, sVT);
    stage_cum(d, row0, h, sCum, sKs);
    f32x4 o[4];
#pragma unroll
    for (int i = 0; i < 4; i++) o[i] = (f32x4){0.f, 0.f, 0.f, 0.f};
#pragma unroll 1
    for (int dir = 0; dir < 2; dir++) {
      const float* cum = sCum + dir * 64 * g;
      {
        size_t seq = (size_t)((b * 4 + h) * 2 + dir) * 36 + gc;
        const u16* S = SIN + d.sloc_off + seq * (size_t)(dk * 64);
        u32x4 sr[4];
#pragma unroll
        for (int it = 0; it < 4; it++) {
          int i = tid + it * NTHR;
          sr[it] = (u32x4){0u, 0u, 0u, 0u};
          if (i < 64 * cpr) { int vv = i / cpr, ch = i - vv * cpr; sr[it] = *(const u32x4*)(S + vv * dk + ch * 8); }
        }
#pragma unroll
        for (int it = 0; it < 4; it++) {
          int i = tid + it * NTHR;
          if (i < 64 * cpr) { int vv = i / cpr, ch = i - vv * cpr; *(u32x4*)(sSin + vv * ldq + ch * 8) = sr[it]; }
        }
      }
      if (g > 1) {
        for (int i = tid; i < 64 * 4; i += NTHR) {
          int j = i >> 2, kg = i & 3;
          float qv[8], kv[8];
          unpack8(*(const u32x4*)(sQr + j * 32 + kg * 8), qv);
          unpack8(*(const u32x4*)(sKr + j * 32 + kg * 8), kv);
#pragma unroll
          for (int e = 0; e < 8; e++) {
            float c = cum[j * 32 + kg * 8 + e];
            qv[e] *= d.qscale * __expf(c); kv[e] *= __expf(-c);
          }
          *(u32x4*)(sQ + j * ldq + kg * 8) = pack8(qv);
          *(u32x4*)(sK + j * ldq + kg * 8) = pack8(kv);
        }
      }
      __syncthreads();
      f32x4 s[4], tmp[4];
#pragma unroll
      for (int nt = 0; nt < 4; nt++) { s[nt] = (f32x4){0.f, 0.f, 0.f, 0.f}; tmp[nt] = (f32x4){0.f, 0.f, 0.f, 0.f}; }
#pragma unroll 1
      for (int ks = 0; ks < dk; ks += 32) {
        bf16x8 a = *(const bf16x8*)(sQ + (wave * 16 + lr) * ldq + ks + lq * 8);
#pragma unroll
        for (int nt = 0; nt < 4; nt++) {
          bf16x8 bk = *(const bf16x8*)(sK + (nt * 16 + lr) * ldq + ks + lq * 8);
          s[nt] = mfma16(a, bk, s[nt]);
          bf16x8 bs = *(const bf16x8*)(sSin + (nt * 16 + lr) * ldq + ks + lq * 8);
          tmp[nt] = mfma16(a, bs, tmp[nt]);
        }
      }
      __syncthreads();
      float ci[4];
#pragma unroll
      for (int r = 0; r < 4; r++) ci[r] = (g > 1) ? 0.f : cum[wave * 16 + lq * 4 + r];
#pragma unroll
      for (int nt = 0; nt < 4; nt++) {
        int j = nt * 16 + lr;
        float cj = (g > 1) ? 0.f : cum[j];
        float ksj = sKs[dir * 64 + j];
#pragma unroll
        for (int r = 0; r < 4; r++) {
          int i = wave * 16 + lq * 4 + r;
          bool valid = dir == 0 ? (j <= i) : (j >= i);
          float val = 0.f;
          if (valid) val = (g > 1) ? s[nt][r] : s[nt][r] * ksj * __expf(ci[r] - cj);
          sPm[i * 72 + j] = f2bf(val);
        }
      }
      __syncthreads();
#pragma unroll
      for (int ks = 0; ks < 2; ks++) {
        bf16x8 a = *(const bf16x8*)(sPm + (wave * 16 + lr) * 72 + ks * 32 + lq * 8);
#pragma unroll
        for (int nt = 0; nt < 4; nt++) {
          bf16x8 bb = *(const bf16x8*)(sVT + (nt * 16 + lr) * 72 + ks * 32 + lq * 8);
          o[nt] = mfma16(a, bb, o[nt]);
        }
      }
#pragma unroll
      for (int r = 0; r < 4; r++) {
        float sc = (g > 1) ? 1.f : __expf(ci[r]);
#pragma unroll
        for (int nt = 0; nt < 4; nt++) o[nt][r] += sc * tmp[nt][r];
      }
      __syncthreads();
    }
    float ga[4][4], gb[4][4];
#pragma unroll
    for (int r = 0; r < 4; r++) {
      int row = row0 + wave * 16 + lq * 4 + r;
#pragma unroll
      for (int nt = 0; nt < 4; nt++) {
        int c = h * 64 + nt * 16 + lr;
        if (m == 0) { ga[r][nt] = bf2f(Pm[(size_t)row * LDP + 928 + c]); gb[r][nt] = p.in[16][l * 256 + c]; }
        else if (m == 2) { ga[r][nt] = bf2f(Pm[(size_t)row * LDP + 2760 + c]); gb[r][nt] = 0.f; }
        else { ga[r][nt] = bf2f(XBC[(size_t)row * 768 + c]); gb[r][nt] = bf2f(Pm[(size_t)row * LDP + 1216 + c]); }
      }
    }
#pragma unroll
    for (int r = 0; r < 4; r++) {
      int row = row0 + wave * 16 + lq * 4 + r;
      if (m == 0) {
        float ss = 0.f;
#pragma unroll
        for (int nt = 0; nt < 4; nt++) ss += o[nt][r] * o[nt][r];
        ss = xor16_sum(ss);
        float rinv = rsqrtf(ss * (1.f / 64.f) + 1e-6f);
#pragma unroll
        for (int nt = 0; nt < 4; nt++) {
          int c = h * 64 + nt * 16 + lr;
          MIX[(size_t)row * 1024 + 256 + c] = f2bf(o[nt][r] * rinv * gb[r][nt] * silu_f(ga[r][nt]));
        }
      } else if (m == 2) {
        float sm = 0.f;
#pragma unroll
        for (int nt = 0; nt < 4; nt++) sm += o[nt][r];
        sm = xor16_sum(sm);
        float mean = sm * (1.f / 64.f);
        float ss = 0.f;
#pragma unroll
        for (int nt = 0; nt < 4; nt++) { float dd = o[nt][r] - mean; ss += dd * dd; }
        ss = xor16_sum(ss);
        float rinv = rsqrtf(ss * (1.f / 64.f) + 1e-6f);
#pragma unroll
        for (int nt = 0; nt < 4; nt++) {
          int c = h * 64 + nt * 16 + lr;
          MIX[(size_t)row * 1024 + 768 + c] = f2bf((o[nt][r] - mean) * rinv * silu_f(ga[r][nt]));
        }
      } else {
        float dsk = p.in[23][l * 4 + h];
        float ss = 0.f;
#pragma unroll
        for (int nt = 0; nt < 4; nt++) {
          int c = h * 64 + nt * 16 + lr;
          float y = (o[nt][r] + dsk * ga[r][nt]) * silu_f(gb[r][nt]);
          u16 yb = f2bf(y);
          float yr = bf2f(yb);
          ss += yr * yr;
          MIX[(size_t)row * 1024 + 512 + c] = yb;
        }
        ss = xor16_sum(ss);
        if (lr == 0) SSQ[(size_t)row * 4 + h] = ss;
      }
    }
  }
}

__device__ __forceinline__ void ph_ln1(const P& p, int l, int nrows) {
  OPAQUE_Z;
  float* xc = (float*)(p.ws + zz + O_XCUR);
  u16* xm = (u16*)(p.ws + zz + O_XMOD);
  const float* MOD = (const float*)(p.ws + zz + O_MOD);
  const int lane = (threadIdx.x + zz) & 63;
  int gw = ((blockIdx.x + zz) * NTHR + (threadIdx.x + zz)) >> 6, nw = ((gridDim.x + zz) * NTHR) >> 6;
  const float* g1 = p.in[26] + l * 1024; const float* b1 = p.in[27] + l * 1024;
  f32x4 gg[4], bb[4];
#pragma unroll
  for (int q = 0; q < 4; q++) { gg[q] = *(const f32x4*)(g1 + q * 256 + lane * 4); bb[q] = *(const f32x4*)(b1 + q * 256 + lane * 4); }
  f32x4 cur[4];
#pragma unroll
  for (int q = 0; q < 4; q++) cur[q] = (gw < nrows) ? *(const f32x4*)(xc + (size_t)gw * 1024 + q * 256 + lane * 4) : (f32x4){0.f, 0.f, 0.f, 0.f};
  for (int row = gw; row < nrows; row += nw) {
    float* xr = xc + (size_t)row * 1024;
    const float* m = MOD + (size_t)(l * 9 + modrow_of(row)) * 6144;
    f32x4 nxt[4], sh[4], sc[4];
    const int rown = row + nw;
#pragma unroll
    for (int q = 0; q < 4; q++) {
      nxt[q] = (rown < nrows) ? *(const f32x4*)(xc + (size_t)rown * 1024 + q * 256 + lane * 4) : (f32x4){0.f, 0.f, 0.f, 0.f};
      sh[q] = *(const f32x4*)(m + 3 * 1024 + q * 256 + lane * 4);
      sc[q] = *(const f32x4*)(m + 4 * 1024 + q * 256 + lane * 4);
    }
    float s = 0.f;
#pragma unroll
    for (int q = 0; q < 4; q++) s += (cur[q][0] + cur[q][1]) + (cur[q][2] + cur[q][3]);
    float mean = wave_sum(s) * (1.f / 1024.f);
    float ss = 0.f;
#pragma unroll
    for (int q = 0; q < 4; q++)
#pragma unroll
      for (int e = 0; e < 4; e++) { float dd = cur[q][e] - mean; ss += dd * dd; }
    float rinv = rsqrtf(wave_sum(ss) * (1.f / 1024.f) + 1e-5f);
#pragma unroll
    for (int q = 0; q < 4; q++) {
      int c = q * 256 + lane * 4;
      f32x4 y;
#pragma unroll
      for (int e = 0; e < 4; e++) y[e] = (cur[q][e] - mean) * rinv * gg[q][e] + bb[q][e];
      *(f32x4*)(xr + c) = y;
      uint2 o; o.x = pack2(y[0] * (1.f + sc[q][0]) + sh[q][0], y[1] * (1.f + sc[q][1]) + sh[q][1]);
      o.y = pack2(y[2] * (1.f + sc[q][2]) + sh[q][2], y[3] * (1.f + sc[q][3]) + sh[q][3]);
      *(uint2*)(xm + (size_t)row * 1024 + c) = o;
    }
#pragma unroll
    for (int q = 0; q < 4; q++) cur[q] = nxt[q];
  }
}

#define TOPK_INSERT(v_, id_)                                   \
  {                                                            \
    float vv_ = (v_); int ii_ = (id_);                         \
    _Pragma("unroll") for (int q_ = 0; q_ < 16; q_++) {        \
      bool gt_ = vv_ > tv[q_];                                 \
      float ov_ = tv[q_]; int oi_ = ti[q_];                    \
      tv[q_] = gt_ ? vv_ : ov_; ti[q_] = gt_ ? ii_ : oi_;      \
      vv_ = gt_ ? ov_ : vv_; ii_ = gt_ ? oi_ : ii_;            \
    }                                                          \
  }

DEV u32 mono_key(float v, u32 mask, int tag) {
  u32 u = __float_as_uint(v);
  u32 k = (u & 0x80000000u) ? ~u : (u | 0x80000000u);
  return (k & ~mask) | (u32)tag;
}
DEV float key_value(u32 k, u32 mask) {
  k &= ~mask;
  u32 u = (k & 0x80000000u) ? (k & 0x7fffffffu) : ~k;
  return __uint_as_float(u);
}
#define MONO_KEY(v_, m_, t_) mono_key((v_), (m_), (t_))
#define KEY_VALUE(k_, m_) key_value((k_), (m_))
#define KEY_INSERT(k_)                                         \
  {                                                            \
    u32 kk_ = (k_);                                            \
    _Pragma("unroll") for (int q_ = 0; q_ < 16; q_++) {        \
      u32 hi_ = max(tk[q_], kk_);                              \
      kk_ = min(tk[q_], kk_);                                  \
      tk[q_] = hi_;                                            \
    }                                                          \
  }
typedef float f32x2 __attribute__((ext_vector_type(2)));
#define DOT8(acc_, w_, x0_, x1_, x2_, x3_)                                          \
  {                                                                                 \
    f32x2 lo_ = __builtin_amdgcn_cvt_pk_f32_fp8((int)(w_), false);                  \
    f32x2 hi_ = __builtin_amdgcn_cvt_pk_f32_fp8((int)(w_), true);                   \
    acc_ += x0_ * lo_[0]; acc_ += x1_ * lo_[1]; acc_ += x2_ * hi_[0]; acc_ += x3_ * hi_[1]; \
  }
#define AXPY8(a_, w_, f0_, f1_, f2_, f3_)                                           \
  {                                                                                 \
    f32x2 lo_ = __builtin_amdgcn_cvt_pk_f32_fp8((int)(w_), false);                  \
    f32x2 hi_ = __builtin_amdgcn_cvt_pk_f32_fp8((int)(w_), true);                   \
    f0_ += a_ * lo_[0]; f1_ += a_ * lo_[1]; f2_ += a_ * hi_[0]; f3_ += a_ * hi_[1]; \
  }
#define PEER_LOAD(U_, V_, G_, SU_, SV_, e0_)                                        \
  _Pragma("unroll") for (int q_ = 0; q_ < 4; q_++) {                                \
    int e_ = sE[tok * 128 + (e0_) + q_];                                            \
    G_[q_] = sG[tok * 128 + (e0_) + q_];                                            \
    SU_[q_] = sSU[tok * 128 + (e0_) + q_];                                          \
    SV_[q_] = sSV[tok * 128 + (e0_) + q_];                                          \
    U_[q_] = *(const u32x4*)(UB + (size_t)e_ * 1024 + lane * 16);                   \
    V_[q_] = *(const u32x4*)(VB + (size_t)e_ * 1024 + lane * 16);                   \
  }
#define PEER_COMPUTE(U_, V_, G_, SU_, SV_)                                          \
  _Pragma("unroll") for (int q_ = 0; q_ < 4; q_++) {                                \
    float d_ = 0.f;                                                                 \
    DOT8(d_, U_[q_][0], xv[0], xv[1], xv[2], xv[3]);                                \
    DOT8(d_, U_[q_][1], xv[4], xv[5], xv[6], xv[7]);                                \
    DOT8(d_, U_[q_][2], xv[8], xv[9], xv[10], xv[11]);                              \
    DOT8(d_, U_[q_][3], xv[12], xv[13], xv[14], xv[15]);                            \
    d_ = wave_sum(d_) * SU_[q_];                                                    \
    float act_ = 0.5f * d_ * (1.f + erff(d_ * 0.7071067811865476f)) * G_[q_] * SV_[q_]; \
    AXPY8(act_, V_[q_][0], f[0], f[1], f[2], f[3]);                                 \
    AXPY8(act_, V_[q_][1], f[4], f[5], f[6], f[7]);                                 \
    AXPY8(act_, V_[q_][2], f[8], f[9], f[10], f[11]);                               \
    AXPY8(act_, V_[q_][3], f[12], f[13], f[14], f[15]);                             \
  }

__device__ __forceinline__ void ph_peer(const P& p, int l, int nrows, char* smem, int dryc) {
  OPAQUE_Z;
  const int dry = zz + dryc;
  const u16* SC = (const u16*)(p.ws + zz + O_P);
  float* xc = (float*)(p.ws + zz + O_XCUR);
  u16* xm = (u16*)(p.ws + zz + O_XMOD);
  const float* MOD = (const float*)(p.ws + zz + O_MOD);
  const unsigned char* UB = (const unsigned char*)(p.ws + zz + O_UBF) + (size_t)l * 16384 * 1024;
  const unsigned char* VB = (const unsigned char*)(p.ws + zz + O_VBF) + (size_t)l * 16384 * 1024;
  const float* USC = (const float*)(p.ws + zz + O_USC) + l * 16384;
  const float* VSC = (const float*)(p.ws + zz + O_VSC) + l * 16384;
  float* sLV = (float*)smem;
  int* sLI = (int*)(smem + 16384);
  int* sE = (int*)(smem + 32768);
  float* sG = (float*)(smem + 40960);
  float* sSU = (float*)(smem + 49152);
  float* sSV = (float*)(smem + 57344);
  const int tid = (threadIdx.x + zz), lane = tid & 63, wave = tid >> 6;
  const float* g2 = p.in[32] + l * 1024; const float* b2 = p.in[33] + l * 1024;
  const int ntok = (nrows == T_ALL) ? 12 : 16;
  const int ngroups = nrows / ntok;
  for (int grp = (blockIdx.x + zz); grp < ngroups; grp += (gridDim.x + zz)) {
    int rowb = grp * ntok;
    __syncthreads();
    if (tid < ntok * 16) {
      int tok = tid >> 4, lst = tid & 15;
      const u32x4* s4 = (const u32x4*)(SC + (size_t)(rowb + tok) * 2048 + lst * 128);
      u32 tk[16];
#pragma unroll
      for (int q = 0; q < 16; q++) tk[q] = 0u;
      u32x4 cur[4], nxt[4];
#pragma unroll
      for (int q = 0; q < 4; q++) { cur[q] = s4[q]; nxt[q] = cur[q]; }
#pragma unroll 1
      for (int c0 = 0; c0 < 16; c0 += 4) {
        if (c0 + 4 < 16) {
#pragma unroll
          for (int q = 0; q < 4; q++) nxt[q] = s4[c0 + 4 + q];
        }
#pragma unroll
        for (int q = 0; q < 4; q++) {
          const int c = c0 + q;
          const u32x4 sv = cur[q];
#pragma unroll
          for (int e = 0; e < 4; e++) {
            KEY_INSERT(MONO_KEY(lo2f(sv[e]), 127u, 127 - (c * 8 + e * 2 + 0)));
            KEY_INSERT(MONO_KEY(hi2f(sv[e]), 127u, 127 - (c * 8 + e * 2 + 1)));
          }
        }
#pragma unroll
        for (int q = 0; q < 4; q++) cur[q] = nxt[q];
      }
#pragma unroll
      for (int q = 0; q < 16; q++) { sLV[tid * 16 + q] = KEY_VALUE(tk[q], 127u); sLI[tid * 16 + q] = 127 - (int)(tk[q] & 127u); }
    }
    __syncthreads();
    if (tid < ntok * 8) {
      int tok = tid >> 3, h = tid & 7;
      const float* v1 = sLV + (tok * 16 + h * 2) * 16; const float* v2 = v1 + 16;
      const int* i1 = sLI + (tok * 16 + h * 2) * 16; const int* i2 = i1 + 16;
      float a1[16], a2[16];
#pragma unroll
      for (int q = 0; q < 16; q++) { a1[q] = v1[q]; a2[q] = v2[q]; }
      u32 tk[16];
#pragma unroll
      for (int q = 0; q < 16; q++) tk[q] = 0u;
#pragma unroll
      for (int a = 0; a < 16; a++) {
#pragma unroll
        for (int bq = 0; bq < 16; bq++) {
          if ((a + 1) * (bq + 1) <= 16) { KEY_INSERT(MONO_KEY(a1[a] + a2[bq], 255u, 255 - (a * 16 + bq))); }
        }
      }
      float mx = KEY_VALUE(tk[0], 255u); float sum = 0.f; float ex[16];
#pragma unroll
      for (int q = 0; q < 16; q++) { ex[q] = __expf(KEY_VALUE(tk[q], 255u) - mx); sum += ex[q]; }
      float inv = 1.f / sum;
#pragma unroll
      for (int q = 0; q < 16; q++) {
        int ci = 255 - (int)(tk[q] & 255u);
        int e = i1[ci >> 4] * 128 + i2[ci & 15];
        sE[tok * 128 + h * 16 + q] = e;
        sG[tok * 128 + h * 16 + q] = ex[q] * inv;
        sSU[tok * 128 + h * 16 + q] = USC[e];
        sSV[tok * 128 + h * 16 + q] = VSC[e];
      }
    }
    __syncthreads();
    int* sE2 = (int*)smem;
    float* sGV2 = (float*)(smem + 8192);
    float* sSU2 = (float*)(smem + 16384);
    int* sCnt = (int*)(smem + 24576);
    {
#pragma unroll 1
      for (int i = tid; i < ntok * 128; i += NTHR) {
        int key = sE[i] >> 11;
#pragma unroll
        for (int sl = 0; sl < 8; sl++) {
          unsigned long long mk = __ballot(key == sl);
          if (lane == sl) sCnt[(i >> 6) * 8 + sl] = __popcll(mk);
        }
      }
      __syncthreads();
#pragma unroll 1
      for (int i = tid; i < ntok * 128; i += NTHR) {
        int tok = i >> 7, half = (i >> 6) & 1;
        int e = sE[i]; int key = e >> 11;
        int within = 0;
#pragma unroll
        for (int sl = 0; sl < 8; sl++) {
          unsigned long long mk = __ballot(key == sl);
          if (key == sl) within = __popcll(mk & ((1ull << lane) - 1ull));
        }
        const int* c0 = sCnt + tok * 16; const int* c1 = c0 + 8;
        int base = half ? c0[key] : 0;
#pragma unroll
        for (int sl = 0; sl < 8; sl++) base += (sl < key) ? (c0[sl] + c1[sl]) : 0;
        int dst = tok * 128 + base + within;
        sE2[dst] = e; sGV2[dst] = sG[i] * sSV[i]; sSU2[dst] = sSU[i];
      }
    }
    __syncthreads();
    {
      const int n = ntok >> 2;
      unsigned char* sX8 = (unsigned char*)(smem + 32768);
      const int lr = lane & 15, lq = lane >> 4;
      int vz; asm volatile("v_mov_b32 %0, 0" : "=v"(vz));
      float* sQinv = (float*)(smem + 24576 + 1024);
#pragma unroll 1
      for (int tk = 0; tk < n; tk++) {
        int row = rowb + wave * n + tk;
        float xv[16];
        u32x4 a = *(const u32x4*)(xm + (size_t)row * 1024 + lane * 16);
        u32x4 bq = *(const u32x4*)(xm + (size_t)row * 1024 + lane * 16 + 8);
        unpack8(a, xv); unpack8(bq, xv + 8);
        float am = 0.f;
#pragma unroll
        for (int i = 0; i < 16; i++) am = fmaxf(am, fabsf(xv[i]));
        am = fmaxf(am, __shfl_xor(am, 1, 64)); am = fmaxf(am, __shfl_xor(am, 2, 64)); am = fmaxf(am, __shfl_xor(am, 4, 64));
        am = fmaxf(am, __shfl_xor(am, 8, 64)); am = fmaxf(am, __shfl_xor(am, 16, 64)); am = fmaxf(am, __shfl_xor(am, 32, 64));
        float qs = am > 0.f ? 240.f / am : 1.f;
        if (lane == 0) sQinv[wave * 4 + tk] = am > 0.f ? am * (1.f / 240.f) : 1.f;
        u32x4 x8; int w;
#pragma unroll
        for (int i = 0; i < 4; i++) {
          w = 0;
          w = __builtin_amdgcn_cvt_pk_fp8_f32(xv[i * 4 + 0] * qs, xv[i * 4 + 1] * qs, w, false);
          w = __builtin_amdgcn_cvt_pk_fp8_f32(xv[i * 4 + 2] * qs, xv[i * 4 + 3] * qs, w, true);
          x8[i] = (u32)w;
        }
        *(u32x4*)(sX8 + (wave * 4 + tk) * 1024 + lane * 16) = x8;
      }
#define PEER_ACCV(V_, q0_)                                                            \
  _Pragma("unroll") for (int q_ = 0; q_ < 8; q_++) {                                  \
    float a_ = sGV2[nb + (q0_) + q_ + vz];                                            \
    f32x2 a2_ = (f32x2){a_, a_};                                                      \
    _Pragma("unroll") for (int i_ = 0; i_ < 4; i_++) {                                \
      f32x2 lo_ = __builtin_amdgcn_cvt_pk_f32_fp8((int)V_[q_][i_], false);            \
      f32x2 hi_ = __builtin_amdgcn_cvt_pk_f32_fp8((int)V_[q_][i_], true);             \
      f2[j][i_ * 2] += lo_ * a2_; f2[j][i_ * 2 + 1] += hi_ * a2_;                     \
    }                                                                                 \
  }
      {
        const int nit = 8 * n;
        u32x4 bA[16], bB[16];
#define PEER_ULOAD(B_, it_)                                                                   \
  {                                                                                           \
    const int c_ = (it_) / n, tk_ = (it_) - c_ * n;                                           \
    const int nb_ = (wave * n + tk_) * 128 + c_ * 16;                                         \
    const unsigned ub_ = (unsigned)sE2[nb_ + lr] * 1024u + (unsigned)(lq * 16);               \
    _Pragma("unroll") for (int kc_ = 0; kc_ < 16; kc_++) B_[kc_] = *(const u32x4*)(UB + (ub_ + (unsigned)(kc_ * 64))); \
  }
#define PEER_UCOMP(B_, it_)                                                                   \
  {                                                                                           \
    const int c_ = (it_) / n, tk_ = (it_) - c_ * n;                                           \
    const int nb_ = (wave * n + tk_) * 128 + c_ * 16;                                         \
    f32x4 acc_ = (f32x4){0.f, 0.f, 0.f, 0.f};                                                 \
    const unsigned char* xa_ = sX8 + (wave * 4 + tk_) * 1024 + lq * 16;                       \
    _Pragma("unroll") for (int kc_ = 0; kc_ < 16; kc_++) {                                    \
      u32x4 a_ = *(const u32x4*)(xa_ + kc_ * 64);                                             \
      long alo_ = (long)(((unsigned long)a_[1] << 32) | (unsigned long)a_[0]);                \
      long ahi_ = (long)(((unsigned long)a_[3] << 32) | (unsigned long)a_[2]);                \
      long blo_ = (long)(((unsigned long)B_[kc_][1] << 32) | (unsigned long)B_[kc_][0]);      \
      long bhi_ = (long)(((unsigned long)B_[kc_][3] << 32) | (unsigned long)B_[kc_][2]);      \
      acc_ = __builtin_amdgcn_mfma_f32_16x16x32_fp8_fp8(alo_, blo_, acc_, 0, 0, 0);           \
      acc_ = __builtin_amdgcn_mfma_f32_16x16x32_fp8_fp8(ahi_, bhi_, acc_, 0, 0, 0);           \
    }                                                                                         \
    float d_ = acc_[0] * sQinv[wave * 4 + tk_] * sSU2[nb_ + lr];                              \
    float act_ = 0.5f * d_ * (1.f + erff(d_ * 0.7071067811865476f)) * sGV2[nb_ + lr];         \
    if (lq == 0) sGV2[nb_ + lr] = act_;                                                       \
  }
        PEER_ULOAD(bA, 0);
#pragma unroll 1
        for (int it = 0; it < nit; it += 2) {
          PEER_ULOAD(bB, it + 1);
          PEER_UCOMP(bA, it);
          if (it + 2 < nit) { PEER_ULOAD(bA, it + 2); }
          PEER_UCOMP(bB, it + 1);
        }
      }
#pragma unroll 1
      for (int t0 = 0; t0 < n; t0 += 2) {
        f32x2 f2[2][8];
#pragma unroll
        for (int j = 0; j < 2; j++)
#pragma unroll
          for (int i = 0; i < 8; i++) f2[j][i] = (f32x2){0.f, 0.f};
        {
          u32x4 vA[8], vB[8];
#define PEER_VLOAD(V_, c_, j_, h_)                                                            \
  if (t0 + (j_) < n) {                                                                        \
    const int nb_ = (wave * n + t0 + (j_)) * 128 + (c_) * 16 + (h_) * 8;                      \
    _Pragma("unroll") for (int q_ = 0; q_ < 8; q_++) {                                        \
      unsigned e_ = (unsigned)sE2[nb_ + q_ + vz];                                             \
      V_[q_] = *(const u32x4*)(VB + (e_ * 1024u + (unsigned)(lane * 16)));                    \
    }                                                                                         \
  }
#define PEER_VCOMP(V_, c_, j_, h_)                                                            \
  if (t0 + (j_) < n) {                                                                        \
    const int nb_ = (wave * n + t0 + (j_)) * 128 + (c_) * 16 + (h_) * 8;                      \
    _Pragma("unroll") for (int q_ = 0; q_ < 8; q_++) {                                        \
      float a_ = sGV2[nb_ + q_ + vz];                                                         \
      f32x2 a2_ = (f32x2){a_, a_};                                                            \
      _Pragma("unroll") for (int i_ = 0; i_ < 4; i_++) {                                      \
        f32x2 lo_ = __builtin_amdgcn_cvt_pk_f32_fp8((int)V_[q_][i_], false);                  \
        f32x2 hi_ = __builtin_amdgcn_cvt_pk_f32_fp8((int)V_[q_][i_], true);                   \
        f2[j_][i_ * 2] += lo_ * a2_; f2[j_][i_ * 2 + 1] += hi_ * a2_;                         \
      }                                                                                       \
    }                                                                                         \
  }
          PEER_VLOAD(vA, 0, 0, 0);
#pragma unroll 1
          for (int c = 0; c < 8; c++) {
            PEER_VLOAD(vB, c, 0, 1);
            PEER_VCOMP(vA, c, 0, 0);
            PEER_VLOAD(vA, c, 1, 0);
            PEER_VCOMP(vB, c, 0, 1);
            PEER_VLOAD(vB, c, 1, 1);
            PEER_VCOMP(vA, c, 1, 0);
            if (c + 1 < 8) { PEER_VLOAD(vA, c + 1, 0, 0); }
            PEER_VCOMP(vB, c, 1, 1);
          }
        }
#pragma unroll
        for (int j = 0; j < 2; j++) {
          const int tk = t0 + j;
          if (tk < n) {
            int row = rowb + wave * n + tk;
            float f[16];
#pragma unroll
            for (int i = 0; i < 8; i++) { f[2 * i] = f2[j][i][0]; f[2 * i + 1] = f2[j][i][1]; }
          const float* m = MOD + (size_t)(l * 9 + modrow_of(row)) * 6144;
          float tt[16];
          float* xr = xc + (size_t)row * 1024;
#pragma unroll
          for (int q = 0; q < 4; q++) {
            int c = lane * 16 + q * 4;
            float4 x4 = *(const float4*)(xr + c); float4 g5 = *(const float4*)(m + 5 * 1024 + c);
            tt[q * 4 + 0] = ALPHA * x4.x + g5.x * f[q * 4 + 0];
            tt[q * 4 + 1] = ALPHA * x4.y + g5.y * f[q * 4 + 1];
            tt[q * 4 + 2] = ALPHA * x4.z + g5.z * f[q * 4 + 2];
            tt[q * 4 + 3] = ALPHA * x4.w + g5.w * f[q * 4 + 3];
          }
          float sm = 0.f;
#pragma unroll
          for (int i = 0; i < 16; i++) sm += tt[i];
          float mean = wave_sum(sm) * (1.f / 1024.f);
          float ss = 0.f;
#pragma unroll
          for (int i = 0; i < 16; i++) { float dd = tt[i] - mean; ss += dd * dd; }
          float rinv = rsqrtf(wave_sum(ss) * (1.f / 1024.f) + 1e-5f);
          const float* mn = MOD + (size_t)((l + 1 < 4 ? l + 1 : 3) * 9 + modrow_of(row)) * 6144;
          f32x4 gg4[4], bb4[4], sh4[4], sc4[4];
#pragma unroll
          for (int q = 0; q < 4; q++) {
            int c = lane * 16 + q * 4;
            gg4[q] = *(const f32x4*)(g2 + c); bb4[q] = *(const f32x4*)(b2 + c);
            sh4[q] = *(const f32x4*)(mn + c); sc4[q] = *(const f32x4*)(mn + 1024 + c);
          }
#pragma unroll
          for (int q = 0; q < 4; q++) {
            int c = lane * 16 + q * 4;
            float4 y;
            y.x = (tt[q * 4 + 0] - mean) * rinv * gg4[q][0] + bb4[q][0];
            y.y = (tt[q * 4 + 1] - mean) * rinv * gg4[q][1] + bb4[q][1];
            y.z = (tt[q * 4 + 2] - mean) * rinv * gg4[q][2] + bb4[q][2];
            y.w = (tt[q * 4 + 3] - mean) * rinv * gg4[q][3] + bb4[q][3];
            if (dry) {
            } else if (l == 3) {
              *(float4*)(p.out + (size_t)row * 1024 + c) = y;
            } else {
              *(float4*)(xr + c) = y;
              uint2 o; o.x = pack2(y.x * (1.f + sc4[q][0]) + sh4[q][0], y.y * (1.f + sc4[q][1]) + sh4[q][1]);
              o.y = pack2(y.z * (1.f + sc4[q][2]) + sh4[q][2], y.w * (1.f + sc4[q][3]) + sh4[q][3]);
              *(uint2*)(xm + (size_t)row * 1024 + c) = o;
            }
          }
          }
        }
      }
    }
  }
}

#define XB_TMO      128
#define XB_XCNT(j)  (256  + 64 * (j))
#define XB_XSUB(j)  (1280 + 64 * (j))
#define XB_XGEN(j)  (2304 + 64 * (j))
#define XB_TOP      3328
#define XB_TOPGEN   3392
#define XCD_BAR_WORDS 3456
#define XB_SPIN_CAP (1u << 20)
DEV unsigned xb_ld(unsigned* p) { return __hip_atomic_load(p, __ATOMIC_RELAXED, __HIP_MEMORY_SCOPE_AGENT); }
DEV unsigned xb_add(unsigned* p, unsigned v) { return __hip_atomic_fetch_add(p, v, __ATOMIC_RELAXED, __HIP_MEMORY_SCOPE_AGENT); }
DEV unsigned xb_xcc_id() { return (unsigned)__builtin_amdgcn_s_getreg((3 << 11) | 20) & 0xFu; }
#define XB_SPIN(cond, bar) do { unsigned _sp = 0; while (cond) { __builtin_amdgcn_s_sleep(1); \
    if ((++_sp & 255u) == 0u) { if (xb_ld(&(bar)[XB_TMO])) break; if (_sp > XB_SPIN_CAP) { atomicAdd(&(bar)[XB_TMO], 1u); break; } } } } while (0)
struct XcdBarrier { unsigned* bar; unsigned x; unsigned nloc, nx; };
DEV XcdBarrier xcd_barrier_post(unsigned* bar) {
  XcdBarrier b; b.bar = bar; b.x = xb_xcc_id(); b.nloc = 0u; b.nx = 0u;
  if (threadIdx.x == 0) (void)xb_add(&bar[XB_XCNT(b.x)], 1u);
  return b;
}
DEV void xcd_barrier_complete(unsigned* bar, unsigned x, unsigned& nloc, unsigned& nx) {
  const unsigned G = gridDim.x;
  unsigned sum, cnt, mine, sp = 0u;
  for (;;) {
    sum = 0u; cnt = 0u; mine = 0u;
#pragma unroll
    for (unsigned j = 0; j < 16; ++j) { const unsigned c = xb_ld(&bar[XB_XCNT(j)]); sum += c; cnt += (c > 0u) ? 1u : 0u; mine = (j == x) ? c : mine; }
    if (sum == G) break;
    __builtin_amdgcn_s_sleep(1);
    if ((++sp & 255u) == 0u) { if (xb_ld(&bar[XB_TMO])) break; if (sp > XB_SPIN_CAP) { atomicAdd(&bar[XB_TMO], 1u); break; } }
  }
  nloc = mine > 0u ? mine : 1u; nx = cnt > 0u ? cnt : 1u;
}
DEV void xcd_barrier(XcdBarrier& b) {
  asm volatile("s_waitcnt vmcnt(0)" ::: "memory");
  __syncthreads();
  if (threadIdx.x == 0) {
    unsigned* bar = b.bar;
    __builtin_amdgcn_s_waitcnt(0);
    unsigned nloc = b.nloc, nx = b.nx;
    if (nloc == 0u) { xcd_barrier_complete(bar, b.x, nloc, nx); b.nloc = nloc; b.nx = nx; }
    const unsigned old = xb_add(&bar[XB_XSUB(b.x)], 1u);
    const unsigned gen = old / nloc;
    if (old + 1u == (gen + 1u) * nloc) {
      __builtin_amdgcn_fence(__ATOMIC_RELEASE, "agent");
      asm volatile("s_waitcnt vmcnt(0)" ::: "memory");
      const unsigned og = xb_add(&bar[XB_TOP], 1u);
      const unsigned tg = og / nx;
      if (og + 1u == (tg + 1u) * nx) xb_add(&bar[XB_TOPGEN], 1u);
      else XB_SPIN(xb_ld(&bar[XB_TOPGEN]) == tg, bar);
      __builtin_amdgcn_fence(__ATOMIC_ACQUIRE, "agent");
      xb_add(&bar[XB_XGEN(b.x)], 1u);
      asm volatile("s_waitcnt vmcnt(0)" ::: "memory");
    } else {
      XB_SPIN(xb_ld(&bar[XB_XGEN(b.x)]) == gen, bar);
      __builtin_amdgcn_fence(__ATOMIC_ACQUIRE, "agent");
      asm volatile("s_waitcnt vmcnt(0)" ::: "memory");
    }
  }
  __syncthreads();
}

#define KARGP(z_) ((const P*)(const void*)((const __attribute__((address_space(4))) char*)__builtin_amdgcn_kernarg_segment_ptr() + (z_)))
__global__ void __launch_bounds__(NTHR, 2) mega(P p) {
  cg::grid_group grid = cg::this_grid();
  __shared__ __attribute__((aligned(16))) char smem[65536];
  if (blockIdx.x == 0) { unsigned* bw = (unsigned*)(p.ws + O_BAR); for (int i = threadIdx.x; i < 3456; i += NTHR) bw[i] = 0u; }
  {
    OPAQUE_Z; const P& q = *KARGP(zz);
    ph_mod(q, smem);
    ph_convert(q, smem);
  }
  grid.sync();
  XcdBarrier xb = xcd_barrier_post((unsigned*)(p.ws + O_BAR));
#pragma unroll 1
  for (int st = -1; st < 40; st++) {
    const int l = st < 0 ? 0 : st / 10;
    const int ph = st < 0 ? -1 : st - l * 10;
    const int need_ctx = l < 3;
    const int nrows = need_ctx ? T_ALL : T_LAT;
    switch (ph) {
      case -1: {
        OPAQUE_Z; const P& q = *KARGP(zz);
        ph_fold(q, smem);
        ph_xinit(q);
        break;
      }
      case 0: {
        OPAQUE_Z; const P& q = *KARGP(zz);
        gemm_phase<EPI_BF16>(q, l, (const u16*)(q.ws + O_XMOD), 1024, (const u16*)(q.ws + O_WINT) + (size_t)l * 3072 * 1024, 1024, 1024,
                             T_ALL / 128, 24, (void*)(q.ws + O_P), LDP, smem);
        break;
      }
      case 1: {
        OPAQUE_Z; const P& q = *KARGP(zz);
        gemm_phase<EPI_Q>(q, l, (const u16*)(q.ws + O_P), LDP, (const u16*)(q.ws + O_WUQT) + (size_t)l * 384 * 256, 256, 256,
                          T_ALL / 128, 3, nullptr, 0, smem);
        gemm_phase<EPI_KV>(q, l, (const u16*)(q.ws + O_P) + 256, LDP, (const u16*)(q.ws + O_WUKVT) + (size_t)l * 512 * 128, 128, 128,
                           T_ALL / 128, 4, nullptr, 0, smem);
        ph_prep(q, l, smem);
        break;
      }
      case 2: {
        OPAQUE_Z; const P& q = *KARGP(zz);
        ph_scan1(q, smem);
        break;
      }
      case 3: {
        OPAQUE_Z; const P& q = *KARGP(zz);
        ph_scan2(q);
        ph_attn(q, need_ctx, smem);
        break;
      }
      case 4: {
        OPAQUE_Z; const P& q = *KARGP(zz);
        ph_scan3(q, l, need_ctx, smem);
        break;
      }
      case 5: {
        OPAQUE_Z; const P& q = *KARGP(zz);
        gemm_phase<EPI_OUT>(q, l, (const u16*)(q.ws + O_MIX), 1024, (const u16*)(q.ws + O_WOUTT) + (size_t)l * 1024 * 1024, 1024, 1024,
                            nrows / 128, 8, nullptr, 0, smem);
        break;
      }
      case 6: {
        OPAQUE_Z; const P& q = *KARGP(zz);
        ph_ln1(q, l, nrows);
        break;
      }
      case 7: {
        OPAQUE_Z; const P& q = *KARGP(zz);
        gemm_phase<EPI_BF16>(q, l, (const u16*)(q.ws + O_XMOD), 1024, (const u16*)(q.ws + O_WPT) + (size_t)l * 2048 * 1024, 1024, 1024,
                             nrows / 128, 16, (void*)(q.ws + O_P), 2048, smem);
        break;
      }
      case 8: {
        OPAQUE_Z; const P& q = *KARGP(zz);
        ph_peer(q, l, nrows, smem, 0);
        break;
      }
      default:
        break;
    }
    if (ph != 9) xcd_barrier(xb);
  }
}

extern "C" void kernel_launch(void* const* d_in, const int* in_sizes, int n_in, void* d_out, int out_size, void* d_ws,
                              size_t ws_size, hipStream_t stream) {
  static int grid_blocks = 0;
  if (!grid_blocks) {
    int dev = 0, cus = 0, per_cu = 0;
    (void)hipGetDevice(&dev);
    (void)hipDeviceGetAttribute(&cus, hipDeviceAttributeMultiprocessorCount, dev);
    (void)hipOccupancyMaxActiveBlocksPerMultiprocessor(&per_cu, mega, NTHR, 0);
    if (per_cu > 2) per_cu = 2;
    if (per_cu < 1) per_cu = 1;
    grid_blocks = cus * per_cu;
  }
  if (ws_size < WS_TOTAL) { fprintf(stderr, "workspace too small: %zu < %zu\n", ws_size, (size_t)WS_TOTAL); return; }
  P p{};
  for (int i = 0; i < 34; i++) p.in[i] = (const float*)d_in[i];
  p.out = (float*)d_out;
  p.ws = (char*)d_ws;
  void* args[] = {&p};
  hipError_t e = hipLaunchCooperativeKernel((void*)mega, dim3(grid_blocks), dim3(NTHR), args, 0, stream);
  if (e != hipSuccess) fprintf(stderr, "cooperative launch failed: %s (grid %d)\n", hipGetErrorString(e), grid_blocks);
}
```

```cpp
#include <hip/hip_runtime.h>
#include <hip/hip_cooperative_groups.h>
#include <cstdio>
namespace cg = cooperative_groups;

#define DEV __device__ __forceinline__
typedef unsigned short u16;
typedef unsigned int u32;
typedef short bf16x8 __attribute__((ext_vector_type(8)));
typedef float f32x4 __attribute__((ext_vector_type(4)));
typedef unsigned int u32x4 __attribute__((ext_vector_type(4)));

#define T_ALL 18432
#define T_LAT 16384
#define LDP 3072
#define ALPHA 1.681792830507429f
#define NTHR 256
#ifndef PROBE_REP
#define PROBE_REP 0
#endif

constexpr size_t al(size_t x) { return (x + 255) & ~(size_t)255; }
constexpr size_t O_MOD = 0;
constexpr size_t O_AXC = al(O_MOD + 4ull * 9 * 6144 * 4);
constexpr size_t O_AXS = al(O_AXC + 64 * 8 * 4);
constexpr size_t O_RC = al(O_AXS + 64 * 8 * 4);
constexpr size_t O_RS = al(O_RC + 2048 * 16 * 4);
constexpr size_t O_WINT = al(O_RS + 2048 * 16 * 4);
constexpr size_t O_WUQT = al(O_WINT + 4ull * 3072 * 1024 * 2);
constexpr size_t O_WUKVT = al(O_WUQT + 4ull * 384 * 256 * 2);
constexpr size_t O_WOUTT = al(O_WUKVT + 4ull * 512 * 128 * 2);
constexpr size_t O_WQBF = al(O_WOUTT + 4ull * 1024 * 1024 * 2);
constexpr size_t O_KEYBF = al(O_WQBF + 4ull * 1024 * 2048 * 2);
constexpr size_t O_WPT = al(O_KEYBF + 4ull * 2 * 128 * 128 * 2);
constexpr size_t O_UBF = al(O_WPT + 4ull * 2048 * 1024 * 2);
constexpr size_t O_VBF = al(O_UBF + 4ull * 16384 * 1024);
constexpr size_t O_USC = al(O_VBF + 4ull * 16384 * 1024);
constexpr size_t O_VSC = al(O_USC + 4ull * 16384 * 4);
constexpr size_t O_XCUR = al(O_VSC + 4ull * 16384 * 4);
constexpr size_t O_XMOD = al(O_XCUR + (size_t)T_ALL * 1024 * 4);
constexpr size_t O_MIX = al(O_XMOD + (size_t)T_ALL * 1024 * 2);
constexpr size_t O_P = al(O_MIX + (size_t)T_ALL * 1024 * 2);
constexpr size_t O_QB = al(O_P + (size_t)T_ALL * 2048 * 4);
constexpr size_t O_KN = al(O_QB + (size_t)T_ALL * 384 * 2);
constexpr size_t O_VT = al(O_KN + (size_t)T_ALL * 256 * 2);
constexpr size_t O_KR = al(O_VT + 8ull * 4 * 64 * 2304 * 2);
constexpr size_t O_LGG = al(O_KR + (size_t)T_ALL * 32 * 2);
constexpr size_t O_XBC = al(O_LGG + 2ull * T_ALL * 128 * 4);
constexpr size_t O_DT = al(O_XBC + (size_t)T_ALL * 768 * 2);
constexpr size_t O_LA = al(O_DT + 2ull * T_ALL * 4 * 4);
constexpr size_t O_QKR = al(O_LA + 2ull * T_ALL * 4 * 4);
constexpr size_t O_SLOC = al(O_QKR + (size_t)T_ALL * 256 * 2);
constexpr size_t SLOC_G = 0, SLOC_S = 2304ull * 2048, SLOC_R = SLOC_S + 2304ull * 8192;
constexpr size_t O_DEC = al(O_SLOC + (SLOC_R + 2304ull * 2048) * 4);
constexpr size_t DEC_G = 0, DEC_S = 2304 * 32, DEC_R = DEC_S + 2304;
constexpr size_t O_SIN = al(O_DEC + (DEC_R + 2304) * 4);
constexpr size_t O_SSQ = al(O_SIN + (SLOC_R + 2304ull * 2048) * 2);
constexpr size_t O_BAR = al(O_SSQ + (size_t)T_ALL * 4 * 4);
constexpr size_t WS_TOTAL = al(O_BAR + 3456 * 4);

struct P {
  const float* in[34];
  float* out;
  char* ws;
};

DEV u16 f2bf_sw(float f) { u32 u = __float_as_uint(f); u += 0x7fffu + ((u >> 16) & 1u); return (u16)(u >> 16); }
DEV float bf2f(u16 h) { return __uint_as_float(((u32)h) << 16); }
typedef float f32x2_t __attribute__((ext_vector_type(2)));
typedef __bf16 bf16x2_t __attribute__((ext_vector_type(2)));
DEV u32 pack2(float a, float b) {
  f32x2_t v = {a, b};
  bf16x2_t r = __builtin_convertvector(v, bf16x2_t);
  return __builtin_bit_cast(u32, r);
}
DEV u16 f2bf(float f) { return (u16)(pack2(f, 0.f) & 0xffffu); }
DEV float lo2f(u32 w) { return __uint_as_float(w << 16); }
DEV float hi2f(u32 w) { return __uint_as_float(w & 0xffff0000u); }
DEV float silu_f(float x) { return x / (1.f + __expf(-x)); }
DEV float softplus_f(float x) { return fmaxf(x, 0.f) + log1pf(expf(-fabsf(x))); }
DEV int modrow_of(int row) { return row < T_LAT ? (row >> 11) : 8; }
DEV int tpos_of(int row) { return row < T_LAT ? (row & 2047) : ((row - T_LAT) & 255); }
DEV int chunk_row0(int b, int gc) { return gc < 4 ? (T_LAT + b * 256 + gc * 64) : (b * 2048 + (gc - 4) * 64); }
DEV f32x4 mfma16(bf16x8 a, bf16x8 b, f32x4 c) { return __builtin_amdgcn_mfma_f32_16x16x32_bf16(a, b, c, 0, 0, 0); }
DEV float xor16_sum(float v) {
  v += __shfl_xor(v, 1, 64); v += __shfl_xor(v, 2, 64); v += __shfl_xor(v, 4, 64); v += __shfl_xor(v, 8, 64); return v;
}
DEV float xor16_max(float v) {
  v = fmaxf(v, __shfl_xor(v, 1, 64)); v = fmaxf(v, __shfl_xor(v, 2, 64)); v = fmaxf(v, __shfl_xor(v, 4, 64)); v = fmaxf(v, __shfl_xor(v, 8, 64)); return v;
}
#define OPAQUE_Z int zz; asm volatile("s_mov_b32 %0, 0" : "=s"(zz))
DEV float wave_sum(float v) {
  v += __shfl_xor(v, 1, 64); v += __shfl_xor(v, 2, 64); v += __shfl_xor(v, 4, 64); v += __shfl_xor(v, 8, 64);
  v += __shfl_xor(v, 16, 64); v += __shfl_xor(v, 32, 64); return v;
}

DEV void unpack8(u32x4 w, float* o) {
  o[0] = lo2f(w[0]); o[1] = hi2f(w[0]); o[2] = lo2f(w[1]); o[3] = hi2f(w[1]);
  o[4] = lo2f(w[2]); o[5] = hi2f(w[2]); o[6] = lo2f(w[3]); o[7] = hi2f(w[3]);
}
DEV u32x4 pack8(const float* o) {
  u32x4 w; w[0] = pack2(o[0], o[1]); w[1] = pack2(o[2], o[3]); w[2] = pack2(o[4], o[5]); w[3] = pack2(o[6], o[7]); return w;
}


DEV void sincos_rev(double ang, float& c, float& s) {
  double rev = ang * 0.15915494309189533576888;
  rev -= floor(rev + 0.5);
  double x = rev * 6.28318530717958647692;
  double x2 = x * x;
  double sv = 1.0, cv = 1.0;
  double ts = 1.0, tc = 1.0;
  sv = 0.0; cv = 0.0;
  double term = 1.0;
  double cterm = 1.0, sterm = 1.0;
  cv = 1.0; sv = 1.0;
#pragma unroll
  for (int n = 1; n <= 13; n++) {
    cterm *= -x2 / (double)((2 * n - 1) * (2 * n));
    sterm *= -x2 / (double)((2 * n) * (2 * n + 1));
    cv += cterm; sv += sterm;
  }
  (void)ts; (void)tc; (void)term;
  c = (float)cv; s = (float)(sv * x);
}

__device__ __forceinline__ void ph_mod(const P& p, char* smem) {
  OPAQUE_Z;
  float* MOD = (float*)(p.ws + zz + O_MOD);
  float* sS = (float*)smem;
  float* red = sS + 9 * 1024;
  const int tid = (threadIdx.x + zz);
  for (int i = tid; i < 9 * 1024; i += NTHR) {
    int r = i >> 10, k = i & 1023;
    float v = (r < 8) ? p.in[1][r * 1024 + k] : p.in[3][k];
    sS[i] = v / (1.f + expf(-v));
  }
  __syncthreads();
  for (int task = (blockIdx.x + zz); task < 4 * 96; task += (gridDim.x + zz)) {
    int l = task / 96, n0 = (task % 96) * 64;
    int col = tid & 63, ks = tid >> 6;
    const float* w = p.in[4] + (size_t)l * 1024 * 6144 + (size_t)(ks * 256) * 6144 + n0 + col;
    float acc[9];
#pragma unroll
    for (int r = 0; r < 9; r++) acc[r] = 0.f;
#pragma unroll 16
    for (int k = 0; k < 256; k++) {
      float wv = w[(size_t)k * 6144];
      const float* s = sS + ks * 256 + k;
#pragma unroll
      for (int r = 0; r < 9; r++) acc[r] += s[r * 1024] * wv;
    }
#pragma unroll
    for (int r = 0; r < 9; r++) red[(ks * 9 + r) * 64 + col] = acc[r];
    __syncthreads();
    for (int i = tid; i < 576; i += NTHR) {
      int r = i >> 6, c = i & 63;
      float v = red[(0 * 9 + r) * 64 + c] + red[(1 * 9 + r) * 64 + c] + red[(2 * 9 + r) * 64 + c] + red[(3 * 9 + r) * 64 + c] +
                p.in[5][l * 6144 + n0 + c];
      MOD[(size_t)(l * 9 + r) * 6144 + n0 + c] = v;
    }
    __syncthreads();
  }
  float* AXC = (float*)(p.ws + zz + O_AXC); float* AXS = (float*)(p.ws + zz + O_AXS);
  float* RC = (float*)(p.ws + zz + O_RC); float* RS = (float*)(p.ws + zz + O_RS);
  int gt = (blockIdx.x + zz) * NTHR + tid, gs = (gridDim.x + zz) * NTHR;
  for (int i = gt; i < 64 * 8 + 2048 * 16; i += gs) {
    if (i < 512) {
      int pos = i >> 3, f = i & 7;
      float fr = expf(-9.210340371976184f * (float)f / 8.f);
      float a = (float)pos * fr;
      float c, s; sincos_rev((double)a, c, s);
      AXC[i] = c; AXS[i] = s;
    } else {
      int j = i - 512; int pos = j >> 4, f = j & 15;
      float fr = expf(-9.210340371976184f * (float)f / 16.f);
      float a = (float)pos * fr;
      float c, s; sincos_rev((double)a, c, s);
      RC[j] = c; RS[j] = s;
    }
  }
}

__device__ __forceinline__ void transpose_cvt(const float* src, int K, int N, u16* dst, const float* gk, char* smem, int glo = 0, int ghi = 1 << 30) {
  OPAQUE_Z;
  float* tile = (float*)smem;
  const int tid = (threadIdx.x + zz);
  int nt_n = (N + 63) / 64, nt_k = K / 64;
  for (int t = (blockIdx.x + zz); t < nt_n * nt_k; t += (gridDim.x + zz)) {
    int k0 = (t / nt_n) * 64, n0 = (t % nt_n) * 64;
    float v[16];
#pragma unroll
    for (int it = 0; it < 16; it++) {
      int i = tid + it * NTHR; int kk = i >> 6, nn = i & 63;
      v[it] = (n0 + nn < N) ? src[(size_t)(k0 + kk) * N + n0 + nn] : 0.f;
    }
    __syncthreads();
#pragma unroll
    for (int it = 0; it < 16; it++) {
      int i = tid + it * NTHR; int kk = i >> 6, nn = i & 63;
      float x = v[it];
      if (gk && (k0 + kk) >= glo && (k0 + kk) < ghi) x *= gk[k0 + kk - glo];
      tile[kk * 65 + nn] = x;
    }
    __syncthreads();
#pragma unroll
    for (int it = 0; it < 8; it++) {
      int i = tid + it * NTHR; int nn = i >> 5, kp = (i & 31) * 2;
      if (n0 + nn < N) *(u32*)(dst + (size_t)(n0 + nn) * K + k0 + kp) = pack2(tile[kp * 65 + nn], tile[(kp + 1) * 65 + nn]);
    }
  }
}

__device__ __forceinline__ void cvt_flat(const float* __restrict__ src, u16* __restrict__ dst, size_t n) {
  OPAQUE_Z;
  size_t gt = (size_t)(blockIdx.x + zz) * NTHR + (threadIdx.x + zz), gs = (size_t)(gridDim.x + zz) * NTHR;
  size_t n8 = n >> 3;
#pragma unroll 4
  for (size_t i = gt; i < n8; i += gs) {
    float4 a = ((const float4*)src)[2 * i], b = ((const float4*)src)[2 * i + 1];
    uint4 o; o.x = pack2(a.x, a.y); o.y = pack2(a.z, a.w); o.z = pack2(b.x, b.y); o.w = pack2(b.z, b.w);
    ((uint4*)dst)[i] = o;
  }
}

__device__ __forceinline__ void cvt_fp8_rows(const float* src, unsigned char* dst, float* sc, int nrows) {
  OPAQUE_Z;
  const int lane = (threadIdx.x + zz) & 63;
  int gw = ((blockIdx.x + zz) * NTHR + (threadIdx.x + zz)) >> 6, nw = ((gridDim.x + zz) * NTHR) >> 6;
  for (int row0 = gw; row0 < nrows; row0 += 4 * nw) {
    f32x4 v[4][4];
#pragma unroll
    for (int u = 0; u < 4; u++) {
      int row = row0 + u * nw;
      if (row < nrows) {
        const f32x4* s4 = (const f32x4*)(src + (size_t)row * 1024 + lane * 16);
#pragma unroll
        for (int i = 0; i < 4; i++) v[u][i] = s4[i];
      } else {
#pragma unroll
        for (int i = 0; i < 4; i++) v[u][i] = (f32x4){0.f, 0.f, 0.f, 0.f};
      }
    }
#pragma unroll
    for (int u = 0; u < 4; u++) {
      int row = row0 + u * nw;
      float am = 0.f;
#pragma unroll
      for (int i = 0; i < 4; i++)
#pragma unroll
        for (int e = 0; e < 4; e++) am = fmaxf(am, fabsf(v[u][i][e]));
      am = fmaxf(am, __shfl_xor(am, 1, 64)); am = fmaxf(am, __shfl_xor(am, 2, 64)); am = fmaxf(am, __shfl_xor(am, 4, 64));
      am = fmaxf(am, __shfl_xor(am, 8, 64)); am = fmaxf(am, __shfl_xor(am, 16, 64)); am = fmaxf(am, __shfl_xor(am, 32, 64));
      float q = am > 0.f ? 240.f / am : 1.f;
      float qi = am > 0.f ? am * (1.f / 240.f) : 1.f;
      u32x4 o;
#pragma unroll
      for (int i = 0; i < 4; i++) {
        int w = 0;
        w = __builtin_amdgcn_cvt_pk_fp8_f32(v[u][i][0] * q, v[u][i][1] * q, w, false);
        w = __builtin_amdgcn_cvt_pk_fp8_f32(v[u][i][2] * q, v[u][i][3] * q, w, true);
        o[i] = (u32)w;
      }
      if (row < nrows) {
        *(u32x4*)(dst + (size_t)row * 1024 + lane * 16) = o;
        if (lane == 0) sc[row] = qi;
      }
    }
  }
}

__device__ __forceinline__ void ph_convert(const P& p, char* smem) {
  OPAQUE_Z;
  for (int l = 0; l < 4; l++) {
    transpose_cvt(p.in[6] + (size_t)l * 1024 * 3016, 1024, 3016, (u16*)(p.ws + zz + O_WINT) + (size_t)l * 3072 * 1024, nullptr, smem);
    transpose_cvt(p.in[8] + (size_t)l * 256 * 384, 256, 384, (u16*)(p.ws + zz + O_WUQT) + (size_t)l * 384 * 256, p.in[7] + l * 256, smem);
    transpose_cvt(p.in[10] + (size_t)l * 128 * 256, 128, 256, (u16*)(p.ws + zz + O_WUKVT) + (size_t)l * 512 * 128, p.in[9] + l * 128, smem);
    transpose_cvt(p.in[11] + (size_t)l * 128 * 256, 128, 256, (u16*)(p.ws + zz + O_WUKVT) + (size_t)l * 512 * 128 + 256 * 128, p.in[9] + l * 128, smem);
    transpose_cvt(p.in[25] + (size_t)l * 1024 * 1024, 1024, 1024, (u16*)(p.ws + zz + O_WOUTT) + (size_t)l * 1024 * 1024, p.in[24] + l * 256, smem, 512, 768);
  }
  {
    int gt = (blockIdx.x + zz) * NTHR + (threadIdx.x + zz), gs = (gridDim.x + zz) * NTHR;
    for (int i = gt; i < 4 * 56 * 1024; i += gs) {
      int l = i / (56 * 1024), r = i % (56 * 1024);
      ((u16*)(p.ws + zz + O_WINT))[(size_t)l * 3072 * 1024 + (size_t)3016 * 1024 + r] = 0;
    }
  }
  cvt_flat(p.in[28], (u16*)(p.ws + zz + O_WQBF), 4ull * 1024 * 2048);
  cvt_flat(p.in[29], (u16*)(p.ws + zz + O_KEYBF), 4ull * 2 * 128 * 128);
  cvt_fp8_rows(p.in[30], (unsigned char*)(p.ws + zz + O_UBF), (float*)(p.ws + zz + O_USC), 4 * 16384);
  cvt_fp8_rows(p.in[31], (unsigned char*)(p.ws + zz + O_VBF), (float*)(p.ws + zz + O_VSC), 4 * 16384);
}

template <int HOOK>
__device__ __forceinline__ void gemm_tile(const u16* __restrict__ A, int lda, const u16* __restrict__ B, int ldb, int K, char* smem, const float* ssq = nullptr) {
  OPAQUE_Z;
  u16* sA = (u16*)smem;
  u16* sB = sA + 128 * 72;
  const int tid = (threadIdx.x + zz), lane = tid & 63, wave = tid >> 6;
  const int wm = (wave >> 1) * 64, wn = (wave & 1) * 64;
  const int lr = lane & 15, lq = lane >> 4;
  f32x4 acc[4][4];
#pragma unroll
  for (int i = 0; i < 4; i++)
#pragma unroll
    for (int j = 0; j < 4; j++) acc[i][j] = (f32x4){0.f, 0.f, 0.f, 0.f};
  u32x4 ra[4], rb[4];
  float rs[4];
  if (HOOK) {
#pragma unroll
    for (int i = 0; i < 4; i++) {
      int row = (tid + i * NTHR) >> 3;
      float4 q = *(const float4*)(ssq + (size_t)row * 4);
      rs[i] = rsqrtf((q.x + q.y + q.z + q.w) * (1.f / 256.f) + 1e-6f);
    }
  }
#pragma unroll
  for (int i = 0; i < 4; i++) {
    int id = tid + i * NTHR; int row = id >> 3, ch = id & 7;
    ra[i] = *(const u32x4*)(A + (size_t)row * lda + ch * 8);
    rb[i] = *(const u32x4*)(B + (size_t)row * ldb + ch * 8);
  }
#pragma unroll 1
  for (int k0 = 0; k0 < K; k0 += 64) {
    __syncthreads();
    if (HOOK && k0 >= 512 && k0 < 768) {
#pragma unroll
      for (int i = 0; i < 4; i++) {
        float t8[8];
        unpack8(ra[i], t8);
#pragma unroll
        for (int e = 0; e < 8; e++) t8[e] *= rs[i];
        ra[i] = pack8(t8);
      }
    }
#pragma unroll
    for (int i = 0; i < 4; i++) {
      int id = tid + i * NTHR; int row = id >> 3, ch = id & 7;
      *(u32x4*)(sA + row * 72 + ch * 8) = ra[i];
      *(u32x4*)(sB + row * 72 + ch * 8) = rb[i];
    }
    __syncthreads();
    if (k0 + 64 < K) {
#pragma unroll
      for (int i = 0; i < 4; i++) {
        int id = tid + i * NTHR; int row = id >> 3, ch = id & 7;
        ra[i] = *(const u32x4*)(A + (size_t)row * lda + k0 + 64 + ch * 8);
        rb[i] = *(const u32x4*)(B + (size_t)row * ldb + k0 + 64 + ch * 8);
      }
    }
#pragma unroll
    for (int kk = 0; kk < 64; kk += 32) {
      bf16x8 af[4], bfr[4];
#pragma unroll
      for (int i = 0; i < 4; i++) af[i] = *(const bf16x8*)(sA + (wm + i * 16 + lr) * 72 + kk + lq * 8);
#pragma unroll
      for (int j = 0; j < 4; j++) bfr[j] = *(const bf16x8*)(sB + (wn + j * 16 + lr) * 72 + kk + lq * 8);
      __builtin_amdgcn_s_setprio(1);
#pragma unroll
      for (int i = 0; i < 4; i++)
#pragma unroll
        for (int j = 0; j < 4; j++) acc[i][j] = mfma16(af[i], bfr[j], acc[i][j]);
      __builtin_amdgcn_s_setprio(0);
    }
  }
  __syncthreads();
  float* sC = (float*)smem;
#pragma unroll
  for (int i = 0; i < 4; i++)
#pragma unroll
    for (int j = 0; j < 4; j++)
#pragma unroll
      for (int r = 0; r < 4; r++) sC[(wm + i * 16 + lq * 4 + r) * 128 + wn + j * 16 + lr] = acc[i][j][r];
  __syncthreads();
}

enum { EPI_BF16 = 0, EPI_F32 = 1, EPI_Q = 2, EPI_KV = 3, EPI_OUT = 4 };

template <int EPI>
__device__ __forceinline__ void gemm_phase(const P& p, int l, const u16* A, int lda, const u16* Bt, int ldb, int K, int mtiles, int ntiles,
                           void* outp, int ldo, char* smem) {
  OPAQUE_Z;
  const int tid = (threadIdx.x + zz);
  float* sC = (float*)smem;
  for (int t = (blockIdx.x + zz); t < mtiles * ntiles; t += (gridDim.x + zz)) {
    int mt = t / ntiles, nt = t % ntiles;
    int m0 = mt * 128, n0 = nt * 128;
    gemm_tile<(EPI == EPI_OUT) ? 1 : 0>(A + (size_t)m0 * lda, lda, Bt + (size_t)n0 * ldb, ldb, K, smem, (const float*)(p.ws + zz + O_SSQ) + (size_t)m0 * 4);
    if (EPI == EPI_BF16) {
      u16* out = (u16*)outp;
      for (int i = tid; i < 128 * 32; i += NTHR) {
        int r = i >> 5, c4 = (i & 31) * 4;
        float4 v = *(const float4*)(sC + r * 128 + c4);
        uint2 o; o.x = pack2(v.x, v.y); o.y = pack2(v.z, v.w);
        *(uint2*)(out + (size_t)(m0 + r) * ldo + n0 + c4) = o;
      }
    } else if (EPI == EPI_F32) {
      float* out = (float*)outp;
      for (int i = tid; i < 128 * 32; i += NTHR) {
        int r = i >> 5, c4 = (i & 31) * 4;
        *(float4*)(out + (size_t)(m0 + r) * ldo + n0 + c4) = *(const float4*)(sC + r * 128 + c4);
      }
    } else if (EPI == EPI_OUT) {
      float* xc = (float*)(p.ws + zz + O_XCUR);
      const float* MOD = (const float*)(p.ws + zz + O_MOD);
#pragma unroll 1
      for (int i0 = tid; i0 < 128 * 32; i0 += 4 * NTHR) {
        float4 xv4[4], gg4[4];
#pragma unroll
        for (int u = 0; u < 4; u++) {
          int i = i0 + u * NTHR; int r = i >> 5, c4 = (i & 31) * 4; int row = m0 + r;
          gg4[u] = *(const float4*)(MOD + (size_t)(l * 9 + modrow_of(row)) * 6144 + 2 * 1024 + n0 + c4);
          xv4[u] = *(const float4*)(xc + (size_t)row * 1024 + n0 + c4);
        }
#pragma unroll
        for (int u = 0; u < 4; u++) {
          int i = i0 + u * NTHR; int r = i >> 5, c4 = (i & 31) * 4; int row = m0 + r;
          float4 v = *(const float4*)(sC + r * 128 + c4);
          float4 xv = xv4[u], gg = gg4[u];
          xv.x = ALPHA * xv.x + gg.x * v.x; xv.y = ALPHA * xv.y + gg.y * v.y;
          xv.z = ALPHA * xv.z + gg.z * v.z; xv.w = ALPHA * xv.w + gg.w * v.w;
          *(float4*)(xc + (size_t)row * 1024 + n0 + c4) = xv;
        }
      }
    } else if (EPI == EPI_Q || EPI == EPI_KV) {
      const u16* Pm = (const u16*)(p.ws + zz + O_P);
      for (int i = tid; i < 128 * 32; i += NTHR) {
        int r = i >> 5, sub = i & 31, c4 = sub * 4;
        int row = m0 + r;
        float ss = 0.f;
        if (EPI == EPI_Q) {
          uint4 w = *(const uint4*)(Pm + (size_t)row * LDP + sub * 8);
          float a;
          a = lo2f(w.x); ss += a * a; a = hi2f(w.x); ss += a * a; a = lo2f(w.y); ss += a * a; a = hi2f(w.y); ss += a * a;
          a = lo2f(w.z); ss += a * a; a = hi2f(w.z); ss += a * a; a = lo2f(w.w); ss += a * a; a = hi2f(w.w); ss += a * a;
        } else {
          uint2 w = *(const uint2*)(Pm + (size_t)row * LDP + 256 + sub * 4);
          float a;
          a = lo2f(w.x); ss += a * a; a = hi2f(w.x); ss += a * a; a = lo2f(w.y); ss += a * a; a = hi2f(w.y); ss += a * a;
        }
        ss += __shfl_xor(ss, 1, 64); ss += __shfl_xor(ss, 2, 64); ss += __shfl_xor(ss, 4, 64);
        ss += __shfl_xor(ss, 8, 64); ss += __shfl_xor(ss, 16, 64);
        float rinv = (EPI == EPI_Q) ? rsqrtf(ss * (1.f / 256.f) + 1e-6f) * (0.10206207261596577f * 1.4426950408889634f)
                                    : rsqrtf(ss * (1.f / 128.f) + 1e-6f);
        float4 v = *(float4*)(sC + r * 128 + c4);
        v.x *= rinv; v.y *= rinv; v.z *= rinv; v.w *= rinv;
        *(float4*)(sC + r * 128 + c4) = v;
      }
      __syncthreads();
      if (EPI == EPI_Q) {
        u16* out = (u16*)(p.ws + zz + O_QB);
        const float* AXC = (const float*)(p.ws + zz + O_AXC); const float* AXS = (const float*)(p.ws + zz + O_AXS);
        for (int i = tid; i < 128 * 128; i += NTHR) {
          int r = i >> 7, c = i & 127;
          int row = m0 + r, col = n0 + c;
          float v = sC[r * 128 + c];
          int hc = col % 96;
          if (row < T_LAT && hc >= 64) {
            int d = hc - 64; int sub = d >> 4, dd = d & 15, f = dd & 7; bool first = dd < 8;
            int t = row & 2047;
            int pos = sub == 0 ? (t >> 6) : (t & 63);
            float cs = AXC[pos * 8 + f], sn = AXS[pos * 8 + f];
            float other = sC[r * 128 + (first ? c + 8 : c - 8)];
            v = first ? (v * cs - other * sn) : (other * sn + v * cs);
          }
          out[(size_t)row * 384 + col] = f2bf(v);
        }
      } else {
        if (nt < 2) {
          u16* out = (u16*)(p.ws + zz + O_KN);
          for (int i = tid; i < 128 * 32; i += NTHR) {
            int r = i >> 5, c4 = (i & 31) * 4;
            float4 v = *(const float4*)(sC + r * 128 + c4);
            uint2 o; o.x = pack2(v.x, v.y); o.y = pack2(v.z, v.w);
            *(uint2*)(out + (size_t)(m0 + r) * 256 + n0 + c4) = o;
          }
        } else {
          u16* VT = (u16*)(p.ws + zz + O_VT);
          int b, pos0;
          if (m0 < T_LAT) { b = m0 >> 11; pos0 = 256 + (m0 & 2047); } else { b = (m0 - T_LAT) >> 8; pos0 = (m0 - T_LAT) & 255; }
          for (int i = tid; i < 128 * 16; i += NTHR) {
            int c = i >> 4, r8 = (i & 15) * 8;
            int vc = (nt - 2) * 128 + c; int h = vc >> 6, dv = vc & 63;
            uint4 o;
            o.x = pack2(sC[(r8 + 0) * 128 + c], sC[(r8 + 1) * 128 + c]);
            o.y = pack2(sC[(r8 + 2) * 128 + c], sC[(r8 + 3) * 128 + c]);
            o.z = pack2(sC[(r8 + 4) * 128 + c], sC[(r8 + 5) * 128 + c]);
            o.w = pack2(sC[(r8 + 6) * 128 + c], sC[(r8 + 7) * 128 + c]);
            *(uint4*)(VT + ((size_t)((b * 4 + h) * 64 + dv)) * 2304 + pos0 + r8) = o;
          }
        }
      }
    }
  }
}

__device__ __forceinline__ void ph_fold(const P& p, char* smem) {
  OPAQUE_Z;
  const int tid = (threadIdx.x + zz);
  float* sC = (float*)smem;
  for (int t = (blockIdx.x + zz); t < 4 * 16 * 8; t += (gridDim.x + zz)) {
    int l = t >> 7, hj = (t >> 3) & 15, kt = t & 7;
    int j = hj & 1;
    const u16* A = (const u16*)(p.ws + zz + O_KEYBF) + (size_t)(l * 2 + j) * 128 * 128;
    const u16* B = (const u16*)(p.ws + zz + O_WQBF) + (size_t)l * 1024 * 2048 + (size_t)(kt * 128) * 2048 + hj * 128;
    gemm_tile<0>(A, 128, B, 2048, 128, smem);
    u16* out = (u16*)(p.ws + zz + O_WPT) + (size_t)l * 2048 * 1024 + (size_t)(hj * 128) * 1024 + kt * 128;
    for (int i = tid; i < 128 * 32; i += NTHR) {
      int r = i >> 5, c4 = (i & 31) * 4;
      float4 v = *(const float4*)(sC + r * 128 + c4);
      uint2 o; o.x = pack2(v.x, v.y); o.y = pack2(v.z, v.w);
      *(uint2*)(out + (size_t)r * 1024 + c4) = o;
    }
  }
}

__device__ __forceinline__ void ph_xinit(const P& p) {
  OPAQUE_Z;
  float* xc = (float*)(p.ws + zz + O_XCUR);
  u16* xm = (u16*)(p.ws + zz + O_XMOD);
  const float* MOD = (const float*)(p.ws + zz + O_MOD);
  size_t gt = (size_t)(blockIdx.x + zz) * NTHR + (threadIdx.x + zz), gs = (size_t)(gridDim.x + zz) * NTHR;
  for (size_t i0 = gt; i0 < (size_t)T_ALL * 256; i0 += 4 * gs) {
    float4 vv[4];
#pragma unroll
    for (int u = 0; u < 4; u++) {
      size_t i = i0 + u * gs;
      vv[u] = make_float4(0.f, 0.f, 0.f, 0.f);
      if (i < (size_t)T_ALL * 256) {
        int row = (int)(i >> 8), c4 = (int)(i & 255) * 4;
        vv[u] = (row < T_LAT) ? *(const float4*)(p.in[0] + (size_t)row * 1024 + c4)
                              : *(const float4*)(p.in[2] + (size_t)(row - T_LAT) * 1024 + c4);
      }
    }
#pragma unroll
    for (int u = 0; u < 4; u++) {
      size_t i = i0 + u * gs;
      if (i < (size_t)T_ALL * 256) {
        int row = (int)(i >> 8), c4 = (int)(i & 255) * 4;
        float4 v = vv[u];
        *(float4*)(xc + (size_t)row * 1024 + c4) = v;
        const float* m = MOD + (size_t)(0 * 9 + modrow_of(row)) * 6144;
        float4 sh = *(const float4*)(m + c4), sc = *(const float4*)(m + 1024 + c4);
        uint2 o; o.x = pack2(v.x * (1.f + sc.x) + sh.x, v.y * (1.f + sc.y) + sh.y);
        o.y = pack2(v.z * (1.f + sc.z) + sh.z, v.w * (1.f + sc.w) + sh.w);
        *(uint2*)(xm + (size_t)row * 1024 + c4) = o;
      }
    }
  }
}

__device__ __forceinline__ void ph_prep(const P& p, int l, char* smem) {
  OPAQUE_Z;
  const u16* Pm = (const u16*)(p.ws + zz + O_P);
  const int tid = (threadIdx.x + zz);
  const int gt = (blockIdx.x + zz) * NTHR + tid, gs = (gridDim.x + zz) * NTHR;
  float* sW = (float*)smem;
  float* sBg = sW + 2 * 16 * 128;
  __syncthreads();
  for (int i = tid; i < 2 * 16 * 128; i += NTHR) sW[i] = ((i >> 11) == 0 ? p.in[12] : p.in[14])[l * 2048 + (i & 2047)];
  for (int i = tid; i < 256; i += NTHR) sBg[i] = ((i >> 7) == 0 ? p.in[13] : p.in[15])[l * 128 + (i & 127)];
  __syncthreads();
  {
    float* LG = (float*)(p.ws + zz + O_LGG);
    for (int i0 = gt; i0 < T_ALL * 32; i0 += 2 * gs) {
      u32x4 la[2], lb[2];
#pragma unroll
      for (int u = 0; u < 2; u++) {
        int i = i0 + u * gs;
        la[u] = (u32x4){0u, 0u, 0u, 0u}; lb[u] = la[u];
        if (i < T_ALL * 32) {
          int row = i >> 5, dir = (i >> 4) & 1;
          const u16* lrp = Pm + (size_t)row * LDP + 1184 + dir * 16;
          la[u] = *(const u32x4*)lrp; lb[u] = *(const u32x4*)(lrp + 8);
        }
      }
#pragma unroll
      for (int u = 0; u < 2; u++) {
        int i = i0 + u * gs;
        if (i < T_ALL * 32) {
          int row = i >> 5, dir = (i >> 4) & 1, cg = i & 15;
          float lr[16];
          unpack8(la[u], lr); unpack8(lb[u], lr + 8);
          float z[8];
#pragma unroll
          for (int c = 0; c < 8; c++) z[c] = sBg[dir * 128 + cg * 8 + c];
#pragma unroll
          for (int k = 0; k < 16; k++) {
            const float4 w0 = *(const float4*)(sW + dir * 2048 + k * 128 + cg * 8);
            const float4 w1 = *(const float4*)(sW + dir * 2048 + k * 128 + cg * 8 + 4);
            z[0] += lr[k] * w0.x; z[1] += lr[k] * w0.y; z[2] += lr[k] * w0.z; z[3] += lr[k] * w0.w;
            z[4] += lr[k] * w1.x; z[5] += lr[k] * w1.y; z[6] += lr[k] * w1.z; z[7] += lr[k] * w1.w;
          }
#pragma unroll
          for (int c = 0; c < 8; c++) z[c] = (fminf(z[c], 0.f) - log1pf(__expf(-fabsf(z[c])))) * (1.f / 16.f);
          float* o = LG + (size_t)dir * T_ALL * 128 + (size_t)row * 128 + cg * 8;
          *(float4*)o = make_float4(z[0], z[1], z[2], z[3]);
          *(float4*)(o + 4) = make_float4(z[4], z[5], z[6], z[7]);
        }
      }
    }
  }
  {
    u16* KR = (u16*)(p.ws + zz + O_KR);
    const float* AXC = (const float*)(p.ws + zz + O_AXC); const float* AXS = (const float*)(p.ws + zz + O_AXS);
    for (int row = gt; row < T_ALL; row += gs) {
      const u16* src = Pm + (size_t)row * LDP + 384;
      u32x4 w0 = *(const u32x4*)src, w1 = *(const u32x4*)(src + 8), w2 = *(const u32x4*)(src + 16), w3 = *(const u32x4*)(src + 24);
      if (row < T_LAT) {
        int t = row & 2047;
        float a[8], b[8], c[8], d[8];
        unpack8(w0, a); unpack8(w1, b); unpack8(w2, c); unpack8(w3, d);
        const float* cr = AXC + (t >> 6) * 8; const float* sr = AXS + (t >> 6) * 8;
        const float* cc = AXC + (t & 63) * 8; const float* sc = AXS + (t & 63) * 8;
#pragma unroll
        for (int f = 0; f < 8; f++) {
          float x1 = a[f], x2 = b[f]; a[f] = x1 * cr[f] - x2 * sr[f]; b[f] = x1 * sr[f] + x2 * cr[f];
          float y1 = c[f], y2 = d[f]; c[f] = y1 * cc[f] - y2 * sc[f]; d[f] = y1 * sc[f] + y2 * cc[f];
        }
        w0 = pack8(a); w1 = pack8(b); w2 = pack8(c); w3 = pack8(d);
      }
      u16* dst = KR + (size_t)row * 32;
      *(u32x4*)dst = w0; *(u32x4*)(dst + 8) = w1; *(u32x4*)(dst + 16) = w2; *(u32x4*)(dst + 24) = w3;
    }
  }
  {
    u16* XBC = (u16*)(p.ws + zz + O_XBC);
    const float* cw = p.in[17] + (size_t)l * 3 * 768; const float* cb = p.in[18] + l * 768;
    for (int i0 = gt; i0 < T_ALL * 96; i0 += 2 * gs) {
      u32x4 r0[2], rm[2], rp[2];
      const u32x4 zero = (u32x4){0u, 0u, 0u, 0u};
#pragma unroll
      for (int u = 0; u < 2; u++) {
        int i = i0 + u * gs;
        r0[u] = zero; rm[u] = zero; rp[u] = zero;
        if (i < T_ALL * 96) {
          int row = i / 96, cg = i - row * 96;
          int t = tpos_of(row); int L = row < T_LAT ? 2048 : 256;
          const u16* src = Pm + (size_t)row * LDP + 1472 + cg * 8;
          r0[u] = *(const u32x4*)src;
          if (t > 0) rm[u] = *(const u32x4*)(src - LDP);
          if (t < L - 1) rp[u] = *(const u32x4*)(src + LDP);
        }
      }
#pragma unroll
      for (int u = 0; u < 2; u++) {
        int i = i0 + u * gs;
        if (i < T_ALL * 96) {
          int row = i / 96, cg = i - row * 96;
          float x0[8], xm[8], xp[8];
          unpack8(r0[u], x0); unpack8(rm[u], xm); unpack8(rp[u], xp);
          float y[8];
#pragma unroll
          for (int c = 0; c < 8; c++) {
            float v = cw[cg * 8 + c] * xm[c] + cw[768 + cg * 8 + c] * x0[c] + cw[1536 + cg * 8 + c] * xp[c] + cb[cg * 8 + c];
            y[c] = silu_f(v);
          }
          *(u32x4*)(XBC + (size_t)row * 768 + cg * 8) = pack8(y);
        }
      }
    }
    float* DT = (float*)(p.ws + zz + O_DT); float* LA = (float*)(p.ws + zz + O_LA);
    for (int i = gt; i < 2 * T_ALL * 4; i += gs) {
      int dir = i / (T_ALL * 4); int rem = i - dir * (T_ALL * 4);
      int row = rem >> 2, h = rem & 3;
      float raw = bf2f(Pm[(size_t)row * LDP + 2240 + dir * 4 + h]);
      float bias = (dir == 0 ? p.in[19] : p.in[20])[l * 4 + h];
      float alog = (dir == 0 ? p.in[21] : p.in[22])[l * 4 + h];
      float dt = softplus_f(raw + bias);
      DT[i] = dt; LA[i] = -dt * expf(alog);
    }
  }
  {
    u16* QK = (u16*)(p.ws + zz + O_QKR);
    const float* RC = (const float*)(p.ws + zz + O_RC); const float* RS = (const float*)(p.ws + zz + O_RS);
    for (int i = gt; i < T_ALL * 8; i += gs) {
      int row = i >> 3, which = (i >> 2) & 1, h = i & 3;
      const u16* src = Pm + (size_t)row * LDP + 2248 + which * 128 + h * 32;
      float a[8], b[8], c[8], d[8];
      unpack8(*(const u32x4*)src, a); unpack8(*(const u32x4*)(src + 8), b);
      unpack8(*(const u32x4*)(src + 16), c); unpack8(*(const u32x4*)(src + 24), d);
      float sc = which == 1 ? 0.17677669529663687f : 1.f;
      if (row < T_LAT) {
        int t = row & 2047;
        const float* cs = RC + t * 16; const float* sn = RS + t * 16;
#pragma unroll
        for (int f = 0; f < 8; f++) {
          float x1 = a[f], x2 = c[f]; a[f] = x1 * cs[f] - x2 * sn[f]; c[f] = x1 * sn[f] + x2 * cs[f];
          float y1 = b[f], y2 = d[f]; b[f] = y1 * cs[8 + f] - y2 * sn[8 + f]; d[f] = y1 * sn[8 + f] + y2 * cs[8 + f];
        }
      }
#pragma unroll
      for (int f = 0; f < 8; f++) { a[f] *= sc; b[f] *= sc; c[f] *= sc; d[f] *= sc; }
      u16* dst = QK + (size_t)row * 256 + which * 128 + h * 32;
      *(u32x4*)dst = pack8(a); *(u32x4*)(dst + 8) = pack8(b); *(u32x4*)(dst + 16) = pack8(c); *(u32x4*)(dst + 24) = pack8(d);
    }
  }
}

__device__ __forceinline__ void ph_attn(const P& p, int need_ctx, char* smem) {
  OPAQUE_Z;
  const u16* QB = (const u16*)(p.ws + zz + O_QB);
  const u16* KN = (const u16*)(p.ws + zz + O_KN);
  const u16* KR = (const u16*)(p.ws + zz + O_KR);
  const u16* VT = (const u16*)(p.ws + zz + O_VT);
  u16* MIX = (u16*)(p.ws + zz + O_MIX);
  u16* sK = (u16*)smem;
  u16* sV = sK + 64 * 104;
  const int tid = (threadIdx.x + zz), lane = tid & 63, wave = tid >> 6, lr = lane & 15, lq = lane >> 4;
  int ntask = 8 * 4 * 16 + (need_ctx ? 8 * 4 * 2 : 0);
  for (int task = (blockIdx.x + zz); task < ntask; task += (gridDim.x + zz)) {
    int b, h, qrow0, nkt;
    if (task < 512) { b = task >> 6; h = (task >> 4) & 3; int qt = task & 15; qrow0 = b * 2048 + qt * 128; nkt = 36; }
    else { int t2 = task - 512; b = t2 >> 3; h = (t2 >> 1) & 3; int qt = t2 & 1; qrow0 = T_LAT + b * 256 + qt * 128; nkt = 4; }
    bf16x8 qf[2][3];
#pragma unroll
    for (int qs = 0; qs < 2; qs++) {
      const u16* qp = QB + (size_t)(qrow0 + wave * 32 + qs * 16 + lr) * 384 + h * 96 + lq * 8;
#pragma unroll
      for (int ks = 0; ks < 3; ks++) qf[qs][ks] = *(const bf16x8*)(qp + ks * 32);
    }
    f32x4 o[2][4];
    float m[2], lsum[2];
#pragma unroll
    for (int qs = 0; qs < 2; qs++) {
      m[qs] = -1e30f; lsum[qs] = 0.f;
#pragma unroll
      for (int i = 0; i < 4; i++) o[qs][i] = (f32x4){0.f, 0.f, 0.f, 0.f};
    }
    u32x4 rk[3], rv[2];
#define ATT_LOAD(kt_)                                                                                   \
  {                                                                                                     \
    int pos0_ = (kt_) * 64;                                                                             \
    int krow0_ = (pos0_ < 256) ? (T_LAT + b * 256 + pos0_) : (b * 2048 + pos0_ - 256);                  \
    _Pragma("unroll") for (int i_ = 0; i_ < 3; i_++) {                                                  \
      int id_ = tid + i_ * NTHR; int j_ = id_ / 12, ch_ = id_ - j_ * 12;                                \
      rk[i_] = (ch_ < 8) ? *(const u32x4*)(KN + (size_t)(krow0_ + j_) * 256 + h * 64 + ch_ * 8)         \
                         : *(const u32x4*)(KR + (size_t)(krow0_ + j_) * 32 + (ch_ - 8) * 8);            \
    }                                                                                                   \
    _Pragma("unroll") for (int i_ = 0; i_ < 2; i_++) {                                                  \
      int id_ = tid + i_ * NTHR; int dv_ = id_ >> 3, ch_ = id_ & 7;                                     \
      rv[i_] = *(const u32x4*)(VT + ((size_t)((b * 4 + h) * 64 + dv_)) * 2304 + pos0_ + ch_ * 8);       \
    }                                                                                                   \
  }
    ATT_LOAD(0);
#pragma unroll 1
    for (int kt = 0; kt < nkt; kt++) {
      __syncthreads();
#pragma unroll
      for (int i = 0; i < 3; i++) { int id = tid + i * NTHR; int j = id / 12, ch = id - j * 12; *(u32x4*)(sK + j * 104 + ch * 8) = rk[i]; }
#pragma unroll
      for (int i = 0; i < 2; i++) { int id = tid + i * NTHR; int dv = id >> 3, ch = id & 7; *(u32x4*)(sV + dv * 72 + ch * 8) = rv[i]; }
      __syncthreads();
      if (kt + 1 < nkt) ATT_LOAD(kt + 1);
      f32x4 s[2][4];
      __builtin_amdgcn_s_setprio(1);
#pragma unroll
      for (int nt = 0; nt < 4; nt++) {
        s[0][nt] = (f32x4){0.f, 0.f, 0.f, 0.f}; s[1][nt] = (f32x4){0.f, 0.f, 0.f, 0.f};
#pragma unroll
        for (int ks = 0; ks < 3; ks++) {
          bf16x8 kf = *(const bf16x8*)(sK + (nt * 16 + lr) * 104 + ks * 32 + lq * 8);
          s[0][nt] = mfma16(kf, qf[0][ks], s[0][nt]);
          s[1][nt] = mfma16(kf, qf[1][ks], s[1][nt]);
        }
      }
      __builtin_amdgcn_s_setprio(0);
      bf16x8 pf[2][2];
#pragma unroll
      for (int qs = 0; qs < 2; qs++) {
        float mx = s[qs][0][0];
#pragma unroll
        for (int nt = 0; nt < 4; nt++)
#pragma unroll
          for (int r = 0; r < 4; r++) mx = fmaxf(mx, s[qs][nt][r]);
        mx = fmaxf(mx, __shfl_xor(mx, 16, 64)); mx = fmaxf(mx, __shfl_xor(mx, 32, 64));
        float mn = fmaxf(m[qs], mx);
        float alpha = __builtin_amdgcn_exp2f(m[qs] - mn);
        m[qs] = mn;
        float ps = 0.f;
#pragma unroll
        for (int nt = 0; nt < 4; nt++)
#pragma unroll
          for (int r = 0; r < 4; r++) { float e = __builtin_amdgcn_exp2f(s[qs][nt][r] - mn); s[qs][nt][r] = e; ps += e; }
        lsum[qs] = lsum[qs] * alpha + ps;
#pragma unroll
        for (int nt = 0; nt < 4; nt++)
#pragma unroll
          for (int r = 0; r < 4; r++) o[qs][nt][r] *= alpha;
#pragma unroll
        for (int m2 = 0; m2 < 2; m2++) {
          u32x4 w;
          w[0] = pack2(s[qs][2 * m2][0], s[qs][2 * m2][1]); w[1] = pack2(s[qs][2 * m2][2], s[qs][2 * m2][3]);
          w[2] = pack2(s[qs][2 * m2 + 1][0], s[qs][2 * m2 + 1][1]); w[3] = pack2(s[qs][2 * m2 + 1][2], s[qs][2 * m2 + 1][3]);
          pf[qs][m2] = __builtin_bit_cast(bf16x8, w);
        }
      }
      __builtin_amdgcn_s_setprio(1);
#pragma unroll
      for (int m2 = 0; m2 < 2; m2++) {
#pragma unroll
        for (int nt = 0; nt < 4; nt++) {
          const u16* vp = sV + (nt * 16 + lr) * 72 + 32 * m2 + 4 * lq;
          uint2 lo = *(const uint2*)vp, hi = *(const uint2*)(vp + 16);
          u32x4 w; w[0] = lo.x; w[1] = lo.y; w[2] = hi.x; w[3] = hi.y;
          bf16x8 vf = __builtin_bit_cast(bf16x8, w);
          o[0][nt] = mfma16(vf, pf[0][m2], o[0][nt]);
          o[1][nt] = mfma16(vf, pf[1][m2], o[1][nt]);
        }
      }
      __builtin_amdgcn_s_setprio(0);
    }
#pragma unroll
    for (int qs = 0; qs < 2; qs++) {
      float ls = lsum[qs];
      ls += __shfl_xor(ls, 16, 64); ls += __shfl_xor(ls, 32, 64);
      float inv = 1.f / ls;
      int row = qrow0 + wave * 32 + qs * 16 + lr;
#pragma unroll
      for (int nt = 0; nt < 4; nt++) {
        uint2 w; w.x = pack2(o[qs][nt][0] * inv, o[qs][nt][1] * inv); w.y = pack2(o[qs][nt][2] * inv, o[qs][nt][3] * inv);
        *(uint2*)(MIX + (size_t)row * 1024 + h * 64 + nt * 16 + lq * 4) = w;
      }
    }
  }
}

struct MixDesc {
  const u16 *q, *k, *v;
  int qld, kld, vld, qc, kc, vc;
  int dk, hshift, g;
  float qscale;
  const float* lg;
  const float* ks;
  size_t sloc_off, dec_off;
};

DEV MixDesc get_mix(const P& p, int m) {
  OPAQUE_Z;
  MixDesc d;
  const u16* Pm = (const u16*)(p.ws + zz + O_P);
  if (m == 0) {
    d.q = Pm; d.k = Pm; d.v = Pm; d.qld = d.kld = d.vld = LDP; d.qc = 416; d.kc = 544; d.vc = 672;
    d.dk = 32; d.hshift = 0; d.g = 32; d.qscale = 0.17677669529663687f;
    d.lg = (const float*)(p.ws + zz + O_LGG); d.ks = nullptr; d.sloc_off = SLOC_G; d.dec_off = DEC_G;
  } else if (m == 1) {
    const u16* X = (const u16*)(p.ws + zz + O_XBC);
    d.q = X; d.k = X; d.v = X; d.qld = d.kld = d.vld = 768; d.qc = 512; d.kc = 256; d.vc = 0;
    d.dk = 128; d.hshift = 1; d.g = 1; d.qscale = 1.f;
    d.lg = (const float*)(p.ws + zz + O_LA); d.ks = (const float*)(p.ws + zz + O_DT); d.sloc_off = SLOC_S; d.dec_off = DEC_S;
  } else {
    const u16* X = (const u16*)(p.ws + zz + O_QKR);
    d.q = X; d.k = X; d.v = Pm; d.qld = d.kld = 256; d.vld = LDP; d.qc = 0; d.kc = 128; d.vc = 2504;
    d.dk = 32; d.hshift = 0; d.g = 1; d.qscale = 1.f;
    d.lg = nullptr; d.ks = nullptr; d.sloc_off = SLOC_R; d.dec_off = DEC_R;
  }
  return d;
}

DEV void stage_cum(const MixDesc& d, int row0, int h, float* sCum, float* sKs) {
  OPAQUE_Z;
  const int tid = (threadIdx.x + zz);
  const int g = d.g;
  if (g > 1) {
    for (int i = tid; i < 2 * 64 * 8; i += NTHR) {
      int dir = i >> 9, j = (i >> 3) & 63, c4 = (i & 7) * 4;
      *(float4*)(sCum + dir * 2048 + j * 32 + c4) =
          *(const float4*)(d.lg + (size_t)dir * T_ALL * 128 + (size_t)(row0 + j) * 128 + h * 32 + c4);
    }
  } else if (tid < 128) {
    int dir = tid >> 6, j = tid & 63;
    sCum[tid] = d.lg ? d.lg[(size_t)dir * T_ALL * 4 + (size_t)(row0 + j) * 4 + h] : log1pf(-exp2f(-5.f - (float)h));
  }
  if (tid < 128) {
    int dir = tid >> 6, j = tid & 63;
    sKs[tid] = d.ks ? d.ks[(size_t)dir * T_ALL * 4 + (size_t)(row0 + j) * 4 + h] : 1.f;
  }
  __syncthreads();
  if (g > 1) {
    if (tid < 64) {
      int dir = tid >> 5, kk = tid & 31;
      float* c = sCum + dir * 2048 + kk;
      float run = 0.f;
      if (dir == 0) {
#pragma unroll 8
        for (int j = 0; j < 64; j++) { run += c[j * 32]; c[j * 32] = run; }
      } else {
#pragma unroll 8
        for (int j = 63; j >= 0; j--) { run += c[j * 32]; c[j * 32] = run; }
      }
    }
  } else if (tid < 128) {
    int dir = tid >> 6, lane = tid & 63;
    float v = sCum[tid];
#pragma unroll
    for (int off = 1; off < 64; off <<= 1) {
      float o = dir == 0 ? __shfl_up(v, off, 64) : __shfl_down(v, off, 64);
      bool ok = dir == 0 ? (lane >= off) : (lane + off < 64);
      v += ok ? o : 0.f;
    }
    sCum[tid] = v;
  }
  __syncthreads();
}

DEV void stage_vt(const MixDesc& d, int row0, int h, u16* sVT) {
  OPAQUE_Z;
  const int tid = (threadIdx.x + zz);
  int vcol = d.vc + h * 64;
  for (int i = tid; i < 512; i += NTHR) {
    int j = i >> 3, ch = i & 7;
    u32x4 v = *(const u32x4*)(d.v + (size_t)(row0 + j) * d.vld + vcol + ch * 8);
    u16* dst = sVT + (ch * 8) * 72 + j;
    dst[0 * 72] = (u16)(v[0] & 0xffff); dst[1 * 72] = (u16)(v[0] >> 16);
    dst[2 * 72] = (u16)(v[1] & 0xffff); dst[3 * 72] = (u16)(v[1] >> 16);
    dst[4 * 72] = (u16)(v[2] & 0xffff); dst[5 * 72] = (u16)(v[2] >> 16);
    dst[6 * 72] = (u16)(v[3] & 0xffff); dst[7 * 72] = (u16)(v[3] >> 16);
  }
}

__device__ __forceinline__ void ph_scan1(const P& p, char* smem) {
  OPAQUE_Z;
  u16* sKraw = (u16*)smem;
  u16* sVT = (u16*)(smem + 16384);
  u16* sKT = (u16*)(smem + 25600);
  float* sCum = (float*)(smem + 44032);
  float* sKs = (float*)(smem + 60416);
  float* SLOC = (float*)(p.ws + zz + O_SLOC);
  float* DEC = (float*)(p.ws + zz + O_DEC);
  const int tid = (threadIdx.x + zz), lane = tid & 63, wave = tid >> 6, lr = lane & 15, lq = lane >> 4;
  for (int task = (blockIdx.x + zz); task < 3 * 8 * 36 * 4; task += (gridDim.x + zz)) {
    int m = task / 1152; int rem = task - m * 1152; int b = rem / 144; int rem2 = rem - b * 144; int gc = rem2 >> 2, h = rem2 & 3;
    MixDesc d = get_mix(p, m);
    const int dk = d.dk, g = d.g;
    int row0 = chunk_row0(b, gc);
    __syncthreads();
    int kcol = d.kc + (h >> d.hshift) * dk;
    int cpr = dk >> 3;
    {
      u32x4 kr[4];
#pragma unroll
      for (int it = 0; it < 4; it++) {
        int i = tid + it * NTHR;
        kr[it] = (u32x4){0u, 0u, 0u, 0u};
        if (i < 64 * cpr) { int j = i / cpr, ch = i - j * cpr; kr[it] = *(const u32x4*)(d.k + (size_t)(row0 + j) * d.kld + kcol + ch * 8); }
      }
#pragma unroll
      for (int it = 0; it < 4; it++) {
        int i = tid + it * NTHR;
        if (i < 64 * cpr) { int j = i / cpr, ch = i - j * cpr; *(u32x4*)(sKraw + j * dk + ch * 8) = kr[it]; }
      }
    }
    stage_vt(d, row0, h, sVT);
    stage_cum(d, row0, h, sCum, sKs);
#pragma unroll 1
    for (int dir = 0; dir < 2; dir++) {
      const float* cum = sCum + dir * 64 * g;
      const int jl = dir == 0 ? 63 : 0;
      for (int i = tid; i < 64 * cpr; i += NTHR) {
        int j = i & 63, kg = i >> 6;
        float kv[8];
        unpack8(*(const u32x4*)(sKraw + j * dk + kg * 8), kv);
        float ksj = sKs[dir * 64 + j];
        if (g > 1) {
#pragma unroll
          for (int e = 0; e < 8; e++) kv[e] *= ksj * __expf(cum[jl * 32 + kg * 8 + e] - cum[j * 32 + kg * 8 + e]);
        } else {
          float f = ksj * __expf(cum[jl] - cum[j]);
#pragma unroll
          for (int e = 0; e < 8; e++) kv[e] *= f;
        }
#pragma unroll
        for (int e = 0; e < 8; e++) sKT[(kg * 8 + e) * 72 + j] = f2bf(kv[e]);
      }
      __syncthreads();
      size_t seq = (size_t)((b * 4 + h) * 2 + dir) * 36 + gc;
      float* outS = SLOC + d.sloc_off + seq * (size_t)(dk * 64);
      int ntile = (dk >> 4) * 4;
      for (int t = wave; t < ntile; t += 4) {
        int mt = t & 3, nt = t >> 2;
        f32x4 acc = (f32x4){0.f, 0.f, 0.f, 0.f};
#pragma unroll
        for (int ks = 0; ks < 2; ks++) {
          bf16x8 a = *(const bf16x8*)(sVT + (mt * 16 + lr) * 72 + ks * 32 + lq * 8);
          bf16x8 bb = *(const bf16x8*)(sKT + (nt * 16 + lr) * 72 + ks * 32 + lq * 8);
          acc = mfma16(a, bb, acc);
        }
#pragma unroll
        for (int r = 0; r < 4; r++) outS[(mt * 16 + lq * 4 + r) * dk + nt * 16 + lr] = acc[r];
      }
      if (tid < g) DEC[d.dec_off + seq * g + tid] = __expf(cum[jl * g + tid]);
      __syncthreads();
    }
  }
}

__device__ __forceinline__ void ph_scan2(const P& p) {
  OPAQUE_Z;
  const float* SLOC = (const float*)(p.ws + zz + O_SLOC);
  u16* SIN = (u16*)(p.ws + zz + O_SIN);
  const float* DEC = (const float*)(p.ws + zz + O_DEC);
  int gt = (blockIdx.x + zz) * NTHR + (threadIdx.x + zz), gs = (gridDim.x + zz) * NTHR;
  const int NG = 64 * 2048, NS = 64 * 8192;
  for (int i = gt; i < NG + NS + NG; i += gs) {
    int m, rem;
    if (i < NG) { m = 0; rem = i; } else if (i < NG + NS) { m = 1; rem = i - NG; } else { m = 2; rem = i - NG - NS; }
    int dk = m == 1 ? 128 : 32; int g = m == 0 ? 32 : 1;
    size_t so = m == 0 ? SLOC_G : (m == 1 ? SLOC_S : SLOC_R);
    size_t dof = m == 0 ? DEC_G : (m == 1 ? DEC_S : DEC_R);
    int esz = dk * 64;
    int seq = rem / esz, e = rem - seq * esz;
    int dir = seq & 1;
    int kk = e & (dk - 1);
    int gi = g > 1 ? kk : 0;
    float run = 0.f;
#pragma unroll 1
    for (int s0 = 0; s0 < 36; s0 += 18) {
      float loc[18], dd[18]; size_t aa[18];
#pragma unroll
      for (int u = 0; u < 18; u++) {
        int s = s0 + u;
        int gc = dir == 0 ? s : (s < 4 ? 3 - s : 39 - s);
        aa[u] = so + ((size_t)seq * 36 + gc) * esz + e;
        loc[u] = SLOC[aa[u]];
        dd[u] = DEC[dof + ((size_t)seq * 36 + gc) * g + gi];
      }
#pragma unroll
      for (int u = 0; u < 18; u++) { SIN[aa[u]] = f2bf(run); run = dd[u] * run + loc[u]; }
    }
  }
}

__device__ __forceinline__ void ph_scan3(const P& p, int l, int need_ctx, char* smem) {
  OPAQUE_Z;
  const u16* SIN = (const u16*)(p.ws + zz + O_SIN);
  const u16* Pm = (const u16*)(p.ws + zz + O_P);
  const u16* XBC = (const u16*)(p.ws + zz + O_XBC);
  u16* MIX = (u16*)(p.ws + zz + O_MIX);
  float* SSQ = (float*)(p.ws + zz + O_SSQ);
  const int tid = (threadIdx.x + zz), lane = tid & 63, wave = tid >> 6, lr = lane & 15, lq = lane >> 4;
  const int gcn = need_ctx ? 36 : 32, gcb = need_ctx ? 0 : 4;
  const int per_m = 8 * gcn * 4;
  for (int task = (blockIdx.x + zz); task < 3 * per_m; task += (gridDim.x + zz)) {
    int m = task / per_m; int rem = task - m * per_m; int b = rem / (gcn * 4); int rem2 = rem - b * gcn * 4;
    int gc = gcb + (rem2 >> 2), h = rem2 & 3;
    MixDesc d = get_mix(p, m);
    const int dk = d.dk, g = d.g, ldq = dk + 8;
    u16* sQ = (u16*)smem;
    u16* sK = sQ + 64 * ldq;
    u16* sSin = sK + 64 * ldq;
    u16* sVT = sSin + 64 * ldq;
    float* sCum = (float*)(sVT + 64 * 72);
    float* sKs = sCum + 2 * 64 * g;
    u16* sQr = (u16*)(sKs + 128);
    u16* sKr = sQr + 64 * 32;
    u16* sPm = (dk == 128) ? sSin : (sKr + 64 * 32);
    int row0 = chunk_row0(b, gc);
    __syncthreads();
    int qcol = d.qc + (h >> d.hshift) * dk, kcol = d.kc + (h >> d.hshift) * dk;
    int cpr = dk >> 3;
    {
      u32x4 qr[4], kr[4];
#pragma unroll
      for (int it = 0; it < 4; it++) {
        int i = tid + it * NTHR;
        qr[it] = (u32x4){0u, 0u, 0u, 0u}; kr[it] = qr[it];
        if (i < 64 * cpr) {
          int j = i / cpr, ch = i - j * cpr;
          qr[it] = *(const u32x4*)(d.q + (size_t)(row0 + j) * d.qld + qcol + ch * 8);
          kr[it] = *(const u32x4*)(d.k + (size_t)(row0 + j) * d.kld + kcol + ch * 8);
        }
      }
#pragma unroll
      for (int it = 0; it < 4; it++) {
        int i = tid + it * NTHR;
        if (i < 64 * cpr) {
          int j = i / cpr, ch = i - j * cpr;
          if (g > 1) { *(u32x4*)(sQr + j * 32 + ch * 8) = qr[it]; *(u32x4*)(sKr + j * 32 + ch * 8) = kr[it]; }
          else { *(u32x4*)(sQ + j * ldq + ch * 8) = qr[it]; *(u32x4*)(sK + j * ldq + ch * 8) = kr[it]; }
        }
      }
    }
    stage_vt(d, row0, h, sVT);
    stage_cum(d, row0, h, sCum, sKs);
    f32x4 o[4];
#pragma unroll
    for (int i = 0; i < 4; i++) o[i] = (f32x4){0.f, 0.f, 0.f, 0.f};
#pragma unroll 1
    for (int dir = 0; dir < 2; dir++) {
      const float* cum = sCum + dir * 64 * g;
      {
        size_t seq = (size_t)((b * 4 + h) * 2 + dir) * 36 + gc;
        const u16* S = SIN + d.sloc_off + seq * (size_t)(dk * 64);
        u32x4 sr[4];
#pragma unroll
        for (int it = 0; it < 4; it++) {
          int i = tid + it * NTHR;
          sr[it] = (u32x4){0u, 0u, 0u, 0u};
          if (i < 64 * cpr) { int vv = i / cpr, ch = i - vv * cpr; sr[it] = *(const u32x4*)(S + vv * dk + ch * 8); }
        }
#pragma unroll
        for (int it = 0; it < 4; it++) {
          int i = tid + it * NTHR;
          if (i < 64 * cpr) { int vv = i / cpr, ch = i - vv * cpr; *(u32x4*)(sSin + vv * ldq + ch * 8) = sr[it]; }
        }
      }
      if (g > 1) {
        for (int i = tid; i < 64 * 4; i += NTHR) {
          int j = i >> 2, kg = i & 3;
          float qv[8], kv[8];
          unpack8(*(const u32x4*)(sQr + j * 32 + kg * 8), qv);
          unpack8(*(const u32x4*)(sKr + j * 32 + kg * 8), kv);
#pragma unroll
          for (int e = 0; e < 8; e++) {
            float c = cum[j * 32 + kg * 8 + e];
            qv[e] *= d.qscale * __expf(c); kv[e] *= __expf(-c);
          }
          *(u32x4*)(sQ + j * ldq + kg * 8) = pack8(qv);
          *(u32x4*)(sK + j * ldq + kg * 8) = pack8(kv);
        }
      }
      __syncthreads();
      f32x4 s[4], tmp[4];
#pragma unroll
      for (int nt = 0; nt < 4; nt++) { s[nt] = (f32x4){0.f, 0.f, 0.f, 0.f}; tmp[nt] = (f32x4){0.f, 0.f, 0.f, 0.f}; }
#pragma unroll 1
      for (int ks = 0; ks < dk; ks += 32) {
        bf16x8 a = *(const bf16x8*)(sQ + (wave * 16 + lr) * ldq + ks + lq * 8);
#pragma unroll
        for (int nt = 0; nt < 4; nt++) {
          bf16x8 bk = *(const bf16x8*)(sK + (nt * 16 + lr) * ldq + ks + lq * 8);
          s[nt] = mfma16(a, bk, s[nt]);
          bf16x8 bs = *(const bf16x8*)(sSin + (nt * 16 + lr) * ldq + ks + lq * 8);
          tmp[nt] = mfma16(a, bs, tmp[nt]);
        }
      }
      __syncthreads();
      float ci[4];
#pragma unroll
      for (int r = 0; r < 4; r++) ci[r] = (g > 1) ? 0.f : cum[wave * 16 + lq * 4 + r];
#pragma unroll
      for (int nt = 0; nt < 4; nt++) {
        int j = nt * 16 + lr;
        float cj = (g > 1) ? 0.f : cum[j];
        float ksj = sKs[dir * 64 + j];
#pragma unroll
        for (int r = 0; r < 4; r++) {
          int i = wave * 16 + lq * 4 + r;
          bool valid = dir == 0 ? (j <= i) : (j >= i);
          float val = 0.f;
          if (valid) val = (g > 1) ? s[nt][r] : s[nt][r] * ksj * __expf(ci[r] - cj);
          sPm[i * 72 + j] = f2bf(val);
        }
      }
      __syncthreads();
#pragma unroll
      for (int ks = 0; ks < 2; ks++) {
        bf16x8 a = *(const bf16x8*)(sPm + (wave * 16 + lr) * 72 + ks * 32 + lq * 8);
#pragma unroll
        for (int nt = 0; nt < 4; nt++) {
          bf16x8 bb = *(const bf16x8*)(sVT + (nt * 16 + lr) * 72 + ks * 32 + lq * 8);
          o[nt] = mfma16(a, bb, o[nt]);
        }
      }
#pragma unroll
      for (int r = 0; r < 4; r++) {
        float sc = (g > 1) ? 1.f : __expf(ci[r]);
#pragma unroll
        for (int nt = 0; nt < 4; nt++) o[nt][r] += sc * tmp[nt][r];
      }
      __syncthreads();
    }
    float ga[4][4], gb[4][4];
#pragma unroll
    for (int r = 0; r < 4; r++) {
      int row = row0 + wave * 16 + lq * 4 + r;
#pragma unroll
      for (int nt = 0; nt < 4; nt++) {
        int c = h * 64 + nt * 16 + lr;
        if (m == 0) { ga[r][nt] = bf2f(Pm[(size_t)row * LDP + 928 + c]); gb[r][nt] = p.in[16][l * 256 + c]; }
        else if (m == 2) { ga[r][nt] = bf2f(Pm[(size_t)row * LDP + 2760 + c]); gb[r][nt] = 0.f; }
        else { ga[r][nt] = bf2f(XBC[(size_t)row * 768 + c]); gb[r][nt] = bf2f(Pm[(size_t)row * LDP + 1216 + c]); }
      }
    }
#pragma unroll
    for (int r = 0; r < 4; r++) {
      int row = row0 + wave * 16 + lq * 4 + r;
      if (m == 0) {
        float ss = 0.f;
#pragma unroll
        for (int nt = 0; nt < 4; nt++) ss += o[nt][r] * o[nt][r];
        ss = xor16_sum(ss);
        float rinv = rsqrtf(ss * (1.f / 64.f) + 1e-6f);
#pragma unroll
        for (int nt = 0; nt < 4; nt++) {
          int c = h * 64 + nt * 16 + lr;
          MIX[(size_t)row * 1024 + 256 + c] = f2bf(o[nt][r] * rinv * gb[r][nt] * silu_f(ga[r][nt]));
        }
      } else if (m == 2) {
        float sm = 0.f;
#pragma unroll
        for (int nt = 0; nt < 4; nt++) sm += o[nt][r];
        sm = xor16_sum(sm);
        float mean = sm * (1.f / 64.f);
        float ss = 0.f;
#pragma unroll
        for (int nt = 0; nt < 4; nt++) { float dd = o[nt][r] - mean; ss += dd * dd; }
        ss = xor16_sum(ss);
        float rinv = rsqrtf(ss * (1.f / 64.f) + 1e-6f);
#pragma unroll
        for (int nt = 0; nt < 4; nt++) {
          int c = h * 64 + nt * 16 + lr;
          MIX[(size_t)row * 1024 + 768 + c] = f2bf((o[nt][r] - mean) * rinv * silu_f(ga[r][nt]));
        }
      } else {
        float dsk = p.in[23][l * 4 + h];
        float ss = 0.f;
#pragma unroll
        for (int nt = 0; nt < 4; nt++) {
          int c = h * 64 + nt * 16 + lr;
          float y = (o[nt][r] + dsk * ga[r][nt]) * silu_f(gb[r][nt]);
          u16 yb = f2bf(y);
          float yr = bf2f(yb);
          ss += yr * yr;
          MIX[(size_t)row * 1024 + 512 + c] = yb;
        }
        ss = xor16_sum(ss);
        if (lr == 0) SSQ[(size_t)row * 4 + h] = ss;
      }
    }
  }
}

__device__ __forceinline__ void ph_ln1(const P& p, int l, int nrows) {
  OPAQUE_Z;
  float* xc = (float*)(p.ws + zz + O_XCUR);
  u16* xm = (u16*)(p.ws + zz + O_XMOD);
  const float* MOD = (const float*)(p.ws + zz + O_MOD);
  const int lane = (threadIdx.x + zz) & 63;
  int gw = ((blockIdx.x + zz) * NTHR + (threadIdx.x + zz)) >> 6, nw = ((gridDim.x + zz) * NTHR) >> 6;
  const float* g1 = p.in[26] + l * 1024; const float* b1 = p.in[27] + l * 1024;
  f32x4 gg[4], bb[4];
#pragma unroll
  for (int q = 0; q < 4; q++) { gg[q] = *(const f32x4*)(g1 + q * 256 + lane * 4); bb[q] = *(const f32x4*)(b1 + q * 256 + lane * 4); }
  f32x4 cur[4];
#pragma unroll
  for (int q = 0; q < 4; q++) cur[q] = (gw < nrows) ? *(const f32x4*)(xc + (size_t)gw * 1024 + q * 256 + lane * 4) : (f32x4){0.f, 0.f, 0.f, 0.f};
  for (int row = gw; row < nrows; row += nw) {
    float* xr = xc + (size_t)row * 1024;
    const float* m = MOD + (size_t)(l * 9 + modrow_of(row)) * 6144;
    f32x4 nxt[4], sh[4], sc[4];
    const int rown = row + nw;
#pragma unroll
    for (int q = 0; q < 4; q++) {
      nxt[q] = (rown < nrows) ? *(const f32x4*)(xc + (size_t)rown * 1024 + q * 256 + lane * 4) : (f32x4){0.f, 0.f, 0.f, 0.f};
      sh[q] = *(const f32x4*)(m + 3 * 1024 + q * 256 + lane * 4);
      sc[q] = *(const f32x4*)(m + 4 * 1024 + q * 256 + lane * 4);
    }
    float s = 0.f;
#pragma unroll
    for (int q = 0; q < 4; q++) s += (cur[q][0] + cur[q][1]) + (cur[q][2] + cur[q][3]);
    float mean = wave_sum(s) * (1.f / 1024.f);
    float ss = 0.f;
#pragma unroll
    for (int q = 0; q < 4; q++)
#pragma unroll
      for (int e = 0; e < 4; e++) { float dd = cur[q][e] - mean; ss += dd * dd; }
    float rinv = rsqrtf(wave_sum(ss) * (1.f / 1024.f) + 1e-5f);
#pragma unroll
    for (int q = 0; q < 4; q++) {
      int c = q * 256 + lane * 4;
      f32x4 y;
#pragma unroll
      for (int e = 0; e < 4; e++) y[e] = (cur[q][e] - mean) * rinv * gg[q][e] + bb[q][e];
      *(f32x4*)(xr + c) = y;
      uint2 o; o.x = pack2(y[0] * (1.f + sc[q][0]) + sh[q][0], y[1] * (1.f + sc[q][1]) + sh[q][1]);
      o.y = pack2(y[2] * (1.f + sc[q][2]) + sh[q][2], y[3] * (1.f + sc[q][3]) + sh[q][3]);
      *(uint2*)(xm + (size_t)row * 1024 + c) = o;
    }
#pragma unroll
    for (int q = 0; q < 4; q++) cur[q] = nxt[q];
  }
}

#define TOPK_INSERT(v_, id_)                                   \
  {                                                            \
    float vv_ = (v_); int ii_ = (id_);                         \
    _Pragma("unroll") for (int q_ = 0; q_ < 16; q_++) {        \
      bool gt_ = vv_ > tv[q_];                                 \
      float ov_ = tv[q_]; int oi_ = ti[q_];                    \
      tv[q_] = gt_ ? vv_ : ov_; ti[q_] = gt_ ? ii_ : oi_;      \
      vv_ = gt_ ? ov_ : vv_; ii_ = gt_ ? oi_ : ii_;            \
    }                                                          \
  }

DEV u32 mono_key(float v, u32 mask, int tag) {
  u32 u = __float_as_uint(v);
  u32 k = (u & 0x80000000u) ? ~u : (u | 0x80000000u);
  return (k & ~mask) | (u32)tag;
}
DEV float key_value(u32 k, u32 mask) {
  k &= ~mask;
  u32 u = (k & 0x80000000u) ? (k & 0x7fffffffu) : ~k;
  return __uint_as_float(u);
}
#define MONO_KEY(v_, m_, t_) mono_key((v_), (m_), (t_))
#define KEY_VALUE(k_, m_) key_value((k_), (m_))
#define KEY_INSERT(k_)                                         \
  {                                                            \
    u32 kk_ = (k_);                                            \
    _Pragma("unroll") for (int q_ = 0; q_ < 16; q_++) {        \
      u32 hi_ = max(tk[q_], kk_);                              \
      kk_ = min(tk[q_], kk_);                                  \
      tk[q_] = hi_;                                            \
    }                                                          \
  }
typedef float f32x2 __attribute__((ext_vector_type(2)));
#define DOT8(acc_, w_, x0_, x1_, x2_, x3_)                                          \
  {                                                                                 \
    f32x2 lo_ = __builtin_amdgcn_cvt_pk_f32_fp8((int)(w_), false);                  \
    f32x2 hi_ = __builtin_amdgcn_cvt_pk_f32_fp8((int)(w_), true);                   \
    acc_ += x0_ * lo_[0]; acc_ += x1_ * lo_[1]; acc_ += x2_ * hi_[0]; acc_ += x3_ * hi_[1]; \
  }
#define AXPY8(a_, w_, f0_, f1_, f2_, f3_)                                           \
  {                                                                                 \
    f32x2 lo_ = __builtin_amdgcn_cvt_pk_f32_fp8((int)(w_), false);                  \
    f32x2 hi_ = __builtin_amdgcn_cvt_pk_f32_fp8((int)(w_), true);                   \
    f0_ += a_ * lo_[0]; f1_ += a_ * lo_[1]; f2_ += a_ * hi_[0]; f3_ += a_ * hi_[1]; \
  }
#define PEER_LOAD(U_, V_, G_, SU_, SV_, e0_)                                        \
  _Pragma("unroll") for (int q_ = 0; q_ < 4; q_++) {                                \
    int e_ = sE[tok * 128 + (e0_) + q_];                                            \
    G_[q_] = sG[tok * 128 + (e0_) + q_];                                            \
    SU_[q_] = sSU[tok * 128 + (e0_) + q_];                                          \
    SV_[q_] = sSV[tok * 128 + (e0_) + q_];                                          \
    U_[q_] = *(const u32x4*)(UB + (size_t)e_ * 1024 + lane * 16);                   \
    V_[q_] = *(const u32x4*)(VB + (size_t)e_ * 1024 + lane * 16);                   \
  }
#define PEER_COMPUTE(U_, V_, G_, SU_, SV_)                                          \
  _Pragma("unroll") for (int q_ = 0; q_ < 4; q_++) {                                \
    float d_ = 0.f;                                                                 \
    DOT8(d_, U_[q_][0], xv[0], xv[1], xv[2], xv[3]);                                \
    DOT8(d_, U_[q_][1], xv[4], xv[5], xv[6], xv[7]);                                \
    DOT8(d_, U_[q_][2], xv[8], xv[9], xv[10], xv[11]);                              \
    DOT8(d_, U_[q_][3], xv[12], xv[13], xv[14], xv[15]);                            \
    d_ = wave_sum(d_) * SU_[q_];                                                    \
    float act_ = 0.5f * d_ * (1.f + erff(d_ * 0.7071067811865476f)) * G_[q_] * SV_[q_]; \
    AXPY8(act_, V_[q_][0], f[0], f[1], f[2], f[3]);                                 \
    AXPY8(act_, V_[q_][1], f[4], f[5], f[6], f[7]);                                 \
    AXPY8(act_, V_[q_][2], f[8], f[9], f[10], f[11]);                               \
    AXPY8(act_, V_[q_][3], f[12], f[13], f[14], f[15]);                             \
  }

__device__ __forceinline__ void ph_peer(const P& p, int l, int nrows, char* smem, int dryc) {
  OPAQUE_Z;
  const int dry = zz + dryc;
  const u16* SC = (const u16*)(p.ws + zz + O_P);
  float* xc = (float*)(p.ws + zz + O_XCUR);
  u16* xm = (u16*)(p.ws + zz + O_XMOD);
  const float* MOD = (const float*)(p.ws + zz + O_MOD);
  const unsigned char* UB = (const unsigned char*)(p.ws + zz + O_UBF) + (size_t)l * 16384 * 1024;
  const unsigned char* VB = (const unsigned char*)(p.ws + zz + O_VBF) + (size_t)l * 16384 * 1024;
  const float* USC = (const float*)(p.ws + zz + O_USC) + l * 16384;
  const float* VSC = (const float*)(p.ws + zz + O_VSC) + l * 16384;
  float* sLV = (float*)smem;
  int* sLI = (int*)(smem + 16384);
  int* sE = (int*)(smem + 32768);
  float* sG = (float*)(smem + 40960);
  float* sSU = (float*)(smem + 49152);
  float* sSV = (float*)(smem + 57344);
  const int tid = (threadIdx.x + zz), lane = tid & 63, wave = tid >> 6;
  const float* g2 = p.in[32] + l * 1024; const float* b2 = p.in[33] + l * 1024;
  const int ntok = (nrows == T_ALL) ? 12 : 16;
  const int ngroups = nrows / ntok;
  for (int grp = (blockIdx.x + zz); grp < ngroups; grp += (gridDim.x + zz)) {
    int rowb = grp * ntok;
    __syncthreads();
    if (tid < ntok * 16) {
      int tok = tid >> 4, lst = tid & 15;
      const u32x4* s4 = (const u32x4*)(SC + (size_t)(rowb + tok) * 2048 + lst * 128);
      u32 tk[16];
#pragma unroll
      for (int q = 0; q < 16; q++) tk[q] = 0u;
      u32x4 cur[4], nxt[4];
#pragma unroll
      for (int q = 0; q < 4; q++) { cur[q] = s4[q]; nxt[q] = cur[q]; }
#pragma unroll 1
      for (int c0 = 0; c0 < 16; c0 += 4) {
        if (c0 + 4 < 16) {
#pragma unroll
          for (int q = 0; q < 4; q++) nxt[q] = s4[c0 + 4 + q];
        }
#pragma unroll
        for (int q = 0; q < 4; q++) {
          const int c = c0 + q;
          const u32x4 sv = cur[q];
#pragma unroll
          for (int e = 0; e < 4; e++) {
            KEY_INSERT(MONO_KEY(lo2f(sv[e]), 127u, 127 - (c * 8 + e * 2 + 0)));
            KEY_INSERT(MONO_KEY(hi2f(sv[e]), 127u, 127 - (c * 8 + e * 2 + 1)));
          }
        }
#pragma unroll
        for (int q = 0; q < 4; q++) cur[q] = nxt[q];
      }
#pragma unroll
      for (int q = 0; q < 16; q++) { sLV[tid * 16 + q] = KEY_VALUE(tk[q], 127u); sLI[tid * 16 + q] = 127 - (int)(tk[q] & 127u); }
    }
    __syncthreads();
    if (tid < ntok * 8) {
      int tok = tid >> 3, h = tid & 7;
      const float* v1 = sLV + (tok * 16 + h * 2) * 16; const float* v2 = v1 + 16;
      const int* i1 = sLI + (tok * 16 + h * 2) * 16; const int* i2 = i1 + 16;
      float a1[16], a2[16];
#pragma unroll
      for (int q = 0; q < 16; q++) { a1[q] = v1[q]; a2[q] = v2[q]; }
      u32 tk[16];
#pragma unroll
      for (int q = 0; q < 16; q++) tk[q] = 0u;
#pragma unroll
      for (int a = 0; a < 16; a++) {
#pragma unroll
        for (int bq = 0; bq < 16; bq++) {
          if ((a + 1) * (bq + 1) <= 16) { KEY_INSERT(MONO_KEY(a1[a] + a2[bq], 255u, 255 - (a * 16 + bq))); }
        }
      }
      float mx = KEY_VALUE(tk[0], 255u); float sum = 0.f; float ex[16];
#pragma unroll
      for (int q = 0; q < 16; q++) { ex[q] = __expf(KEY_VALUE(tk[q], 255u) - mx); sum += ex[q]; }
      float inv = 1.f / sum;
#pragma unroll
      for (int q = 0; q < 16; q++) {
        int ci = 255 - (int)(tk[q] & 255u);
        int e = i1[ci >> 4] * 128 + i2[ci & 15];
        sE[tok * 128 + h * 16 + q] = e;
        sG[tok * 128 + h * 16 + q] = ex[q] * inv;
        sSU[tok * 128 + h * 16 + q] = USC[e];
        sSV[tok * 128 + h * 16 + q] = VSC[e];
      }
    }
    __syncthreads();
    int* sE2 = (int*)smem;
    float* sGV2 = (float*)(smem + 8192);
    float* sSU2 = (float*)(smem + 16384);
    int* sCnt = (int*)(smem + 24576);
    {
#pragma unroll 1
      for (int i = tid; i < ntok * 128; i += NTHR) {
        int key = sE[i] >> 11;
#pragma unroll
        for (int sl = 0; sl < 8; sl++) {
          unsigned long long mk = __ballot(key == sl);
          if (lane == sl) sCnt[(i >> 6) * 8 + sl] = __popcll(mk);
        }
      }
      __syncthreads();
#pragma unroll 1
      for (int i = tid; i < ntok * 128; i += NTHR) {
        int tok = i >> 7, half = (i >> 6) & 1;
        int e = sE[i]; int key = e >> 11;
        int within = 0;
#pragma unroll
        for (int sl = 0; sl < 8; sl++) {
          unsigned long long mk = __ballot(key == sl);
          if (key == sl) within = __popcll(mk & ((1ull << lane) - 1ull));
        }
        const int* c0 = sCnt + tok * 16; const int* c1 = c0 + 8;
        int base = half ? c0[key] : 0;
#pragma unroll
        for (int sl = 0; sl < 8; sl++) base += (sl < key) ? (c0[sl] + c1[sl]) : 0;
        int dst = tok * 128 + base + within;
        sE2[dst] = e; sGV2[dst] = sG[i] * sSV[i]; sSU2[dst] = sSU[i];
      }
    }
    __syncthreads();
    {
      const int n = ntok >> 2;
      unsigned char* sX8 = (unsigned char*)(smem + 32768);
      const int lr = lane & 15, lq = lane >> 4;
      int vz; asm volatile("v_mov_b32 %0, 0" : "=v"(vz));
      float* sQinv = (float*)(smem + 24576 + 1024);
#pragma unroll 1
      for (int tk = 0; tk < n; tk++) {
        int row = rowb + wave * n + tk;
        float xv[16];
        u32x4 a = *(const u32x4*)(xm + (size_t)row * 1024 + lane * 16);
        u32x4 bq = *(const u32x4*)(xm + (size_t)row * 1024 + lane * 16 + 8);
        unpack8(a, xv); unpack8(bq, xv + 8);
        float am = 0.f;
#pragma unroll
        for (int i = 0; i < 16; i++) am = fmaxf(am, fabsf(xv[i]));
        am = fmaxf(am, __shfl_xor(am, 1, 64)); am = fmaxf(am, __shfl_xor(am, 2, 64)); am = fmaxf(am, __shfl_xor(am, 4, 64));
        am = fmaxf(am, __shfl_xor(am, 8, 64)); am = fmaxf(am, __shfl_xor(am, 16, 64)); am = fmaxf(am, __shfl_xor(am, 32, 64));
        float qs = am > 0.f ? 240.f / am : 1.f;
        if (lane == 0) sQinv[wave * 4 + tk] = am > 0.f ? am * (1.f / 240.f) : 1.f;
        u32x4 x8; int w;
#pragma unroll
        for (int i = 0; i < 4; i++) {
          w = 0;
          w = __builtin_amdgcn_cvt_pk_fp8_f32(xv[i * 4 + 0] * qs, xv[i * 4 + 1] * qs, w, false);
          w = __builtin_amdgcn_cvt_pk_fp8_f32(xv[i * 4 + 2] * qs, xv[i * 4 + 3] * qs, w, true);
          x8[i] = (u32)w;
        }
        *(u32x4*)(sX8 + (wave * 4 + tk) * 1024 + lane * 16) = x8;
      }
#define PEER_ACCV(V_, q0_)                                                            \
  _Pragma("unroll") for (int q_ = 0; q_ < 8; q_++) {                                  \
    float a_ = sGV2[nb + (q0_) + q_ + vz];                                            \
    f32x2 a2_ = (f32x2){a_, a_};                                                      \
    _Pragma("unroll") for (int i_ = 0; i_ < 4; i_++) {                                \
      f32x2 lo_ = __builtin_amdgcn_cvt_pk_f32_fp8((int)V_[q_][i_], false);            \
      f32x2 hi_ = __builtin_amdgcn_cvt_pk_f32_fp8((int)V_[q_][i_], true);             \
      f2[j][i_ * 2] += lo_ * a2_; f2[j][i_ * 2 + 1] += hi_ * a2_;                     \
    }                                                                                 \
  }
      {
        const int nit = 8 * n;
        u32x4 bA[16], bB[16];
#define PEER_ULOAD(B_, it_)                                                                   \
  {                                                                                           \
    const int c_ = (it_) / n, tk_ = (it_) - c_ * n;                                           \
    const int nb_ = (wave * n + tk_) * 128 + c_ * 16;                                         \
    const unsigned ub_ = (unsigned)sE2[nb_ + lr] * 1024u + (unsigned)(lq * 16);               \
    _Pragma("unroll") for (int kc_ = 0; kc_ < 16; kc_++) B_[kc_] = *(const u32x4*)(UB + (ub_ + (unsigned)(kc_ * 64))); \
  }
#define PEER_UCOMP(B_, it_)                                                                   \
  {                                                                                           \
    const int c_ = (it_) / n, tk_ = (it_) - c_ * n;                                           \
    const int nb_ = (wave * n + tk_) * 128 + c_ * 16;                                         \
    f32x4 acc_ = (f32x4){0.f, 0.f, 0.f, 0.f};                                                 \
    const unsigned char* xa_ = sX8 + (wave * 4 + tk_) * 1024 + lq * 16;                       \
    _Pragma("unroll") for (int kc_ = 0; kc_ < 16; kc_++) {                                    \
      u32x4 a_ = *(const u32x4*)(xa_ + kc_ * 64);                                             \
      long alo_ = (long)(((unsigned long)a_[1] << 32) | (unsigned long)a_[0]);                \
      long ahi_ = (long)(((unsigned long)a_[3] << 32) | (unsigned long)a_[2]);                \
      long blo_ = (long)(((unsigned long)B_[kc_][1] << 32) | (unsigned long)B_[kc_][0]);      \
      long bhi_ = (long)(((unsigned long)B_[kc_][3] << 32) | (unsigned long)B_[kc_][2]);      \
      acc_ = __builtin_amdgcn_mfma_f32_16x16x32_fp8_fp8(alo_, blo_, acc_, 0, 0, 0);           \
      acc_ = __builtin_amdgcn_mfma_f32_16x16x32_fp8_fp8(ahi_, bhi_, acc_, 0, 0, 0);           \
    }                                                                                         \
    float d_ = acc_[0] * sQinv[wave * 4 + tk_] * sSU2[nb_ + lr];                              \
    float act_ = 0.5f * d_ * (1.f + erff(d_ * 0.7071067811865476f)) * sGV2[nb_ + lr];         \
    if (lq == 0) sGV2[nb_ + lr] = act_;                                                       \
  }
        PEER_ULOAD(bA, 0);
#pragma unroll 1
        for (int it = 0; it < nit; it += 2) {
          PEER_ULOAD(bB, it + 1);
          PEER_UCOMP(bA, it);
          if (it + 2 < nit) { PEER_ULOAD(bA, it + 2); }
          PEER_UCOMP(bB, it + 1);
        }
      }
#pragma unroll 1
      for (int t0 = 0; t0 < n; t0 += 2) {
        f32x2 f2[2][8];
#pragma unroll
        for (int j = 0; j < 2; j++)
#pragma unroll
          for (int i = 0; i < 8; i++) f2[j][i] = (f32x2){0.f, 0.f};
        {
          u32x4 vA[8], vB[8];
#define PEER_VLOAD(V_, c_, j_, h_)                                                            \
  if (t0 + (j_) < n) {                                                                        \
    const int nb_ = (wave * n + t0 + (j_)) * 128 + (c_) * 16 + (h_) * 8;                      \
    _Pragma("unroll") for (int q_ = 0; q_ < 8; q_++) {                                        \
      unsigned e_ = (unsigned)sE2[nb_ + q_ + vz];                                             \
      V_[q_] = *(const u32x4*)(VB + (e_ * 1024u + (unsigned)(lane * 16)));                    \
    }                                                                                         \
  }
#define PEER_VCOMP(V_, c_, j_, h_)                                                            \
  if (t0 + (j_) < n) {                                                                        \
    const int nb_ = (wave * n + t0 + (j_)) * 128 + (c_) * 16 + (h_) * 8;                      \
    _Pragma("unroll") for (int q_ = 0; q_ < 8; q_++) {                                        \
      float a_ = sGV2[nb_ + q_ + vz];                                                         \
      f32x2 a2_ = (f32x2){a_, a_};                                                            \
      _Pragma("unroll") for (int i_ = 0; i_ < 4; i_++) {                                      \
        f32x2 lo_ = __builtin_amdgcn_cvt_pk_f32_fp8((int)V_[q_][i_], false);                  \
        f32x2 hi_ = __builtin_amdgcn_cvt_pk_f32_fp8((int)V_[q_][i_], true);                   \
        f2[j_][i_ * 2] += lo_ * a2_; f2[j_][i_ * 2 + 1] += hi_ * a2_;                         \
      }                                                                                       \
    }                                                                                         \
  }
          PEER_VLOAD(vA, 0, 0, 0);
#pragma unroll 1
          for (int c = 0; c < 8; c++) {
            PEER_VLOAD(vB, c, 0, 1);
            PEER_VCOMP(vA, c, 0, 0);
            PEER_VLOAD(vA, c, 1, 0);
            PEER_VCOMP(vB, c, 0, 1);
            PEER_VLOAD(vB, c, 1, 1);
            PEER_VCOMP(vA, c, 1, 0);
            if (c + 1 < 8) { PEER_VLOAD(vA, c + 1, 0, 0); }
            PEER_VCOMP(vB, c, 1, 1);
          }
        }
#pragma unroll
        for (int j = 0; j < 2; j++) {
          const int tk = t0 + j;
          if (tk < n) {
            int row = rowb + wave * n + tk;
            float f[16];
#pragma unroll
            for (int i = 0; i < 8; i++) { f[2 * i] = f2[j][i][0]; f[2 * i + 1] = f2[j][i][1]; }
          const float* m = MOD + (size_t)(l * 9 + modrow_of(row)) * 6144;
          float tt[16];
          float* xr = xc + (size_t)row * 1024;
#pragma unroll
          for (int q = 0; q < 4; q++) {
            int c = lane * 16 + q * 4;
            float4 x4 = *(const float4*)(xr + c); float4 g5 = *(const float4*)(m + 5 * 1024 + c);
            tt[q * 4 + 0] = ALPHA * x4.x + g5.x * f[q * 4 + 0];
            tt[q * 4 + 1] = ALPHA * x4.y + g5.y * f[q * 4 + 1];
            tt[q * 4 + 2] = ALPHA * x4.z + g5.z * f[q * 4 + 2];
            tt[q * 4 + 3] = ALPHA * x4.w + g5.w * f[q * 4 + 3];
          }
          float sm = 0.f;
#pragma unroll
          for (int i = 0; i < 16; i++) sm += tt[i];
          float mean = wave_sum(sm) * (1.f / 1024.f);
          float ss = 0.f;
#pragma unroll
          for (int i = 0; i < 16; i++) { float dd = tt[i] - mean; ss += dd * dd; }
          float rinv = rsqrtf(wave_sum(ss) * (1.f / 1024.f) + 1e-5f);
          const float* mn = MOD + (size_t)((l + 1 < 4 ? l + 1 : 3) * 9 + modrow_of(row)) * 6144;
          f32x4 gg4[4], bb4[4], sh4[4], sc4[4];
#pragma unroll
          for (int q = 0; q < 4; q++) {
            int c = lane * 16 + q * 4;
            gg4[q] = *(const f32x4*)(g2 + c); bb4[q] = *(const f32x4*)(b2 + c);
            sh4[q] = *(const f32x4*)(mn + c); sc4[q] = *(const f32x4*)(mn + 1024 + c);
          }
#pragma unroll
          for (int q = 0; q < 4; q++) {
            int c = lane * 16 + q * 4;
            float4 y;
            y.x = (tt[q * 4 + 0] - mean) * rinv * gg4[q][0] + bb4[q][0];
            y.y = (tt[q * 4 + 1] - mean) * rinv * gg4[q][1] + bb4[q][1];
            y.z = (tt[q * 4 + 2] - mean) * rinv * gg4[q][2] + bb4[q][2];
            y.w = (tt[q * 4 + 3] - mean) * rinv * gg4[q][3] + bb4[q][3];
            if (dry) {
            } else if (l == 3) {
              *(float4*)(p.out + (size_t)row * 1024 + c) = y;
            } else {
              *(float4*)(xr + c) = y;
              uint2 o; o.x = pack2(y.x * (1.f + sc4[q][0]) + sh4[q][0], y.y * (1.f + sc4[q][1]) + sh4[q][1]);
              o.y = pack2(y.z * (1.f + sc4[q][2]) + sh4[q][2], y.w * (1.f + sc4[q][3]) + sh4[q][3]);
              *(uint2*)(xm + (size_t)row * 1024 + c) = o;
            }
          }
          }
        }
      }
    }
  }
}

#define XB_TMO      128
#define XB_XCNT(j)  (256  + 64 * (j))
#define XB_XSUB(j)  (1280 + 64 * (j))
#define XB_XGEN(j)  (2304 + 64 * (j))
#define XB_TOP      3328
#define XB_TOPGEN   3392
#define XCD_BAR_WORDS 3456
#define XB_SPIN_CAP (1u << 20)
DEV unsigned xb_ld(unsigned* p) { return __hip_atomic_load(p, __ATOMIC_RELAXED, __HIP_MEMORY_SCOPE_AGENT); }
DEV unsigned xb_add(unsigned* p, unsigned v) { return __hip_atomic_fetch_add(p, v, __ATOMIC_RELAXED, __HIP_MEMORY_SCOPE_AGENT); }
DEV unsigned xb_xcc_id() { return (unsigned)__builtin_amdgcn_s_getreg((3 << 11) | 20) & 0xFu; }
#define XB_SPIN(cond, bar) do { unsigned _sp = 0; while (cond) { __builtin_amdgcn_s_sleep(1); \
    if ((++_sp & 255u) == 0u) { if (xb_ld(&(bar)[XB_TMO])) break; if (_sp > XB_SPIN_CAP) { atomicAdd(&(bar)[XB_TMO], 1u); break; } } } } while (0)
struct XcdBarrier { unsigned* bar; unsigned x; unsigned nloc, nx; };
DEV XcdBarrier xcd_barrier_post(unsigned* bar) {
  XcdBarrier b; b.bar = bar; b.x = xb_xcc_id(); b.nloc = 0u; b.nx = 0u;
  if (threadIdx.x == 0) (void)xb_add(&bar[XB_XCNT(b.x)], 1u);
  return b;
}
DEV void xcd_barrier_complete(unsigned* bar, unsigned x, unsigned& nloc, unsigned& nx) {
  const unsigned G = gridDim.x;
  unsigned sum, cnt, mine, sp = 0u;
  for (;;) {
    sum = 0u; cnt = 0u; mine = 0u;
#pragma unroll
    for (unsigned j = 0; j < 16; ++j) { const unsigned c = xb_ld(&bar[XB_XCNT(j)]); sum += c; cnt += (c > 0u) ? 1u : 0u; mine = (j == x) ? c : mine; }
    if (sum == G) break;
    __builtin_amdgcn_s_sleep(1);
    if ((++sp & 255u) == 0u) { if (xb_ld(&bar[XB_TMO])) break; if (sp > XB_SPIN_CAP) { atomicAdd(&bar[XB_TMO], 1u); break; } }
  }
  nloc = mine > 0u ? mine : 1u; nx = cnt > 0u ? cnt : 1u;
}
DEV void xcd_barrier(XcdBarrier& b) {
  asm volatile("s_waitcnt vmcnt(0)" ::: "memory");
  __syncthreads();
  if (threadIdx.x == 0) {
    unsigned* bar = b.bar;
    __builtin_amdgcn_s_waitcnt(0);
    unsigned nloc = b.nloc, nx = b.nx;
    if (nloc == 0u) { xcd_barrier_complete(bar, b.x, nloc, nx); b.nloc = nloc; b.nx = nx; }
    const unsigned old = xb_add(&bar[XB_XSUB(b.x)], 1u);
    const unsigned gen = old / nloc;
    if (old + 1u == (gen + 1u) * nloc) {
      __builtin_amdgcn_fence(__ATOMIC_RELEASE, "agent");
      asm volatile("s_waitcnt vmcnt(0)" ::: "memory");
      const unsigned og = xb_add(&bar[XB_TOP], 1u);
      const unsigned tg = og / nx;
      if (og + 1u == (tg + 1u) * nx) xb_add(&bar[XB_TOPGEN], 1u);
      else XB_SPIN(xb_ld(&bar[XB_TOPGEN]) == tg, bar);
      __builtin_amdgcn_fence(__ATOMIC_ACQUIRE, "agent");
      xb_add(&bar[XB_XGEN(b.x)], 1u);
      asm volatile("s_waitcnt vmcnt(0)" ::: "memory");
    } else {
      XB_SPIN(xb_ld(&bar[XB_XGEN(b.x)]) == gen, bar);
      __builtin_amdgcn_fence(__ATOMIC_ACQUIRE, "agent");
      asm volatile("s_waitcnt vmcnt(0)" ::: "memory");
    }
  }
  __syncthreads();
}

#define KARGP(z_) ((const P*)(const void*)((const __attribute__((address_space(4))) char*)__builtin_amdgcn_kernarg_segment_ptr() + (z_)))
__global__ void __launch_bounds__(NTHR, 2) mega(P p) {
  cg::grid_group grid = cg::this_grid();
  __shared__ __attribute__((aligned(16))) char smem[65536];
  if (blockIdx.x == 0) { unsigned* bw = (unsigned*)(p.ws + O_BAR); for (int i = threadIdx.x; i < 3456; i += NTHR) bw[i] = 0u; }
  {
    OPAQUE_Z; const P& q = *KARGP(zz);
    ph_mod(q, smem);
    ph_convert(q, smem);
  }
  grid.sync();
  XcdBarrier xb = xcd_barrier_post((unsigned*)(p.ws + O_BAR));
#pragma unroll 1
  for (int st = -1; st < 40; st++) {
    const int l = st < 0 ? 0 : st / 10;
    const int ph = st < 0 ? -1 : st - l * 10;
    const int need_ctx = l < 3;
    const int nrows = need_ctx ? T_ALL : T_LAT;
    switch (ph) {
      case -1: {
        OPAQUE_Z; const P& q = *KARGP(zz);
        ph_fold(q, smem);
        ph_xinit(q);
        break;
      }
      case 0: {
        OPAQUE_Z; const P& q = *KARGP(zz);
        gemm_phase<EPI_BF16>(q, l, (const u16*)(q.ws + O_XMOD), 1024, (const u16*)(q.ws + O_WINT) + (size_t)l * 3072 * 1024, 1024, 1024,
                             T_ALL / 128, 24, (void*)(q.ws + O_P), LDP, smem);
        break;
      }
      case 1: {
        OPAQUE_Z; const P& q = *KARGP(zz);
        gemm_phase<EPI_Q>(q, l, (const u16*)(q.ws + O_P), LDP, (const u16*)(q.ws + O_WUQT) + (size_t)l * 384 * 256, 256, 256,
                          T_ALL / 128, 3, nullptr, 0, smem);
        gemm_phase<EPI_KV>(q, l, (const u16*)(q.ws + O_P) + 256, LDP, (const u16*)(q.ws + O_WUKVT) + (size_t)l * 512 * 128, 128, 128,
                           T_ALL / 128, 4, nullptr, 0, smem);
        ph_prep(q, l, smem);
        break;
      }
      case 2: {
        OPAQUE_Z; const P& q = *KARGP(zz);
        ph_scan1(q, smem);
        break;
      }
      case 3: {
        OPAQUE_Z; const P& q = *KARGP(zz);
        ph_scan2(q);
        ph_attn(q, need_ctx, smem);
        break;
      }
      case 4: {
        OPAQUE_Z; const P& q = *KARGP(zz);
        ph_scan3(q, l, need_ctx, smem);
        break;
      }
      case 5: {
        OPAQUE_Z; const P& q = *KARGP(zz);
        gemm_phase<EPI_OUT>(q, l, (const u16*)(q.ws + O_MIX), 1024, (const u16*)(q.ws + O_WOUTT) + (size_t)l * 1024 * 1024, 1024, 1024,
                            nrows / 128, 8, nullptr, 0, smem);
        break;
      }
      case 6: {
        OPAQUE_Z; const P& q = *KARGP(zz);
        ph_ln1(q, l, nrows);
        break;
      }
      case 7: {
        OPAQUE_Z; const P& q = *KARGP(zz);
        gemm_phase<EPI_BF16>(q, l, (const u16*)(q.ws + O_XMOD), 1024, (const u16*)(q.ws + O_WPT) + (size_t)l * 2048 * 1024, 1024, 1024,
                             nrows / 128, 16, (void*)(q.ws + O_P), 2048, smem);
        break;
      }
      case 8: {
        OPAQUE_Z; const P& q = *KARGP(zz);
        ph_peer(q, l, nrows, smem, 0);
        break;
      }
      default:
        break;
    }
    if (ph != 9) xcd_barrier(xb);
  }
}

extern "C" void kernel_launch(void* const* d_in, const int* in_sizes, int n_in, void* d_out, int out_size, void* d_ws,
                              size_t ws_size, hipStream_t stream) {
  static int grid_blocks = 0;
  if (!grid_blocks) {
    int dev = 0, cus = 0, per_cu = 0;
    (void)hipGetDevice(&dev);
    (void)hipDeviceGetAttribute(&cus, hipDeviceAttributeMultiprocessorCount, dev);
    (void)hipOccupancyMaxActiveBlocksPerMultiprocessor(&per_cu, mega, NTHR, 0);
    if (per_cu > 2) per_cu = 2;
    if (per_cu < 1) per_cu = 1;
    grid_blocks = cus * per_cu;
  }
  if (ws_size < WS_TOTAL) { fprintf(stderr, "workspace too small: %zu < %zu\n", ws_size, (size_t)WS_TOTAL); return; }
  P p{};
  for (int i = 0; i < 34; i++) p.in[i] = (const float*)d_in[i];
  p.out = (float*)d_out;
  p.ws = (char*)d_ws;
  void* args[] = {&p};
  hipError_t e = hipLaunchCooperativeKernel((void*)mega, dim3(grid_blocks), dim3(NTHR), args, 0, stream);
  if (e != hipSuccess) fprintf(stderr, "cooperative launch failed: %s (grid %d)\n", hipGetErrorString(e), grid_blocks);
}
```

```cpp
#include <hip/hip_runtime.h>
#include <hip/hip_cooperative_groups.h>
#include <cstdio>
namespace cg = cooperative_groups;

#define DEV __device__ __forceinline__
typedef unsigned short u16;
typedef unsigned int u32;
typedef short bf16x8 __attribute__((ext_vector_type(8)));
typedef float f32x4 __attribute__((ext_vector_type(4)));
typedef unsigned int u32x4 __attribute__((ext_vector_type(4)));

#define T_ALL 18432
#define T_LAT 16384
#define LDP 3072
#define ALPHA 1.681792830507429f
#define NTHR 256
#ifndef PROBE_REP
#define PROBE_REP 0
#endif

constexpr size_t al(size_t x) { return (x + 255) & ~(size_t)255; }
constexpr size_t O_MOD = 0;
constexpr size_t O_AXC = al(O_MOD + 4ull * 9 * 6144 * 4);
constexpr size_t O_AXS = al(O_AXC + 64 * 8 * 4);
constexpr size_t O_RC = al(O_AXS + 64 * 8 * 4);
constexpr size_t O_RS = al(O_RC + 2048 * 16 * 4);
constexpr size_t O_WINT = al(O_RS + 2048 * 16 * 4);
constexpr size_t O_WUQT = al(O_WINT + 4ull * 3072 * 1024 * 2);
constexpr size_t O_WUKVT = al(O_WUQT + 4ull * 384 * 256 * 2);
constexpr size_t O_WOUTT = al(O_WUKVT + 4ull * 512 * 128 * 2);
constexpr size_t O_WQBF = al(O_WOUTT + 4ull * 1024 * 1024 * 2);
constexpr size_t O_KEYBF = al(O_WQBF + 4ull * 1024 * 2048 * 2);
constexpr size_t O_WPT = al(O_KEYBF + 4ull * 2 * 128 * 128 * 2);
constexpr size_t O_UBF = al(O_WPT + 4ull * 2048 * 1024 * 2);
constexpr size_t O_VBF = al(O_UBF + 4ull * 16384 * 1024);
constexpr size_t O_USC = al(O_VBF + 4ull * 16384 * 1024);
constexpr size_t O_VSC = al(O_USC + 4ull * 16384 * 4);
constexpr size_t O_XCUR = al(O_VSC + 4ull * 16384 * 4);
constexpr size_t O_XMOD = al(O_XCUR + (size_t)T_ALL * 1024 * 4);
constexpr size_t O_MIX = al(O_XMOD + (size_t)T_ALL * 1024 * 2);
constexpr size_t O_P = al(O_MIX + (size_t)T_ALL * 1024 * 2);
constexpr size_t O_QB = al(O_P + (size_t)T_ALL * 2048 * 4);
constexpr size_t O_KN = al(O_QB + (size_t)T_ALL * 384 * 2);
constexpr size_t O_VT = al(O_KN + (size_t)T_ALL * 256 * 2);
constexpr size_t O_KR = al(O_VT + 8ull * 4 * 64 * 2304 * 2);
constexpr size_t O_LGG = al(O_KR + (size_t)T_ALL * 32 * 2);
constexpr size_t O_XBC = al(O_LGG + 2ull * T_ALL * 128 * 4);
constexpr size_t O_DT = al(O_XBC + (size_t)T_ALL * 768 * 2);
constexpr size_t O_LA = al(O_DT + 2ull * T_ALL * 4 * 4);
constexpr size_t O_QKR = al(O_LA + 2ull * T_ALL * 4 * 4);
constexpr size_t O_SLOC = al(O_QKR + (size_t)T_ALL * 256 * 2);
constexpr size_t SLOC_G = 0, SLOC_S = 2304ull * 2048, SLOC_R = SLOC_S + 2304ull * 8192;
constexpr size_t O_DEC = al(O_SLOC + (SLOC_R + 2304ull * 2048) * 4);
constexpr size_t DEC_G = 0, DEC_S = 2304 * 32, DEC_R = DEC_S + 2304;
constexpr size_t O_SIN = al(O_DEC + (DEC_R + 2304) * 4);
constexpr size_t O_SSQ = al(O_SIN + (SLOC_R + 2304ull * 2048) * 2);
constexpr size_t O_BAR = al(O_SSQ + (size_t)T_ALL * 4 * 4);
constexpr size_t WS_TOTAL = al(O_BAR + 3456 * 4);

struct P {
  const float* in[34];
  float* out;
  char* ws;
};

DEV u16 f2bf_sw(float f) { u32 u = __float_as_uint(f); u += 0x7fffu + ((u >> 16) & 1u); return (u16)(u >> 16); }
DEV float bf2f(u16 h) { return __uint_as_float(((u32)h) << 16); }
typedef float f32x2_t __attribute__((ext_vector_type(2)));
typedef __bf16 bf16x2_t __attribute__((ext_vector_type(2)));
DEV u32 pack2(float a, float b) {
  f32x2_t v = {a, b};
  bf16x2_t r = __builtin_convertvector(v, bf16x2_t);
  return __builtin_bit_cast(u32, r);
}
DEV u16 f2bf(float f) { return (u16)(pack2(f, 0.f) & 0xffffu); }
DEV float lo2f(u32 w) { return __uint_as_float(w << 16); }
DEV float hi2f(u32 w) { return __uint_as_float(w & 0xffff0000u); }
DEV float silu_f(float x) { return x / (1.f + __expf(-x)); }
DEV float softplus_f(float x) { return fmaxf(x, 0.f) + log1pf(expf(-fabsf(x))); }
DEV int modrow_of(int row) { return row < T_LAT ? (row >> 11) : 8; }
DEV int tpos_of(int row) { return row < T_LAT ? (row & 2047) : ((row - T_LAT) & 255); }
DEV int chunk_row0(int b, int gc) { return gc < 4 ? (T_LAT + b * 256 + gc * 64) : (b * 2048 + (gc - 4) * 64); }
DEV f32x4 mfma16(bf16x8 a, bf16x8 b, f32x4 c) { return __builtin_amdgcn_mfma_f32_16x16x32_bf16(a, b, c, 0, 0, 0); }
DEV float xor16_sum(float v) {
  v += __shfl_xor(v, 1, 64); v += __shfl_xor(v, 2, 64); v += __shfl_xor(v, 4, 64); v += __shfl_xor(v, 8, 64); return v;
}
DEV float xor16_max(float v) {
  v = fmaxf(v, __shfl_xor(v, 1, 64)); v = fmaxf(v, __shfl_xor(v, 2, 64)); v = fmaxf(v, __shfl_xor(v, 4, 64)); v = fmaxf(v, __shfl_xor(v, 8, 64)); return v;
}
#define OPAQUE_Z int zz; asm volatile("s_mov_b32 %0, 0" : "=s"(zz))
DEV float wave_sum(float v) {
  v += __shfl_xor(v, 1, 64); v += __shfl_xor(v, 2, 64); v += __shfl_xor(v, 4, 64); v += __shfl_xor(v, 8, 64);
  v += __shfl_xor(v, 16, 64); v += __shfl_xor(v, 32, 64); return v;
}

DEV void unpack8(u32x4 w, float* o) {
  o[0] = lo2f(w[0]); o[1] = hi2f(w[0]); o[2] = lo2f(w[1]); o[3] = hi2f(w[1]);
  o[4] = lo2f(w[2]); o[5] = hi2f(w[2]); o[6] = lo2f(w[3]); o[7] = hi2f(w[3]);
}
DEV u32x4 pack8(const float* o) {
  u32x4 w; w[0] = pack2(o[0], o[1]); w[1] = pack2(o[2], o[3]); w[2] = pack2(o[4], o[5]); w[3] = pack2(o[6], o[7]); return w;
}


DEV void sincos_rev(double ang, float& c, float& s) {
  double rev = ang * 0.15915494309189533576888;
  rev -= floor(rev + 0.5);
  double x = rev * 6.28318530717958647692;
  double x2 = x * x;
  double sv = 1.0, cv = 1.0;
  double ts = 1.0, tc = 1.0;
  sv = 0.0; cv = 0.0;
  double term = 1.0;
  double cterm = 1.0, sterm = 1.0;
  cv = 1.0; sv = 1.0;
#pragma unroll
  for (int n = 1; n <= 13; n++) {
    cterm *= -x2 / (double)((2 * n - 1) * (2 * n));
    sterm *= -x2 / (double)((2 * n) * (2 * n + 1));
    cv += cterm; sv += sterm;
  }
  (void)ts; (void)tc; (void)term;
  c = (float)cv; s = (float)(sv * x);
}

__device__ __forceinline__ void ph_mod(const P& p, char* smem) {
  OPAQUE_Z;
  float* MOD = (float*)(p.ws + zz + O_MOD);
  float* sS = (float*)smem;
  float* red = sS + 9 * 1024;
  const int tid = (threadIdx.x + zz);
  for (int i = tid; i < 9 * 1024; i += NTHR) {
    int r = i >> 10, k = i & 1023;
    float v = (r < 8) ? p.in[1][r * 1024 + k] : p.in[3][k];
    sS[i] = v / (1.f + expf(-v));
  }
  __syncthreads();
  for (int task = (blockIdx.x + zz); task < 4 * 96; task += (gridDim.x + zz)) {
    int l = task / 96, n0 = (task % 96) * 64;
    int col = tid & 63, ks = tid >> 6;
    const float* w = p.in[4] + (size_t)l * 1024 * 6144 + (size_t)(ks * 256) * 6144 + n0 + col;
    float acc[9];
#pragma unroll
    for (int r = 0; r < 9; r++) acc[r] = 0.f;
#pragma unroll 16
    for (int k = 0; k < 256; k++) {
      float wv = w[(size_t)k * 6144];
      const float* s = sS + ks * 256 + k;
#pragma unroll
      for (int r = 0; r < 9; r++) acc[r] += s[r * 1024] * wv;
    }
#pragma unroll
    for (int r = 0; r < 9; r++) red[(ks * 9 + r) * 64 + col] = acc[r];
    __syncthreads();
    for (int i = tid; i < 576; i += NTHR) {
      int r = i >> 6, c = i & 63;
      float v = red[(0 * 9 + r) * 64 + c] + red[(1 * 9 + r) * 64 + c] + red[(2 * 9 + r) * 64 + c] + red[(3 * 9 + r) * 64 + c] +
                p.in[5][l * 6144 + n0 + c];
      MOD[(size_t)(l * 9 + r) * 6144 + n0 + c] = v;
    }
    __syncthreads();
  }
  float* AXC = (float*)(p.ws + zz + O_AXC); float* AXS = (float*)(p.ws + zz + O_AXS);
  float* RC = (float*)(p.ws + zz + O_RC); float* RS = (float*)(p.ws + zz + O_RS);
  int gt = (blockIdx.x + zz) * NTHR + tid, gs = (gridDim.x + zz) * NTHR;
  for (int i = gt; i < 64 * 8 + 2048 * 16; i += gs) {
    if (i < 512) {
      int pos = i >> 3, f = i & 7;
      float fr = expf(-9.210340371976184f * (float)f / 8.f);
      float a = (float)pos * fr;
      float c, s; sincos_rev((double)a, c, s);
      AXC[i] = c; AXS[i] = s;
    } else {
      int j = i - 512; int pos = j >> 4, f = j & 15;
      float fr = expf(-9.210340371976184f * (float)f / 16.f);
      float a = (float)pos * fr;
      float c, s; sincos_rev((double)a, c, s);
      RC[j] = c; RS[j] = s;
    }
  }
}

__device__ __forceinline__ void transpose_cvt(const float* src, int K, int N, u16* dst, const float* gk, char* smem, int glo = 0, int ghi = 1 << 30) {
  OPAQUE_Z;
  float* tile = (float*)smem;
  const int tid = (threadIdx.x + zz);
  int nt_n = (N + 63) / 64, nt_k = K / 64;
  for (int t = (blockIdx.x + zz); t < nt_n * nt_k; t += (gridDim.x + zz)) {
    int k0 = (t / nt_n) * 64, n0 = (t % nt_n) * 64;
    float v[16];
#pragma unroll
    for (int it = 0; it < 16; it++) {
      int i = tid + it * NTHR; int kk = i >> 6, nn = i & 63;
      v[it] = (n0 + nn < N) ? src[(size_t)(k0 + kk) * N + n0 + nn] : 0.f;
    }
    __syncthreads();
#pragma unroll
    for (int it = 0; it < 16; it++) {
      int i = tid + it * NTHR; int kk = i >> 6, nn = i & 63;
      float x = v[it];
      if (gk && (k0 + kk) >= glo && (k0 + kk) < ghi) x *= gk[k0 + kk - glo];
      tile[kk * 65 + nn] = x;
    }
    __syncthreads();
#pragma unroll
    for (int it = 0; it < 8; it++) {
      int i = tid + it * NTHR; int nn = i >> 5, kp = (i & 31) * 2;
      if (n0 + nn < N) *(u32*)(dst + (size_t)(n0 + nn) * K + k0 + kp) = pack2(tile[kp * 65 + nn], tile[(kp + 1) * 65 + nn]);
    }
  }
}

__device__ __forceinline__ void cvt_flat(const float* __restrict__ src, u16* __restrict__ dst, size_t n) {
  OPAQUE_Z;
  size_t gt = (size_t)(blockIdx.x + zz) * NTHR + (threadIdx.x + zz), gs = (size_t)(gridDim.x + zz) * NTHR;
  size_t n8 = n >> 3;
#pragma unroll 4
  for (size_t i = gt; i < n8; i += gs) {
    float4 a = ((const float4*)src)[2 * i], b = ((const float4*)src)[2 * i + 1];
    uint4 o; o.x = pack2(a.x, a.y); o.y = pack2(a.z, a.w); o.z = pack2(b.x, b.y); o.w = pack2(b.z, b.w);
    ((uint4*)dst)[i] = o;
  }
}

__device__ __forceinline__ void cvt_fp8_rows(const float* src, unsigned char* dst, float* sc, int nrows) {
  OPAQUE_Z;
  const int lane = (threadIdx.x + zz) & 63;
  int gw = ((blockIdx.x + zz) * NTHR + (threadIdx.x + zz)) >> 6, nw = ((gridDim.x + zz) * NTHR) >> 6;
  for (int row0 = gw; row0 < nrows; row0 += 4 * nw) {
    f32x4 v[4][4];
#pragma unroll
    for (int u = 0; u < 4; u++) {
      int row = row0 + u * nw;
      if (row < nrows) {
        const f32x4* s4 = (const f32x4*)(src + (size_t)row * 1024 + lane * 16);
#pragma unroll
        for (int i = 0; i < 4; i++) v[u][i] = s4[i];
      } else {
#pragma unroll
        for (int i = 0; i < 4; i++) v[u][i] = (f32x4){0.f, 0.f, 0.f, 0.f};
      }
    }
#pragma unroll
    for (int u = 0; u < 4; u++) {
      int row = row0 + u * nw;
      float am = 0.f;
#pragma unroll
      for (int i = 0; i < 4; i++)
#pragma unroll
        for (int e = 0; e < 4; e++) am = fmaxf(am, fabsf(v[u][i][e]));
      am = fmaxf(am, __shfl_xor(am, 1, 64)); am = fmaxf(am, __shfl_xor(am, 2, 64)); am = fmaxf(am, __shfl_xor(am, 4, 64));
      am = fmaxf(am, __shfl_xor(am, 8, 64)); am = fmaxf(am, __shfl_xor(am, 16, 64)); am = fmaxf(am, __shfl_xor(am, 32, 64));
      float q = am > 0.f ? 240.f / am : 1.f;
      float qi = am > 0.f ? am * (1.f / 240.f) : 1.f;
      u32x4 o;
#pragma unroll
      for (int i = 0; i < 4; i++) {
        int w = 0;
        w = __builtin_amdgcn_cvt_pk_fp8_f32(v[u][i][0] * q, v[u][i][1] * q, w, false);
        w = __builtin_amdgcn_cvt_pk_fp8_f32(v[u][i][2] * q, v[u][i][3] * q, w, true);
        o[i] = (u32)w;
      }
      if (row < nrows) {
        *(u32x4*)(dst + (size_t)row * 1024 + lane * 16) = o;
        if (lane == 0) sc[row] = qi;
      }
    }
  }
}

__device__ __forceinline__ void ph_convert(const P& p, char* smem) {
  OPAQUE_Z;
  for (int l = 0; l < 4; l++) {
    transpose_cvt(p.in[6] + (size_t)l * 1024 * 3016, 1024, 3016, (u16*)(p.ws + zz + O_WINT) + (size_t)l * 3072 * 1024, nullptr, smem);
    transpose_cvt(p.in[8] + (size_t)l * 256 * 384, 256, 384, (u16*)(p.ws + zz + O_WUQT) + (size_t)l * 384 * 256, p.in[7] + l * 256, smem);
    transpose_cvt(p.in[10] + (size_t)l * 128 * 256, 128, 256, (u16*)(p.ws + zz + O_WUKVT) + (size_t)l * 512 * 128, p.in[9] + l * 128, smem);
    transpose_cvt(p.in[11] + (size_t)l * 128 * 256, 128, 256, (u16*)(p.ws + zz + O_WUKVT) + (size_t)l * 512 * 128 + 256 * 128, p.in[9] + l * 128, smem);
    transpose_cvt(p.in[25] + (size_t)l * 1024 * 1024, 1024, 1024, (u16*)(p.ws + zz + O_WOUTT) + (size_t)l * 1024 * 1024, p.in[24] + l * 256, smem, 512, 768);
  }
  {
    int gt = (blockIdx.x + zz) * NTHR + (threadIdx.x + zz), gs = (gridDim.x + zz) * NTHR;
    for (int i = gt; i < 4 * 56 * 1024; i += gs) {
      int l = i / (56 * 1024), r = i % (56 * 1024);
      ((u16*)(p.ws + zz + O_WINT))[(size_t)l * 3072 * 1024 + (size_t)3016 * 1024 + r] = 0;
    }
  }
  cvt_flat(p.in[28], (u16*)(p.ws + zz + O_WQBF), 4ull * 1024 * 2048);
  cvt_flat(p.in[29], (u16*)(p.ws + zz + O_KEYBF), 4ull * 2 * 128 * 128);
  cvt_fp8_rows(p.in[30], (unsigned char*)(p.ws + zz + O_UBF), (float*)(p.ws + zz + O_USC), 4 * 16384);
  cvt_fp8_rows(p.in[31], (unsigned char*)(p.ws + zz + O_VBF), (float*)(p.ws + zz + O_VSC), 4 * 16384);
}

template <int HOOK>
__device__ __forceinline__ void gemm_tile(const u16* __restrict__ A, int lda, const u16* __restrict__ B, int ldb, int K, char* smem, const float* ssq = nullptr) {
  OPAQUE_Z;
  u16* sA = (u16*)smem;
  u16* sB = sA + 128 * 72;
  const int tid = (threadIdx.x + zz), lane = tid & 63, wave = tid >> 6;
  const int wm = (wave >> 1) * 64, wn = (wave & 1) * 64;
  const int lr = lane & 15, lq = lane >> 4;
  f32x4 acc[4][4];
#pragma unroll
  for (int i = 0; i < 4; i++)
#pragma unroll
    for (int j = 0; j < 4; j++) acc[i][j] = (f32x4){0.f, 0.f, 0.f, 0.f};
  u32x4 ra[4], rb[4];
  float rs[4];
  if (HOOK) {
#pragma unroll
    for (int i = 0; i < 4; i++) {
      int row = (tid + i * NTHR) >> 3;
      float4 q = *(const float4*)(ssq + (size_t)row * 4);
      rs[i] = rsqrtf((q.x + q.y + q.z + q.w) * (1.f / 256.f) + 1e-6f);
    }
  }
#pragma unroll
  for (int i = 0; i < 4; i++) {
    int id = tid + i * NTHR; int row = id >> 3, ch = id & 7;
    ra[i] = *(const u32x4*)(A + (size_t)row * lda + ch * 8);
    rb[i] = *(const u32x4*)(B + (size_t)row * ldb + ch * 8);
  }
#pragma unroll 1
  for (int k0 = 0; k0 < K; k0 += 64) {
    __syncthreads();
    if (HOOK && k0 >= 512 && k0 < 768) {
#pragma unroll
      for (int i = 0; i < 4; i++) {
        float t8[8];
        unpack8(ra[i], t8);
#pragma unroll
        for (int e = 0; e < 8; e++) t8[e] *= rs[i];
        ra[i] = pack8(t8);
      }
    }
#pragma unroll
    for (int i = 0; i < 4; i++) {
      int id = tid + i * NTHR; int row = id >> 3, ch = id & 7;
      *(u32x4*)(sA + row * 72 + ch * 8) = ra[i];
      *(u32x4*)(sB + row * 72 + ch * 8) = rb[i];
    }
    __syncthreads();
    if (k0 + 64 < K) {
#pragma unroll
      for (int i = 0; i < 4; i++) {
        int id = tid + i * NTHR; int row = id >> 3, ch = id & 7;
        ra[i] = *(const u32x4*)(A + (size_t)row * lda + k0 + 64 + ch * 8);
        rb[i] = *(const u32x4*)(B + (size_t)row * ldb + k0 + 64 + ch * 8);
      }
    }
#pragma unroll
    for (int kk = 0; kk < 64; kk += 32) {
      bf16x8 af[4], bfr[4];
#pragma unroll
      for (int i = 0; i < 4; i++) af[i] = *(const bf16x8*)(sA + (wm + i * 16 + lr) * 72 + kk + lq * 8);
#pragma unroll
      for (int j = 0; j < 4; j++) bfr[j] = *(const bf16x8*)(sB + (wn + j * 16 + lr) * 72 + kk + lq * 8);
      __builtin_amdgcn_s_setprio(1);
#pragma unroll
      for (int i = 0; i < 4; i++)
#pragma unroll
        for (int j = 0; j < 4; j++) acc[i][j] = mfma16(af[i], bfr[j], acc[i][j]);
      __builtin_amdgcn_s_setprio(0);
    }
  }
  __syncthreads();
  float* sC = (float*)smem;
#pragma unroll
  for (int i = 0; i < 4; i++)
#pragma unroll
    for (int j = 0; j < 4; j++)
#pragma unroll
      for (int r = 0; r < 4; r++) sC[(wm + i * 16 + lq * 4 + r) * 128 + wn + j * 16 + lr] = acc[i][j][r];
  __syncthreads();
}

enum { EPI_BF16 = 0, EPI_F32 = 1, EPI_Q = 2, EPI_KV = 3, EPI_OUT = 4 };

template <int EPI>
__device__ __forceinline__ void gemm_phase(const P& p, int l, const u16* A, int lda, const u16* Bt, int ldb, int K, int mtiles, int ntiles,
                           void* outp, int ldo, char* smem) {
  OPAQUE_Z;
  const int tid = (threadIdx.x + zz);
  float* sC = (float*)smem;
  for (int t = (blockIdx.x + zz); t < mtiles * ntiles; t += (gridDim.x + zz)) {
    int mt = t / ntiles, nt = t % ntiles;
    int m0 = mt * 128, n0 = nt * 128;
    gemm_tile<(EPI == EPI_OUT) ? 1 : 0>(A + (size_t)m0 * lda, lda, Bt + (size_t)n0 * ldb, ldb, K, smem, (const float*)(p.ws + zz + O_SSQ) + (size_t)m0 * 4);
    if (EPI == EPI_BF16) {
      u16* out = (u16*)outp;
      for (int i = tid; i < 128 * 32; i += NTHR) {
        int r = i >> 5, c4 = (i & 31) * 4;
        float4 v = *(const float4*)(sC + r * 128 + c4);
        uint2 o; o.x = pack2(v.x, v.y); o.y = pack2(v.z, v.w);
        *(uint2*)(out + (size_t)(m0 + r) * ldo + n0 + c4) = o;
      }
    } else if (EPI == EPI_F32) {
      float* out = (float*)outp;
      for (int i = tid; i < 128 * 32; i += NTHR) {
        int r = i >> 5, c4 = (i & 31) * 4;
        *(float4*)(out + (size_t)(m0 + r) * ldo + n0 + c4) = *(const float4*)(sC + r * 128 + c4);
      }
    } else if (EPI == EPI_OUT) {
      float* xc = (float*)(p.ws + zz + O_XCUR);
      const float* MOD = (const float*)(p.ws + zz + O_MOD);
#pragma unroll 1
      for (int i0 = tid; i0 < 128 * 32; i0 += 4 * NTHR) {
        float4 xv4[4], gg4[4];
#pragma unroll
        for (int u = 0; u < 4; u++) {
          int i = i0 + u * NTHR; int r = i >> 5, c4 = (i & 31) * 4; int row = m0 + r;
          gg4[u] = *(const float4*)(MOD + (size_t)(l * 9 + modrow_of(row)) * 6144 + 2 * 1024 + n0 + c4);
          xv4[u] = *(const float4*)(xc + (size_t)row * 1024 + n0 + c4);
        }
#pragma unroll
        for (int u = 0; u < 4; u++) {
          int i = i0 + u * NTHR; int r = i >> 5, c4 = (i & 31) * 4; int row = m0 + r;
          float4 v = *(const float4*)(sC + r * 128 + c4);
          float4 xv = xv4[u], gg = gg4[u];
          xv.x = ALPHA * xv.x + gg.x * v.x; xv.y = ALPHA * xv.y + gg.y * v.y;
          xv.z = ALPHA * xv.z + gg.z * v.z; xv.w = ALPHA * xv.w + gg.w * v.w;
          *(float4*)(xc + (size_t)row * 1024 + n0 + c4) = xv;
        }
      }
    } else if (EPI == EPI_Q || EPI == EPI_KV) {
      const u16* Pm = (const u16*)(p.ws + zz + O_P);
      for (int i = tid; i < 128 * 32; i += NTHR) {
        int r = i >> 5, sub = i & 31, c4 = sub * 4;
        int row = m0 + r;
        float ss = 0.f;
        if (EPI == EPI_Q) {
          uint4 w = *(const uint4*)(Pm + (size_t)row * LDP + sub * 8);
          float a;
          a = lo2f(w.x); ss += a * a; a = hi2f(w.x); ss += a * a; a = lo2f(w.y); ss += a * a; a = hi2f(w.y); ss += a * a;
          a = lo2f(w.z); ss += a * a; a = hi2f(w.z); ss += a * a; a = lo2f(w.w); ss += a * a; a = hi2f(w.w); ss += a * a;
        } else {
          uint2 w = *(const uint2*)(Pm + (size_t)row * LDP + 256 + sub * 4);
          float a;
          a = lo2f(w.x); ss += a * a; a = hi2f(w.x); ss += a * a; a = lo2f(w.y); ss += a * a; a = hi2f(w.y); ss += a * a;
        }
        ss += __shfl_xor(ss, 1, 64); ss += __shfl_xor(ss, 2, 64); ss += __shfl_xor(ss, 4, 64);
        ss += __shfl_xor(ss, 8, 64); ss += __shfl_xor(ss, 16, 64);
        float rinv = (EPI == EPI_Q) ? rsqrtf(ss * (1.f / 256.f) + 1e-6f) * (0.10206207261596577f * 1.4426950408889634f)
                                    : rsqrtf(ss * (1.f / 128.f) + 1e-6f);
        float4 v = *(float4*)(sC + r * 128 + c4);
        v.x *= rinv; v.y *= rinv; v.z *= rinv; v.w *= rinv;
        *(float4*)(sC + r * 128 + c4) = v;
      }
      __syncthreads();
      if (EPI == EPI_Q) {
        u16* out = (u16*)(p.ws + zz + O_QB);
        const float* AXC = (const float*)(p.ws + zz + O_AXC); const float* AXS = (const float*)(p.ws + zz + O_AXS);
        for (int i = tid; i < 128 * 128; i += NTHR) {
          int r = i >> 7, c = i & 127;
          int row = m0 + r, col = n0 + c;
          float v = sC[r * 128 + c];
          int hc = col % 96;
          if (row < T_LAT && hc >= 64) {
            int d = hc - 64; int sub = d >> 4, dd = d & 15, f = dd & 7; bool first = dd < 8;
            int t = row & 2047;
            int pos = sub == 0 ? (t >> 6) : (t & 63);
            float cs = AXC[pos * 8 + f], sn = AXS[pos * 8 + f];
            float other = sC[r * 128 + (first ? c + 8 : c - 8)];
            v = first ? (v * cs - other * sn) : (other * sn + v * cs);
          }
          out[(size_t)row * 384 + col] = f2bf(v);
        }
      } else {
        if (nt < 2) {
          u16* out = (u16*)(p.ws + zz + O_KN);
          for (int i = tid; i < 128 * 32; i += NTHR) {
            int r = i >> 5, c4 = (i & 31) * 4;
            float4 v = *(const float4*)(sC + r * 128 + c4);
            uint2 o; o.x = pack2(v.x, v.y); o.y = pack2(v.z, v.w);
            *(uint2*)(out + (size_t)(m0 + r) * 256 + n0 + c4) = o;
          }
        } else {
          u16* VT = (u16*)(p.ws + zz + O_VT);
          int b, pos0;
          if (m0 < T_LAT) { b = m0 >> 11; pos0 = 256 + (m0 & 2047); } else { b = (m0 - T_LAT) >> 8; pos0 = (m0 - T_LAT) & 255; }
          for (int i = tid; i < 128 * 16; i += NTHR) {
            int c = i >> 4, r8 = (i & 15) * 8;
            int vc = (nt - 2) * 128 + c; int h = vc >> 6, dv = vc & 63;
            uint4 o;
            o.x = pack2(sC[(r8 + 0) * 128 + c], sC[(r8 + 1) * 128 + c]);
            o.y = pack2(sC[(r8 + 2) * 128 + c], sC[(r8 + 3) * 128 + c]);
            o.z = pack2(sC[(r8 + 4) * 128 + c], sC[(r8 + 5) * 128 + c]);
            o.w = pack2(sC[(r8 + 6) * 128 + c], sC[(r8 + 7) * 128 + c]);
            *(uint4*)(VT + ((size_t)((b * 4 + h) * 64 + dv)) * 2304 + pos0 + r8) = o;
          }
        }
      }
    }
  }
}

__device__ __forceinline__ void ph_fold(const P& p, char* smem) {
  OPAQUE_Z;
  const int tid = (threadIdx.x + zz);
  float* sC = (float*)smem;
  for (int t = (blockIdx.x + zz); t < 4 * 16 * 8; t += (gridDim.x + zz)) {
    int l = t >> 7, hj = (t >> 3) & 15, kt = t & 7;
    int j = hj & 1;
    const u16* A = (const u16*)(p.ws + zz + O_KEYBF) + (size_t)(l * 2 + j) * 128 * 128;
    const u16* B = (const u16*)(p.ws + zz + O_WQBF) + (size_t)l * 1024 * 2048 + (size_t)(kt * 128) * 2048 + hj * 128;
    gemm_tile<0>(A, 128, B, 2048, 128, smem);
    u16* out = (u16*)(p.ws + zz + O_WPT) + (size_t)l * 2048 * 1024 + (size_t)(hj * 128) * 1024 + kt * 128;
    for (int i = tid; i < 128 * 32; i += NTHR) {
      int r = i >> 5, c4 = (i & 31) * 4;
      float4 v = *(const float4*)(sC + r * 128 + c4);
      uint2 o; o.x = pack2(v.x, v.y); o.y = pack2(v.z, v.w);
      *(uint2*)(out + (size_t)r * 1024 + c4) = o;
    }
  }
}

__device__ __forceinline__ void ph_xinit(const P& p) {
  OPAQUE_Z;
  float* xc = (float*)(p.ws + zz + O_XCUR);
  u16* xm = (u16*)(p.ws + zz + O_XMOD);
  const float* MOD = (const float*)(p.ws + zz + O_MOD);
  size_t gt = (size_t)(blockIdx.x + zz) * NTHR + (threadIdx.x + zz), gs = (size_t)(gridDim.x + zz) * NTHR;
  for (size_t i0 = gt; i0 < (size_t)T_ALL * 256; i0 += 4 * gs) {
    float4 vv[4];
#pragma unroll
    for (int u = 0; u < 4; u++) {
      size_t i = i0 + u * gs;
      vv[u] = make_float4(0.f, 0.f, 0.f, 0.f);
      if (i < (size_t)T_ALL * 256) {
        int row = (int)(i >> 8), c4 = (int)(i & 255) * 4;
        vv[u] = (row < T_LAT) ? *(const float4*)(p.in[0] + (size_t)row * 1024 + c4)
                              : *(const float4*)(p.in[2] + (size_t)(row - T_LAT) * 1024 + c4);
      }
    }
#pragma unroll
    for (int u = 0; u < 4; u++) {
      size_t i = i0 + u * gs;
      if (i < (size_t)T_ALL * 256) {
        int row = (int)(i >> 8), c4 = (int)(i & 255) * 4;
        float4 v = vv[u];
        *(float4*)(xc + (size_t)row * 1024 + c4) = v;
        const float* m = MOD + (size_t)(0 * 9 + modrow_of(row)) * 6144;
        float4 sh = *(const float4*)(m + c4), sc = *(const float4*)(m + 1024 + c4);
        uint2 o; o.x = pack2(v.x * (1.f + sc.x) + sh.x, v.y * (1.f + sc.y) + sh.y);
        o.y = pack2(v.z * (1.f + sc.z) + sh.z, v.w * (1.f + sc.w) + sh.w);
        *(uint2*)(xm + (size_t)row * 1024 + c4) = o;
      }
    }
  }
}

__device__ __forceinline__ void ph_prep(const P& p, int l, char* smem) {
  OPAQUE_Z;
  const u16* Pm = (const u16*)(p.ws + zz + O_P);
  const int tid = (threadIdx.x + zz);
  const int gt = (blockIdx.x + zz) * NTHR + tid, gs = (gridDim.x + zz) * NTHR;
  float* sW = (float*)smem;
  float* sBg = sW + 2 * 16 * 128;
  __syncthreads();
  for (int i = tid; i < 2 * 16 * 128; i += NTHR) sW[i] = ((i >> 11) == 0 ? p.in[12] : p.in[14])[l * 2048 + (i & 2047)];
  for (int i = tid; i < 256; i += NTHR) sBg[i] = ((i >> 7) == 0 ? p.in[13] : p.in[15])[l * 128 + (i & 127)];
  __syncthreads();
  {
    float* LG = (float*)(p.ws + zz + O_LGG);
    for (int i0 = gt; i0 < T_ALL * 32; i0 += 2 * gs) {
      u32x4 la[2], lb[2];
#pragma unroll
      for (int u = 0; u < 2; u++) {
        int i = i0 + u * gs;
        la[u] = (u32x4){0u, 0u, 0u, 0u}; lb[u] = la[u];
        if (i < T_ALL * 32) {
          int row = i >> 5, dir = (i >> 4) & 1;
          const u16* lrp = Pm + (size_t)row * LDP + 1184 + dir * 16;
          la[u] = *(const u32x4*)lrp; lb[u] = *(const u32x4*)(lrp + 8);
        }
      }
#pragma unroll
      for (int u = 0; u < 2; u++) {
        int i = i0 + u * gs;
        if (i < T_ALL * 32) {
          int row = i >> 5, dir = (i >> 4) & 1, cg = i & 15;
          float lr[16];
          unpack8(la[u], lr); unpack8(lb[u], lr + 8);
          float z[8];
#pragma unroll
          for (int c = 0; c < 8; c++) z[c] = sBg[dir * 128 + cg * 8 + c];
#pragma unroll
          for (int k = 0; k < 16; k++) {
            const float4 w0 = *(const float4*)(sW + dir * 2048 + k * 128 + cg * 8);
            const float4 w1 = *(const float4*)(sW + dir * 2048 + k * 128 + cg * 8 + 4);
            z[0] += lr[k] * w0.x; z[1] += lr[k] * w0.y; z[2] += lr[k] * w0.z; z[3] += lr[k] * w0.w;
            z[4] += lr[k] * w1.x; z[5] += lr[k] * w1.y; z[6] += lr[k] * w1.z; z[7] += lr[k] * w1.w;
          }
#pragma unroll
          for (int c = 0; c < 8; c++) z[c] = (fminf(z[c], 0.f) - log1pf(__expf(-fabsf(z[c])))) * (1.f / 16.f);
          float* o = LG + (size_t)dir * T_ALL * 128 + (size_t)row * 128 + cg * 8;
          *(float4*)o = make_float4(z[0], z[1], z[2], z[3]);
          *(float4*)(o + 4) = make_float4(z[4], z[5], z[6], z[7]);
        }
      }
    }
  }
  {
    u16* KR = (u16*)(p.ws + zz + O_KR);
    const float* AXC = (const float*)(p.ws + zz + O_AXC); const float* AXS = (const float*)(p.ws + zz + O_AXS);
    for (int row = gt; row < T_ALL; row += gs) {
      const u16* src = Pm + (size_t)row * LDP + 384;
      u32x4 w0 = *(const u32x4*)src, w1 = *(const u32x4*)(src + 8), w2 = *(const u32x4*)(src + 16), w3 = *(const u32x4*)(src + 24);
      if (row < T_LAT) {
        int t = row & 2047;
        float a[8], b[8], c[8], d[8];
        unpack8(w0, a); unpack8(w1, b); unpack8(w2, c); unpack8(w3, d);
        const float* cr = AXC + (t >> 6) * 8; const float* sr = AXS + (t >> 6) * 8;
        const float* cc = AXC + (t & 63) * 8; const float* sc = AXS + (t & 63) * 8;
#pragma unroll
        for (int f = 0; f < 8; f++) {
          float x1 = a[f], x2 = b[f]; a[f] = x1 * cr[f] - x2 * sr[f]; b[f] = x1 * sr[f] + x2 * cr[f];
          float y1 = c[f], y2 = d[f]; c[f] = y1 * cc[f] - y2 * sc[f]; d[f] = y1 * sc[f] + y2 * cc[f];
        }
        w0 = pack8(a); w1 = pack8(b); w2 = pack8(c); w3 = pack8(d);
      }
      u16* dst = KR + (size_t)row * 32;
      *(u32x4*)dst = w0; *(u32x4*)(dst + 8) = w1; *(u32x4*)(dst + 16) = w2; *(u32x4*)(dst + 24) = w3;
    }
  }
  {
    u16* XBC = (u16*)(p.ws + zz + O_XBC);
    const float* cw = p.in[17] + (size_t)l * 3 * 768; const float* cb = p.in[18] + l * 768;
    for (int i0 = gt; i0 < T_ALL * 96; i0 += 2 * gs) {
      u32x4 r0[2], rm[2], rp[2];
      const u32x4 zero = (u32x4){0u, 0u, 0u, 0u};
#pragma unroll
      for (int u = 0; u < 2; u++) {
        int i = i0 + u * gs;
        r0[u] = zero; rm[u] = zero; rp[u] = zero;
        if (i < T_ALL * 96) {
          int row = i / 96, cg = i - row * 96;
          int t = tpos_of(row); int L = row < T_LAT ? 2048 : 256;
          const u16* src = Pm + (size_t)row * LDP + 1472 + cg * 8;
          r0[u] = *(const u32x4*)src;
          if (t > 0) rm[u] = *(const u32x4*)(src - LDP);
          if (t < L - 1) rp[u] = *(const u32x4*)(src + LDP);
        }
      }
#pragma unroll
      for (int u = 0; u < 2; u++) {
        int i = i0 + u * gs;
        if (i < T_ALL * 96) {
          int row = i / 96, cg = i - row * 96;
          float x0[8], xm[8], xp[8];
          unpack8(r0[u], x0); unpack8(rm[u], xm); unpack8(rp[u], xp);
          float y[8];
#pragma unroll
          for (int c = 0; c < 8; c++) {
            float v = cw[cg * 8 + c] * xm[c] + cw[768 + cg * 8 + c] * x0[c] + cw[1536 + cg * 8 + c] * xp[c] + cb[cg * 8 + c];
            y[c] = silu_f(v);
          }
          *(u32x4*)(XBC + (size_t)row * 768 + cg * 8) = pack8(y);
        }
      }
    }
    float* DT = (float*)(p.ws + zz + O_DT); float* LA = (float*)(p.ws + zz + O_LA);
    for (int i = gt; i < 2 * T_ALL * 4; i += gs) {
      int dir = i / (T_ALL * 4); int rem = i - dir * (T_ALL * 4);
      int row = rem >> 2, h = rem & 3;
      float raw = bf2f(Pm[(size_t)row * LDP + 2240 + dir * 4 + h]);
      float bias = (dir == 0 ? p.in[19] : p.in[20])[l * 4 + h];
      float alog = (dir == 0 ? p.in[21] : p.in[22])[l * 4 + h];
      float dt = softplus_f(raw + bias);
      DT[i] = dt; LA[i] = -dt * expf(alog);
    }
  }
  {
    u16* QK = (u16*)(p.ws + zz + O_QKR);
    const float* RC = (const float*)(p.ws + zz + O_RC); const float* RS = (const float*)(p.ws + zz + O_RS);
    for (int i = gt; i < T_ALL * 8; i += gs) {
      int row = i >> 3, which = (i >> 2) & 1, h = i & 3;
      const u16* src = Pm + (size_t)row * LDP + 2248 + which * 128 + h * 32;
      float a[8], b[8], c[8], d[8];
      unpack8(*(const u32x4*)src, a); unpack8(*(const u32x4*)(src + 8), b);
      unpack8(*(const u32x4*)(src + 16), c); unpack8(*(const u32x4*)(src + 24), d);
      float sc = which == 1 ? 0.17677669529663687f : 1.f;
      if (row < T_LAT) {
        int t = row & 2047;
        const float* cs = RC + t * 16; const float* sn = RS + t * 16;
#pragma unroll
        for (int f = 0; f < 8; f++) {
          float x1 = a[f], x2 = c[f]; a[f] = x1 * cs[f] - x2 * sn[f]; c[f] = x1 * sn[f] + x2 * cs[f];
          float y1 = b[f], y2 = d[f]; b[f] = y1 * cs[8 + f] - y2 * sn[8 + f]; d[f] = y1 * sn[8 + f] + y2 * cs[8 + f];
        }
      }
#pragma unroll
      for (int f = 0; f < 8; f++) { a[f] *= sc; b[f] *= sc; c[f] *= sc; d[f] *= sc; }
      u16* dst = QK + (size_t)row * 256 + which * 128 + h * 32;
      *(u32x4*)dst = pack8(a); *(u32x4*)(dst + 8) = pack8(b); *(u32x4*)(dst + 16) = pack8(c); *(u32x4*)(dst + 24) = pack8(d);
    }
  }
}

__device__ __forceinline__ void ph_attn(const P& p, int need_ctx, char* smem) {
  OPAQUE_Z;
  const u16* QB = (const u16*)(p.ws + zz + O_QB);
  const u16* KN = (const u16*)(p.ws + zz + O_KN);
  const u16* KR = (const u16*)(p.ws + zz + O_KR);
  const u16* VT = (const u16*)(p.ws + zz + O_VT);
  u16* MIX = (u16*)(p.ws + zz + O_MIX);
  u16* sK = (u16*)smem;
  u16* sV = sK + 64 * 104;
  const int tid = (threadIdx.x + zz), lane = tid & 63, wave = tid >> 6, lr = lane & 15, lq = lane >> 4;
  int ntask = 8 * 4 * 16 + (need_ctx ? 8 * 4 * 2 : 0);
  for (int task = (blockIdx.x + zz); task < ntask; task += (gridDim.x + zz)) {
    int b, h, qrow0, nkt;
    if (task < 512) { b = task >> 6; h = (task >> 4) & 3; int qt = task & 15; qrow0 = b * 2048 + qt * 128; nkt = 36; }
    else { int t2 = task - 512; b = t2 >> 3; h = (t2 >> 1) & 3; int qt = t2 & 1; qrow0 = T_LAT + b * 256 + qt * 128; nkt = 4; }
    bf16x8 qf[2][3];
#pragma unroll
    for (int qs = 0; qs < 2; qs++) {
      const u16* qp = QB + (size_t)(qrow0 + wave * 32 + qs * 16 + lr) * 384 + h * 96 + lq * 8;
#pragma unroll
      for (int ks = 0; ks < 3; ks++) qf[qs][ks] = *(const bf16x8*)(qp + ks * 32);
    }
    f32x4 o[2][4];
    float m[2], lsum[2];
#pragma unroll
    for (int qs = 0; qs < 2; qs++) {
      m[qs] = -1e30f; lsum[qs] = 0.f;
#pragma unroll
      for (int i = 0; i < 4; i++) o[qs][i] = (f32x4){0.f, 0.f, 0.f, 0.f};
    }
    u32x4 rk[3], rv[2];
#define ATT_LOAD(kt_)                                                                                   \
  {                                                                                                     \
    int pos0_ = (kt_) * 64;                                                                             \
    int krow0_ = (pos0_ < 256) ? (T_LAT + b * 256 + pos0_) : (b * 2048 + pos0_ - 256);                  \
    _Pragma("unroll") for (int i_ = 0; i_ < 3; i_++) {                                                  \
      int id_ = tid + i_ * NTHR; int j_ = id_ / 12, ch_ = id_ - j_ * 12;                                \
      rk[i_] = (ch_ < 8) ? *(const u32x4*)(KN + (size_t)(krow0_ + j_) * 256 + h * 64 + ch_ * 8)         \
                         : *(const u32x4*)(KR + (size_t)(krow0_ + j_) * 32 + (ch_ - 8) * 8);            \
    }                                                                                                   \
    _Pragma("unroll") for (int i_ = 0; i_ < 2; i_++) {                                                  \
      int id_ = tid + i_ * NTHR; int dv_ = id_ >> 3, ch_ = id_ & 7;                                     \
      rv[i_] = *(const u32x4*)(VT + ((size_t)((b * 4 + h) * 64 + dv_)) * 2304 + pos0_ + ch_ * 8);       \
    }                                                                                                   \
  }
    ATT_LOAD(0);
#pragma unroll 1
    for (int kt = 0; kt < nkt; kt++) {
      __syncthreads();
#pragma unroll
      for (int i = 0; i < 3; i++) { int id = tid + i * NTHR; int j = id / 12, ch = id - j * 12; *(u32x4*)(sK + j * 104 + ch * 8) = rk[i]; }
#pragma unroll
      for (int i = 0; i < 2; i++) { int id = tid + i * NTHR; int dv = id >> 3, ch = id & 7; *(u32x4*)(sV + dv * 72 + ch * 8) = rv[i]; }
      __syncthreads();
      if (kt + 1 < nkt) ATT_LOAD(kt + 1);
      f32x4 s[2][4];
      __builtin_amdgcn_s_setprio(1);
#pragma unroll
      for (int nt = 0; nt < 4; nt++) {
        s[0][nt] = (f32x4){0.f, 0.f, 0.f, 0.f}; s[1][nt] = (f32x4){0.f, 0.f, 0.f, 0.f};
#pragma unroll
        for (int ks = 0; ks < 3; ks++) {
          bf16x8 kf = *(const bf16x8*)(sK + (nt * 16 + lr) * 104 + ks * 32 + lq * 8);
          s[0][nt] = mfma16(kf, qf[0][ks], s[0][nt]);
          s[1][nt] = mfma16(kf, qf[1][ks], s[1][nt]);
        }
      }
      __builtin_amdgcn_s_setprio(0);
      bf16x8 pf[2][2];
#pragma unroll
      for (int qs = 0; qs < 2; qs++) {
        float mx = s[qs][0][0];
#pragma unroll
        for (int nt = 0; nt < 4; nt++)
#pragma unroll
          for (int r = 0; r < 4; r++) mx = fmaxf(mx, s[qs][nt][r]);
        mx = fmaxf(mx, __shfl_xor(mx, 16, 64)); mx = fmaxf(mx, __shfl_xor(mx, 32, 64));
        float mn = fmaxf(m[qs], mx);
        float alpha = __builtin_amdgcn_exp2f(m[qs] - mn);
        m[qs] = mn;
        float ps = 0.f;
#pragma unroll
        for (int nt = 0; nt < 4; nt++)
#pragma unroll
          for (int r = 0; r < 4; r++) { float e = __builtin_amdgcn_exp2f(s[qs][nt][r] - mn); s[qs][nt][r] = e; ps += e; }
        lsum[qs] = lsum[qs] * alpha + ps;
#pragma unroll
        for (int nt = 0; nt < 4; nt++)
#pragma unroll
          for (int r = 0; r < 4; r++) o[qs][nt][r] *= alpha;
#pragma unroll
        for (int m2 = 0; m2 < 2; m2++) {
          u32x4 w;
          w[0] = pack2(s[qs][2 * m2][0], s[qs][2 * m2][1]); w[1] = pack2(s[qs][2 * m2][2], s[qs][2 * m2][3]);
          w[2] = pack2(s[qs][2 * m2 + 1][0], s[qs][2 * m2 + 1][1]); w[3] = pack2(s[qs][2 * m2 + 1][2], s[qs][2 * m2 + 1][3]);
          pf[qs][m2] = __builtin_bit_cast(bf16x8, w);
        }
      }
      __builtin_amdgcn_s_setprio(1);
#pragma unroll
      for (int m2 = 0; m2 < 2; m2++) {
#pragma unroll
        for (int nt = 0; nt < 4; nt++) {
          const u16* vp = sV + (nt * 16 + lr) * 72 + 32 * m2 + 4 * lq;
          uint2 lo = *(const uint2*)vp, hi = *(const uint2*)(vp + 16);
          u32x4 w; w[0] = lo.x; w[1] = lo.y; w[2] = hi.x; w[3] = hi.y;
          bf16x8 vf = __builtin_bit_cast(bf16x8, w);
          o[0][nt] = mfma16(vf, pf[0][m2], o[0][nt]);
          o[1][nt] = mfma16(vf, pf[1][m2], o[1][nt]);
        }
      }
      __builtin_amdgcn_s_setprio(0);
    }
#pragma unroll
    for (int qs = 0; qs < 2; qs++) {
      float ls = lsum[qs];
      ls += __shfl_xor(ls, 16, 64); ls += __shfl_xor(ls, 32, 64);
      float inv = 1.f / ls;
      int row = qrow0 + wave * 32 + qs * 16 + lr;
#pragma unroll
      for (int nt = 0; nt < 4; nt++) {
        uint2 w; w.x = pack2(o[qs][nt][0] * inv, o[qs][nt][1] * inv); w.y = pack2(o[qs][nt][2] * inv, o[qs][nt][3] * inv);
        *(uint2*)(MIX + (size_t)row * 1024 + h * 64 + nt * 16 + lq * 4) = w;
      }
    }
  }
}

struct MixDesc {
  const u16 *q, *k, *v;
  int qld, kld, vld, qc, kc, vc;
  int dk, hshift, g;
  float qscale;
  const float* lg;
  const float* ks;
  size_t sloc_off, dec_off;
};

DEV MixDesc get_mix(const P& p, int m) {
  OPAQUE_Z;
  MixDesc d;
  const u16* Pm = (const u16*)(p.ws + zz + O_P);
  if (m == 0) {
    d.q = Pm; d.k = Pm; d.v = Pm; d.qld = d.kld = d.vld = LDP; d.qc = 416; d.kc = 544; d.vc = 672;
    d.dk = 32; d.hshift = 0; d.g = 32; d.qscale = 0.17677669529663687f;
    d.lg = (const float*)(p.ws + zz + O_LGG); d.ks = nullptr; d.sloc_off = SLOC_G; d.dec_off = DEC_G;
  } else if (m == 1) {
    const u16* X = (const u16*)(p.ws + zz + O_XBC);
    d.q = X; d.k = X; d.v = X; d.qld = d.kld = d.vld = 768; d.qc = 512; d.kc = 256; d.vc = 0;
    d.dk = 128; d.hshift = 1; d.g = 1; d.qscale = 1.f;
    d.lg = (const float*)(p.ws + zz + O_LA); d.ks = (const float*)(p.ws + zz + O_DT); d.sloc_off = SLOC_S; d.dec_off = DEC_S;
  } else {
    const u16* X = (const u16*)(p.ws + zz + O_QKR);
    d.q = X; d.k = X; d.v = Pm; d.qld = d.kld = 256; d.vld = LDP; d.qc = 0; d.kc = 128; d.vc = 2504;
    d.dk = 32; d.hshift = 0; d.g = 1; d.qscale = 1.f;
    d.lg = nullptr; d.ks = nullptr; d.sloc_off = SLOC_R; d.dec_off = DEC_R;
  }
  return d;
}

struct StagePre { u32x4 v[2]; f32x4 c4[4]; float c1, k1; };
DEV void stage_pre(const MixDesc& d, int row0, int h, StagePre& r) {
  OPAQUE_Z;
  const int tid = (threadIdx.x + zz);
  const int g = d.g;
  const int vcol = d.vc + h * 64;
#pragma unroll
  for (int it = 0; it < 2; it++) {
    int i = tid + it * NTHR; int j = i >> 3, ch = i & 7;
    r.v[it] = *(const u32x4*)(d.v + (size_t)(row0 + j) * d.vld + vcol + ch * 8);
  }
#pragma unroll
  for (int it = 0; it < 4; it++) {
    r.c4[it] = (f32x4){0.f, 0.f, 0.f, 0.f};
    if (g > 1) {
      int i = tid + it * NTHR; int dir = i >> 9, j = (i >> 3) & 63, c4 = (i & 7) * 4;
      r.c4[it] = *(const f32x4*)(d.lg + (size_t)dir * T_ALL * 128 + (size_t)(row0 + j) * 128 + h * 32 + c4);
    }
  }
  r.c1 = 0.f; r.k1 = 1.f;
  if (tid < 128) {
    int dir = tid >> 6, j = tid & 63;
    if (g == 1) r.c1 = d.lg ? d.lg[(size_t)dir * T_ALL * 4 + (size_t)(row0 + j) * 4 + h] : log1pf(-exp2f(-5.f - (float)h));
    r.k1 = d.ks ? d.ks[(size_t)dir * T_ALL * 4 + (size_t)(row0 + j) * 4 + h] : 1.f;
  }
}
DEV void stage_post(const MixDesc& d, const StagePre& r, u16* sVT, float* sCum, float* sKs) {
  OPAQUE_Z;
  const int tid = (threadIdx.x + zz);
  const int g = d.g;
#pragma unroll
  for (int it = 0; it < 2; it++) {
    int i = tid + it * NTHR; int j = i >> 3, ch = i & 7;
    const u32x4 v = r.v[it];
    u16* dst = sVT + (ch * 8) * 72 + j;
    dst[0 * 72] = (u16)(v[0] & 0xffff); dst[1 * 72] = (u16)(v[0] >> 16);
    dst[2 * 72] = (u16)(v[1] & 0xffff); dst[3 * 72] = (u16)(v[1] >> 16);
    dst[4 * 72] = (u16)(v[2] & 0xffff); dst[5 * 72] = (u16)(v[2] >> 16);
    dst[6 * 72] = (u16)(v[3] & 0xffff); dst[7 * 72] = (u16)(v[3] >> 16);
  }
  if (g > 1) {
#pragma unroll
    for (int it = 0; it < 4; it++) {
      int i = tid + it * NTHR; int dir = i >> 9, j = (i >> 3) & 63, c4 = (i & 7) * 4;
      *(f32x4*)(sCum + dir * 2048 + j * 32 + c4) = r.c4[it];
    }
  } else if (tid < 128) {
    sCum[tid] = r.c1;
  }
  if (tid < 128) sKs[tid] = r.k1;
  __syncthreads();
  if (g > 1) {
    if (tid < 64) {
      int dir = tid >> 5, kk = tid & 31;
      float* c = sCum + dir * 2048 + kk;
      float run = 0.f;
      if (dir == 0) {
#pragma unroll 8
        for (int j = 0; j < 64; j++) { run += c[j * 32]; c[j * 32] = run; }
      } else {
#pragma unroll 8
        for (int j = 63; j >= 0; j--) { run += c[j * 32]; c[j * 32] = run; }
      }
    }
  } else if (tid < 128) {
    int dir = tid >> 6, lane = tid & 63;
    float v = sCum[tid];
#pragma unroll
    for (int off = 1; off < 64; off <<= 1) {
      float o = dir == 0 ? __shfl_up(v, off, 64) : __shfl_down(v, off, 64);
      bool ok = dir == 0 ? (lane >= off) : (lane + off < 64);
      v += ok ? o : 0.f;
    }
    sCum[tid] = v;
  }
  __syncthreads();
}


__device__ __forceinline__ void ph_scan1(const P& p, char* smem) {
  OPAQUE_Z;
  u16* sKraw = (u16*)smem;
  u16* sVT = (u16*)(smem + 16384);
  u16* sKT = (u16*)(smem + 25600);
  float* sCum = (float*)(smem + 44032);
  float* sKs = (float*)(smem + 60416);
  float* SLOC = (float*)(p.ws + zz + O_SLOC);
  float* DEC = (float*)(p.ws + zz + O_DEC);
  const int tid = (threadIdx.x + zz), lane = tid & 63, wave = tid >> 6, lr = lane & 15, lq = lane >> 4;
  for (int task = (blockIdx.x + zz); task < 3 * 8 * 36 * 4; task += (gridDim.x + zz)) {
    int m = task / 1152; int rem = task - m * 1152; int b = rem / 144; int rem2 = rem - b * 144; int gc = rem2 >> 2, h = rem2 & 3;
    MixDesc d = get_mix(p, m);
    const int dk = d.dk, g = d.g;
    int row0 = chunk_row0(b, gc);
    __syncthreads();
    int kcol = d.kc + (h >> d.hshift) * dk;
    int cpr = dk >> 3;
    {
      u32x4 kr[4];
#pragma unroll
      for (int it = 0; it < 4; it++) {
        int i = tid + it * NTHR;
        kr[it] = (u32x4){0u, 0u, 0u, 0u};
        if (i < 64 * cpr) { int j = i / cpr, ch = i - j * cpr; kr[it] = *(const u32x4*)(d.k + (size_t)(row0 + j) * d.kld + kcol + ch * 8); }
      }
      StagePre spre; stage_pre(d, row0, h, spre);
#pragma unroll
      for (int it = 0; it < 4; it++) {
        int i = tid + it * NTHR;
        if (i < 64 * cpr) { int j = i / cpr, ch = i - j * cpr; *(u32x4*)(sKraw + j * dk + ch * 8) = kr[it]; }
      }
      stage_post(d, spre, sVT, sCum, sKs);
    }
#pragma unroll 1
    for (int dir = 0; dir < 2; dir++) {
      const float* cum = sCum + dir * 64 * g;
      const int jl = dir == 0 ? 63 : 0;
      for (int i = tid; i < 64 * cpr; i += NTHR) {
        int j = i & 63, kg = i >> 6;
        float kv[8];
        unpack8(*(const u32x4*)(sKraw + j * dk + kg * 8), kv);
        float ksj = sKs[dir * 64 + j];
        if (g > 1) {
#pragma unroll
          for (int e = 0; e < 8; e++) kv[e] *= ksj * __expf(cum[jl * 32 + kg * 8 + e] - cum[j * 32 + kg * 8 + e]);
        } else {
          float f = ksj * __expf(cum[jl] - cum[j]);
#pragma unroll
          for (int e = 0; e < 8; e++) kv[e] *= f;
        }
#pragma unroll
        for (int e = 0; e < 8; e++) sKT[(kg * 8 + e) * 72 + j] = f2bf(kv[e]);
      }
      __syncthreads();
      size_t seq = (size_t)((b * 4 + h) * 2 + dir) * 36 + gc;
      float* outS = SLOC + d.sloc_off + seq * (size_t)(dk * 64);
      int ntile = (dk >> 4) * 4;
      for (int t = wave; t < ntile; t += 4) {
        int mt = t & 3, nt = t >> 2;
        f32x4 acc = (f32x4){0.f, 0.f, 0.f, 0.f};
#pragma unroll
        for (int ks = 0; ks < 2; ks++) {
          bf16x8 a = *(const bf16x8*)(sVT + (mt * 16 + lr) * 72 + ks * 32 + lq * 8);
          bf16x8 bb = *(const bf16x8*)(sKT + (nt * 16 + lr) * 72 + ks * 32 + lq * 8);
          acc = mfma16(a, bb, acc);
        }
#pragma unroll
        for (int r = 0; r < 4; r++) outS[(mt * 16 + lq * 4 + r) * dk + nt * 16 + lr] = acc[r];
      }
      if (tid < g) DEC[d.dec_off + seq * g + tid] = __expf(cum[jl * g + tid]);
      __syncthreads();
    }
  }
}

__device__ __forceinline__ void ph_scan2(const P& p) {
  OPAQUE_Z;
  const float* SLOC = (const float*)(p.ws + zz + O_SLOC);
  u16* SIN = (u16*)(p.ws + zz + O_SIN);
  const float* DEC = (const float*)(p.ws + zz + O_DEC);
  int gt = (blockIdx.x + zz) * NTHR + (threadIdx.x + zz), gs = (gridDim.x + zz) * NTHR;
  const int NG = 64 * 2048, NS = 64 * 8192;
  for (int i = gt; i < NG + NS + NG; i += gs) {
    int m, rem;
    if (i < NG) { m = 0; rem = i; } else if (i < NG + NS) { m = 1; rem = i - NG; } else { m = 2; rem = i - NG - NS; }
    int dk = m == 1 ? 128 : 32; int g = m == 0 ? 32 : 1;
    size_t so = m == 0 ? SLOC_G : (m == 1 ? SLOC_S : SLOC_R);
    size_t dof = m == 0 ? DEC_G : (m == 1 ? DEC_S : DEC_R);
    int esz = dk * 64;
    int seq = rem / esz, e = rem - seq * esz;
    int dir = seq & 1;
    int kk = e & (dk - 1);
    int gi = g > 1 ? kk : 0;
    float run = 0.f;
#pragma unroll 1
    for (int s0 = 0; s0 < 36; s0 += 18) {
      float loc[18], dd[18]; size_t aa[18];
#pragma unroll
      for (int u = 0; u < 18; u++) {
        int s = s0 + u;
        int gc = dir == 0 ? s : (s < 4 ? 3 - s : 39 - s);
        aa[u] = so + ((size_t)seq * 36 + gc) * esz + e;
        loc[u] = SLOC[aa[u]];
        dd[u] = DEC[dof + ((size_t)seq * 36 + gc) * g + gi];
      }
#pragma unroll
      for (int u = 0; u < 18; u++) { SIN[aa[u]] = f2bf(run); run = dd[u] * run + loc[u]; }
    }
  }
}

__device__ __forceinline__ void ph_scan3(const P& p, int l, int need_ctx, char* smem) {
  OPAQUE_Z;
  const u16* SIN = (const u16*)(p.ws + zz + O_SIN);
  const u16* Pm = (const u16*)(p.ws + zz + O_P);
  const u16* XBC = (const u16*)(p.ws + zz + O_XBC);
  u16* MIX = (u16*)(p.ws + zz + O_MIX);
  float* SSQ = (float*)(p.ws + zz + O_SSQ);
  const int tid = (threadIdx.x + zz), lane = tid & 63, wave = tid >> 6, lr = lane & 15, lq = lane >> 4;
  const int gcn = need_ctx ? 36 : 32, gcb = need_ctx ? 0 : 4;
  const int per_m = 8 * gcn * 4;
  for (int task = (blockIdx.x + zz); task < 3 * per_m; task += (gridDim.x + zz)) {
    int m = task / per_m; int rem = task - m * per_m; int b = rem / (gcn * 4); int rem2 = rem - b * gcn * 4;
    int gc = gcb + (rem2 >> 2), h = rem2 & 3;
    MixDesc d = get_mix(p, m);
    const int dk = d.dk, g = d.g, ldq = dk + 8;
    u16* sQ = (u16*)smem;
    u16* sK = sQ + 64 * ldq;
    u16* sSin = sK + 64 * ldq;
    u16* sVT = sSin + 64 * ldq;
    float* sCum = (float*)(sVT + 64 * 72);
    float* sKs = sCum + 2 * 64 * g;
    u16* sQr = (u16*)(sKs + 128);
    u16* sKr = sQr + 64 * 32;
    u16* sPm = (dk == 128) ? sSin : (sKr + 64 * 32);
    int row0 = chunk_row0(b, gc);
    __syncthreads();
    int qcol = d.qc + (h >> d.hshift) * dk, kcol = d.kc + (h >> d.hshift) * dk;
    int cpr = dk >> 3;
    {
      u32x4 qr[4], kr[4];
#pragma unroll
      for (int it = 0; it < 4; it++) {
        int i = tid + it * NTHR;
        qr[it] = (u32x4){0u, 0u, 0u, 0u}; kr[it] = qr[it];
        if (i < 64 * cpr) {
          int j = i / cpr, ch = i - j * cpr;
          qr[it] = *(const u32x4*)(d.q + (size_t)(row0 + j) * d.qld + qcol + ch * 8);
          kr[it] = *(const u32x4*)(d.k + (size_t)(row0 + j) * d.kld + kcol + ch * 8);
        }
      }
      StagePre spre; stage_pre(d, row0, h, spre);
#pragma unroll
      for (int it = 0; it < 4; it++) {
        int i = tid + it * NTHR;
        if (i < 64 * cpr) {
          int j = i / cpr, ch = i - j * cpr;
          if (g > 1) { *(u32x4*)(sQr + j * 32 + ch * 8) = qr[it]; *(u32x4*)(sKr + j * 32 + ch * 8) = kr[it]; }
          else { *(u32x4*)(sQ + j * ldq + ch * 8) = qr[it]; *(u32x4*)(sK + j * ldq + ch * 8) = kr[it]; }
        }
      }
      stage_post(d, spre, sVT, sCum, sKs);
    }
    f32x4 o[4];
#pragma unroll
    for (int i = 0; i < 4; i++) o[i] = (f32x4){0.f, 0.f, 0.f, 0.f};
#pragma unroll 1
    for (int dir = 0; dir < 2; dir++) {
      const float* cum = sCum + dir * 64 * g;
      {
        size_t seq = (size_t)((b * 4 + h) * 2 + dir) * 36 + gc;
        const u16* S = SIN + d.sloc_off + seq * (size_t)(dk * 64);
        u32x4 sr[4];
#pragma unroll
        for (int it = 0; it < 4; it++) {
          int i = tid + it * NTHR;
          sr[it] = (u32x4){0u, 0u, 0u, 0u};
          if (i < 64 * cpr) { int vv = i / cpr, ch = i - vv * cpr; sr[it] = *(const u32x4*)(S + vv * dk + ch * 8); }
        }
#pragma unroll
        for (int it = 0; it < 4; it++) {
          int i = tid + it * NTHR;
          if (i < 64 * cpr) { int vv = i / cpr, ch = i - vv * cpr; *(u32x4*)(sSin + vv * ldq + ch * 8) = sr[it]; }
        }
      }
      if (g > 1) {
        for (int i = tid; i < 64 * 4; i += NTHR) {
          int j = i >> 2, kg = i & 3;
          float qv[8], kv[8];
          unpack8(*(const u32x4*)(sQr + j * 32 + kg * 8), qv);
          unpack8(*(const u32x4*)(sKr + j * 32 + kg * 8), kv);
#pragma unroll
          for (int e = 0; e < 8; e++) {
            float c = cum[j * 32 + kg * 8 + e];
            qv[e] *= d.qscale * __expf(c); kv[e] *= __expf(-c);
          }
          *(u32x4*)(sQ + j * ldq + kg * 8) = pack8(qv);
          *(u32x4*)(sK + j * ldq + kg * 8) = pack8(kv);
        }
      }
      __syncthreads();
      f32x4 s[4], tmp[4];
#pragma unroll
      for (int nt = 0; nt < 4; nt++) { s[nt] = (f32x4){0.f, 0.f, 0.f, 0.f}; tmp[nt] = (f32x4){0.f, 0.f, 0.f, 0.f}; }
#pragma unroll 1
      for (int ks = 0; ks < dk; ks += 32) {
        bf16x8 a = *(const bf16x8*)(sQ + (wave * 16 + lr) * ldq + ks + lq * 8);
#pragma unroll
        for (int nt = 0; nt < 4; nt++) {
          bf16x8 bk = *(const bf16x8*)(sK + (nt * 16 + lr) * ldq + ks + lq * 8);
          s[nt] = mfma16(a, bk, s[nt]);
          bf16x8 bs = *(const bf16x8*)(sSin + (nt * 16 + lr) * ldq + ks + lq * 8);
          tmp[nt] = mfma16(a, bs, tmp[nt]);
        }
      }
      __syncthreads();
      float ci[4];
#pragma unroll
      for (int r = 0; r < 4; r++) ci[r] = (g > 1) ? 0.f : cum[wave * 16 + lq * 4 + r];
#pragma unroll
      for (int nt = 0; nt < 4; nt++) {
        int j = nt * 16 + lr;
        float cj = (g > 1) ? 0.f : cum[j];
        float ksj = sKs[dir * 64 + j];
#pragma unroll
        for (int r = 0; r < 4; r++) {
          int i = wave * 16 + lq * 4 + r;
          bool valid = dir == 0 ? (j <= i) : (j >= i);
          float val = 0.f;
          if (valid) val = (g > 1) ? s[nt][r] : s[nt][r] * ksj * __expf(ci[r] - cj);
          sPm[i * 72 + j] = f2bf(val);
        }
      }
      __syncthreads();
#pragma unroll
      for (int ks = 0; ks < 2; ks++) {
        bf16x8 a = *(const bf16x8*)(sPm + (wave * 16 + lr) * 72 + ks * 32 + lq * 8);
#pragma unroll
        for (int nt = 0; nt < 4; nt++) {
          bf16x8 bb = *(const bf16x8*)(sVT + (nt * 16 + lr) * 72 + ks * 32 + lq * 8);
          o[nt] = mfma16(a, bb, o[nt]);
        }
      }
#pragma unroll
      for (int r = 0; r < 4; r++) {
        float sc = (g > 1) ? 1.f : __expf(ci[r]);
#pragma unroll
        for (int nt = 0; nt < 4; nt++) o[nt][r] += sc * tmp[nt][r];
      }
      __syncthreads();
    }
    float ga[4][4], gb[4][4];
#pragma unroll
    for (int r = 0; r < 4; r++) {
      int row = row0 + wave * 16 + lq * 4 + r;
#pragma unroll
      for (int nt = 0; nt < 4; nt++) {
        int c = h * 64 + nt * 16 + lr;
        if (m == 0) { ga[r][nt] = bf2f(Pm[(size_t)row * LDP + 928 + c]); gb[r][nt] = p.in[16][l * 256 + c]; }
        else if (m == 2) { ga[r][nt] = bf2f(Pm[(size_t)row * LDP + 2760 + c]); gb[r][nt] = 0.f; }
        else { ga[r][nt] = bf2f(XBC[(size_t)row * 768 + c]); gb[r][nt] = bf2f(Pm[(size_t)row * LDP + 1216 + c]); }
      }
    }
#pragma unroll
    for (int r = 0; r < 4; r++) {
      int row = row0 + wave * 16 + lq * 4 + r;
      if (m == 0) {
        float ss = 0.f;
#pragma unroll
        for (int nt = 0; nt < 4; nt++) ss += o[nt][r] * o[nt][r];
        ss = xor16_sum(ss);
        float rinv = rsqrtf(ss * (1.f / 64.f) + 1e-6f);
#pragma unroll
        for (int nt = 0; nt < 4; nt++) {
          int c = h * 64 + nt * 16 + lr;
          MIX[(size_t)row * 1024 + 256 + c] = f2bf(o[nt][r] * rinv * gb[r][nt] * silu_f(ga[r][nt]));
        }
      } else if (m == 2) {
        float sm = 0.f;
#pragma unroll
        for (int nt = 0; nt < 4; nt++) sm += o[nt][r];
        sm = xor16_sum(sm);
        float mean = sm * (1.f / 64.f);
        float ss = 0.f;
#pragma unroll
        for (int nt = 0; nt < 4; nt++) { float dd = o[nt][r] - mean; ss += dd * dd; }
        ss = xor16_sum(ss);
        float rinv = rsqrtf(ss * (1.f / 64.f) + 1e-6f);
#pragma unroll
        for (int nt = 0; nt < 4; nt++) {
          int c = h * 64 + nt * 16 + lr;
          MIX[(size_t)row * 1024 + 768 + c] = f2bf((o[nt][r] - mean) * rinv * silu_f(ga[r][nt]));
        }
      } else {
        float dsk = p.in[23][l * 4 + h];
        float ss = 0.f;
#pragma unroll
        for (int nt = 0; nt < 4; nt++) {
          int c = h * 64 + nt * 16 + lr;
          float y = (o[nt][r] + dsk * ga[r][nt]) * silu_f(gb[r][nt]);
          u16 yb = f2bf(y);
          float yr = bf2f(yb);
          ss += yr * yr;
          MIX[(size_t)row * 1024 + 512 + c] = yb;
        }
        ss = xor16_sum(ss);
        if (lr == 0) SSQ[(size_t)row * 4 + h] = ss;
      }
    }
  }
}

__device__ __forceinline__ void ph_ln1(const P& p, int l, int nrows) {
  OPAQUE_Z;
  float* xc = (float*)(p.ws + zz + O_XCUR);
  u16* xm = (u16*)(p.ws + zz + O_XMOD);
  const float* MOD = (const float*)(p.ws + zz + O_MOD);
  const int lane = (threadIdx.x + zz) & 63;
  int gw = ((blockIdx.x + zz) * NTHR + (threadIdx.x + zz)) >> 6, nw = ((gridDim.x + zz) * NTHR) >> 6;
  const float* g1 = p.in[26] + l * 1024; const float* b1 = p.in[27] + l * 1024;
  f32x4 gg[4], bb[4];
#pragma unroll
  for (int q = 0; q < 4; q++) { gg[q] = *(const f32x4*)(g1 + q * 256 + lane * 4); bb[q] = *(const f32x4*)(b1 + q * 256 + lane * 4); }
  f32x4 cur[4];
#pragma unroll
  for (int q = 0; q < 4; q++) cur[q] = (gw < nrows) ? *(const f32x4*)(xc + (size_t)gw * 1024 + q * 256 + lane * 4) : (f32x4){0.f, 0.f, 0.f, 0.f};
  for (int row = gw; row < nrows; row += nw) {
    float* xr = xc + (size_t)row * 1024;
    const float* m = MOD + (size_t)(l * 9 + modrow_of(row)) * 6144;
    f32x4 nxt[4], sh[4], sc[4];
    const int rown = row + nw;
#pragma unroll
    for (int q = 0; q < 4; q++) {
      nxt[q] = (rown < nrows) ? *(const f32x4*)(xc + (size_t)rown * 1024 + q * 256 + lane * 4) : (f32x4){0.f, 0.f, 0.f, 0.f};
      sh[q] = *(const f32x4*)(m + 3 * 1024 + q * 256 + lane * 4);
      sc[q] = *(const f32x4*)(m + 4 * 1024 + q * 256 + lane * 4);
    }
    float s = 0.f;
#pragma unroll
    for (int q = 0; q < 4; q++) s += (cur[q][0] + cur[q][1]) + (cur[q][2] + cur[q][3]);
    float mean = wave_sum(s) * (1.f / 1024.f);
    float ss = 0.f;
#pragma unroll
    for (int q = 0; q < 4; q++)
#pragma unroll
      for (int e = 0; e < 4; e++) { float dd = cur[q][e] - mean; ss += dd * dd; }
    float rinv = rsqrtf(wave_sum(ss) * (1.f / 1024.f) + 1e-5f);
#pragma unroll
    for (int q = 0; q < 4; q++) {
      int c = q * 256 + lane * 4;
      f32x4 y;
#pragma unroll
      for (int e = 0; e < 4; e++) y[e] = (cur[q][e] - mean) * rinv * gg[q][e] + bb[q][e];
      *(f32x4*)(xr + c) = y;
      uint2 o; o.x = pack2(y[0] * (1.f + sc[q][0]) + sh[q][0], y[1] * (1.f + sc[q][1]) + sh[q][1]);
      o.y = pack2(y[2] * (1.f + sc[q][2]) + sh[q][2], y[3] * (1.f + sc[q][3]) + sh[q][3]);
      *(uint2*)(xm + (size_t)row * 1024 + c) = o;
    }
#pragma unroll
    for (int q = 0; q < 4; q++) cur[q] = nxt[q];
  }
}

#define TOPK_INSERT(v_, id_)                                   \
  {                                                            \
    float vv_ = (v_); int ii_ = (id_);                         \
    _Pragma("unroll") for (int q_ = 0; q_ < 16; q_++) {        \
      bool gt_ = vv_ > tv[q_];                                 \
      float ov_ = tv[q_]; int oi_ = ti[q_];                    \
      tv[q_] = gt_ ? vv_ : ov_; ti[q_] = gt_ ? ii_ : oi_;      \
      vv_ = gt_ ? ov_ : vv_; ii_ = gt_ ? oi_ : ii_;            \
    }                                                          \
  }

DEV u32 mono_key(float v, u32 mask, int tag) {
  u32 u = __float_as_uint(v);
  u32 k = (u & 0x80000000u) ? ~u : (u | 0x80000000u);
  return (k & ~mask) | (u32)tag;
}
DEV float key_value(u32 k, u32 mask) {
  k &= ~mask;
  u32 u = (k & 0x80000000u) ? (k & 0x7fffffffu) : ~k;
  return __uint_as_float(u);
}
#define MONO_KEY(v_, m_, t_) mono_key((v_), (m_), (t_))
#define KEY_VALUE(k_, m_) key_value((k_), (m_))
#define KEY_INSERT(k_)                                         \
  {                                                            \
    u32 kk_ = (k_);                                            \
    _Pragma("unroll") for (int q_ = 0; q_ < 16; q_++) {        \
      u32 hi_ = max(tk[q_], kk_);                              \
      kk_ = min(tk[q_], kk_);                                  \
      tk[q_] = hi_;                                            \
    }                                                          \
  }
typedef float f32x2 __attribute__((ext_vector_type(2)));
#define DOT8(acc_, w_, x0_, x1_, x2_, x3_)                                          \
  {                                                                                 \
    f32x2 lo_ = __builtin_amdgcn_cvt_pk_f32_fp8((int)(w_), false);                  \
    f32x2 hi_ = __builtin_amdgcn_cvt_pk_f32_fp8((int)(w_), true);                   \
    acc_ += x0_ * lo_[0]; acc_ += x1_ * lo_[1]; acc_ += x2_ * hi_[0]; acc_ += x3_ * hi_[1]; \
  }
#define AXPY8(a_, w_, f0_, f1_, f2_, f3_)                                           \
  {                                                                                 \
    f32x2 lo_ = __builtin_amdgcn_cvt_pk_f32_fp8((int)(w_), false);                  \
    f32x2 hi_ = __builtin_amdgcn_cvt_pk_f32_fp8((int)(w_), true);                   \
    f0_ += a_ * lo_[0]; f1_ += a_ * lo_[1]; f2_ += a_ * hi_[0]; f3_ += a_ * hi_[1]; \
  }
#define PEER_LOAD(U_, V_, G_, SU_, SV_, e0_)                                        \
  _Pragma("unroll") for (int q_ = 0; q_ < 4; q_++) {                                \
    int e_ = sE[tok * 128 + (e0_) + q_];                                            \
    G_[q_] = sG[tok * 128 + (e0_) + q_];                                            \
    SU_[q_] = sSU[tok * 128 + (e0_) + q_];                                          \
    SV_[q_] = sSV[tok * 128 + (e0_) + q_];                                          \
    U_[q_] = *(const u32x4*)(UB + (size_t)e_ * 1024 + lane * 16);                   \
    V_[q_] = *(const u32x4*)(VB + (size_t)e_ * 1024 + lane * 16);                   \
  }
#define PEER_COMPUTE(U_, V_, G_, SU_, SV_)                                          \
  _Pragma("unroll") for (int q_ = 0; q_ < 4; q_++) {                                \
    float d_ = 0.f;                                                                 \
    DOT8(d_, U_[q_][0], xv[0], xv[1], xv[2], xv[3]);                                \
    DOT8(d_, U_[q_][1], xv[4], xv[5], xv[6], xv[7]);                                \
    DOT8(d_, U_[q_][2], xv[8], xv[9], xv[10], xv[11]);                              \
    DOT8(d_, U_[q_][3], xv[12], xv[13], xv[14], xv[15]);                            \
    d_ = wave_sum(d_) * SU_[q_];                                                    \
    float act_ = 0.5f * d_ * (1.f + erff(d_ * 0.7071067811865476f)) * G_[q_] * SV_[q_]; \
    AXPY8(act_, V_[q_][0], f[0], f[1], f[2], f[3]);                                 \
    AXPY8(act_, V_[q_][1], f[4], f[5], f[6], f[7]);                                 \
    AXPY8(act_, V_[q_][2], f[8], f[9], f[10], f[11]);                               \
    AXPY8(act_, V_[q_][3], f[12], f[13], f[14], f[15]);                             \
  }

__device__ __forceinline__ void ph_peer(const P& p, int l, int nrows, char* smem, int dryc) {
  OPAQUE_Z;
  const int dry = zz + dryc;
  const u16* SC = (const u16*)(p.ws + zz + O_P);
  float* xc = (float*)(p.ws + zz + O_XCUR);
  u16* xm = (u16*)(p.ws + zz + O_XMOD);
  const float* MOD = (const float*)(p.ws + zz + O_MOD);
  const unsigned char* UB = (const unsigned char*)(p.ws + zz + O_UBF) + (size_t)l * 16384 * 1024;
  const unsigned char* VB = (const unsigned char*)(p.ws + zz + O_VBF) + (size_t)l * 16384 * 1024;
  const float* USC = (const float*)(p.ws + zz + O_USC) + l * 16384;
  const float* VSC = (const float*)(p.ws + zz + O_VSC) + l * 16384;
  float* sLV = (float*)smem;
  int* sLI = (int*)(smem + 16384);
  int* sE = (int*)(smem + 32768);
  float* sG = (float*)(smem + 40960);
  float* sSU = (float*)(smem + 49152);
  float* sSV = (float*)(smem + 57344);
  const int tid = (threadIdx.x + zz), lane = tid & 63, wave = tid >> 6;
  const float* g2 = p.in[32] + l * 1024; const float* b2 = p.in[33] + l * 1024;
  const int ntok = (nrows == T_ALL) ? 12 : 16;
  const int ngroups = nrows / ntok;
  for (int grp = (blockIdx.x + zz); grp < ngroups; grp += (gridDim.x + zz)) {
    int rowb = grp * ntok;
    __syncthreads();
    if (tid < ntok * 16) {
      int tok = tid >> 4, lst = tid & 15;
      const u32x4* s4 = (const u32x4*)(SC + (size_t)(rowb + tok) * 2048 + lst * 128);
      u32 tk[16];
#pragma unroll
      for (int q = 0; q < 16; q++) tk[q] = 0u;
      u32x4 cur[4], nxt[4];
#pragma unroll
      for (int q = 0; q < 4; q++) { cur[q] = s4[q]; nxt[q] = cur[q]; }
#pragma unroll 1
      for (int c0 = 0; c0 < 16; c0 += 4) {
        if (c0 + 4 < 16) {
#pragma unroll
          for (int q = 0; q < 4; q++) nxt[q] = s4[c0 + 4 + q];
        }
#pragma unroll
        for (int q = 0; q < 4; q++) {
          const int c = c0 + q;
          const u32x4 sv = cur[q];
#pragma unroll
          for (int e = 0; e < 4; e++) {
            KEY_INSERT(MONO_KEY(lo2f(sv[e]), 127u, 127 - (c * 8 + e * 2 + 0)));
            KEY_INSERT(MONO_KEY(hi2f(sv[e]), 127u, 127 - (c * 8 + e * 2 + 1)));
          }
        }
#pragma unroll
        for (int q = 0; q < 4; q++) cur[q] = nxt[q];
      }
#pragma unroll
      for (int q = 0; q < 16; q++) { sLV[tid * 16 + q] = KEY_VALUE(tk[q], 127u); sLI[tid * 16 + q] = 127 - (int)(tk[q] & 127u); }
    }
    __syncthreads();
    if (tid < ntok * 8) {
      int tok = tid >> 3, h = tid & 7;
      const float* v1 = sLV + (tok * 16 + h * 2) * 16; const float* v2 = v1 + 16;
      const int* i1 = sLI + (tok * 16 + h * 2) * 16; const int* i2 = i1 + 16;
      float a1[16], a2[16];
#pragma unroll
      for (int q = 0; q < 16; q++) { a1[q] = v1[q]; a2[q] = v2[q]; }
      u32 tk[16];
#pragma unroll
      for (int q = 0; q < 16; q++) tk[q] = 0u;
#pragma unroll
      for (int a = 0; a < 16; a++) {
#pragma unroll
        for (int bq = 0; bq < 16; bq++) {
          if ((a + 1) * (bq + 1) <= 16) { KEY_INSERT(MONO_KEY(a1[a] + a2[bq], 255u, 255 - (a * 16 + bq))); }
        }
      }
      float mx = KEY_VALUE(tk[0], 255u); float sum = 0.f; float ex[16];
#pragma unroll
      for (int q = 0; q < 16; q++) { ex[q] = __expf(KEY_VALUE(tk[q], 255u) - mx); sum += ex[q]; }
      float inv = 1.f / sum;
#pragma unroll
      for (int q = 0; q < 16; q++) {
        int ci = 255 - (int)(tk[q] & 255u);
        int e = i1[ci >> 4] * 128 + i2[ci & 15];
        sE[tok * 128 + h * 16 + q] = e;
        sG[tok * 128 + h * 16 + q] = ex[q] * inv;
        sSU[tok * 128 + h * 16 + q] = USC[e];
        sSV[tok * 128 + h * 16 + q] = VSC[e];
      }
    }
    __syncthreads();
    int* sE2 = (int*)smem;
    float* sGV2 = (float*)(smem + 8192);
    float* sSU2 = (float*)(smem + 16384);
    int* sCnt = (int*)(smem + 24576);
    {
#pragma unroll 1
      for (int i = tid; i < ntok * 128; i += NTHR) {
        int key = sE[i] >> 11;
#pragma unroll
        for (int sl = 0; sl < 8; sl++) {
          unsigned long long mk = __ballot(key == sl);
          if (lane == sl) sCnt[(i >> 6) * 8 + sl] = __popcll(mk);
        }
      }
      __syncthreads();
#pragma unroll 1
      for (int i = tid; i < ntok * 128; i += NTHR) {
        int tok = i >> 7, half = (i >> 6) & 1;
        int e = sE[i]; int key = e >> 11;
        int within = 0;
#pragma unroll
        for (int sl = 0; sl < 8; sl++) {
          unsigned long long mk = __ballot(key == sl);
          if (key == sl) within = __popcll(mk & ((1ull << lane) - 1ull));
        }
        const int* c0 = sCnt + tok * 16; const int* c1 = c0 + 8;
        int base = half ? c0[key] : 0;
#pragma unroll
        for (int sl = 0; sl < 8; sl++) base += (sl < key) ? (c0[sl] + c1[sl]) : 0;
        int dst = tok * 128 + base + within;
        sE2[dst] = e; sGV2[dst] = sG[i] * sSV[i]; sSU2[dst] = sSU[i];
      }
    }
    __syncthreads();
    {
      const int n = ntok >> 2;
      unsigned char* sX8 = (unsigned char*)(smem + 32768);
      const int lr = lane & 15, lq = lane >> 4;
      int vz; asm volatile("v_mov_b32 %0, 0" : "=v"(vz));
      float* sQinv = (float*)(smem + 24576 + 1024);
#pragma unroll 1
      for (int tk = 0; tk < n; tk++) {
        int row = rowb + wave * n + tk;
        float xv[16];
        u32x4 a = *(const u32x4*)(xm + (size_t)row * 1024 + lane * 16);
        u32x4 bq = *(const u32x4*)(xm + (size_t)row * 1024 + lane * 16 + 8);
        unpack8(a, xv); unpack8(bq, xv + 8);
        float am = 0.f;
#pragma unroll
        for (int i = 0; i < 16; i++) am = fmaxf(am, fabsf(xv[i]));
        am = fmaxf(am, __shfl_xor(am, 1, 64)); am = fmaxf(am, __shfl_xor(am, 2, 64)); am = fmaxf(am, __shfl_xor(am, 4, 64));
        am = fmaxf(am, __shfl_xor(am, 8, 64)); am = fmaxf(am, __shfl_xor(am, 16, 64)); am = fmaxf(am, __shfl_xor(am, 32, 64));
        float qs = am > 0.f ? 240.f / am : 1.f;
        if (lane == 0) sQinv[wave * 4 + tk] = am > 0.f ? am * (1.f / 240.f) : 1.f;
        u32x4 x8; int w;
#pragma unroll
        for (int i = 0; i < 4; i++) {
          w = 0;
          w = __builtin_amdgcn_cvt_pk_fp8_f32(xv[i * 4 + 0] * qs, xv[i * 4 + 1] * qs, w, false);
          w = __builtin_amdgcn_cvt_pk_fp8_f32(xv[i * 4 + 2] * qs, xv[i * 4 + 3] * qs, w, true);
          x8[i] = (u32)w;
        }
        *(u32x4*)(sX8 + (wave * 4 + tk) * 1024 + lane * 16) = x8;
      }
#define PEER_ACCV(V_, q0_)                                                            \
  _Pragma("unroll") for (int q_ = 0; q_ < 8; q_++) {                                  \
    float a_ = sGV2[nb + (q0_) + q_ + vz];                                            \
    f32x2 a2_ = (f32x2){a_, a_};                                                      \
    _Pragma("unroll") for (int i_ = 0; i_ < 4; i_++) {                                \
      f32x2 lo_ = __builtin_amdgcn_cvt_pk_f32_fp8((int)V_[q_][i_], false);            \
      f32x2 hi_ = __builtin_amdgcn_cvt_pk_f32_fp8((int)V_[q_][i_], true);             \
      f2[j][i_ * 2] += lo_ * a2_; f2[j][i_ * 2 + 1] += hi_ * a2_;                     \
    }                                                                                 \
  }
      {
        const int nit = 8 * n;
        u32x4 bA[16], bB[16];
#define PEER_ULOAD(B_, it_)                                                                   \
  {                                                                                           \
    const int c_ = (it_) / n, tk_ = (it_) - c_ * n;                                           \
    const int nb_ = (wave * n + tk_) * 128 + c_ * 16;                                         \
    const unsigned ub_ = (unsigned)sE2[nb_ + lr] * 1024u + (unsigned)(lq * 16);               \
    _Pragma("unroll") for (int kc_ = 0; kc_ < 16; kc_++) B_[kc_] = *(const u32x4*)(UB + (ub_ + (unsigned)(kc_ * 64))); \
  }
#define PEER_UCOMP(B_, it_)                                                                   \
  {                                                                                           \
    const int c_ = (it_) / n, tk_ = (it_) - c_ * n;                                           \
    const int nb_ = (wave * n + tk_) * 128 + c_ * 16;                                         \
    f32x4 acc_ = (f32x4){0.f, 0.f, 0.f, 0.f};                                                 \
    const unsigned char* xa_ = sX8 + (wave * 4 + tk_) * 1024 + lq * 16;                       \
    _Pragma("unroll") for (int kc_ = 0; kc_ < 16; kc_++) {                                    \
      u32x4 a_ = *(const u32x4*)(xa_ + kc_ * 64);                                             \
      long alo_ = (long)(((unsigned long)a_[1] << 32) | (unsigned long)a_[0]);                \
      long ahi_ = (long)(((unsigned long)a_[3] << 32) | (unsigned long)a_[2]);                \
      long blo_ = (long)(((unsigned long)B_[kc_][1] << 32) | (unsigned long)B_[kc_][0]);      \
      long bhi_ = (long)(((unsigned long)B_[kc_][3] << 32) | (unsigned long)B_[kc_][2]);      \
      acc_ = __builtin_amdgcn_mfma_f32_16x16x32_fp8_fp8(alo_, blo_, acc_, 0, 0, 0);           \
      acc_ = __builtin_amdgcn_mfma_f32_16x16x32_fp8_fp8(ahi_, bhi_, acc_, 0, 0, 0);           \
    }                                                                                         \
    float d_ = acc_[0] * sQinv[wave * 4 + tk_] * sSU2[nb_ + lr];                              \
    float act_ = 0.5f * d_ * (1.f + erff(d_ * 0.7071067811865476f)) * sGV2[nb_ + lr];         \
    if (lq == 0) sGV2[nb_ + lr] = act_;                                                       \
  }
        PEER_ULOAD(bA, 0);
#pragma unroll 1
        for (int it = 0; it < nit; it += 2) {
          PEER_ULOAD(bB, it + 1);
          PEER_UCOMP(bA, it);
          if (it + 2 < nit) { PEER_ULOAD(bA, it + 2); }
          PEER_UCOMP(bB, it + 1);
        }
      }
#pragma unroll 1
      for (int t0 = 0; t0 < n; t0 += 2) {
        f32x2 f2[2][8];
#pragma unroll
        for (int j = 0; j < 2; j++)
#pragma unroll
          for (int i = 0; i < 8; i++) f2[j][i] = (f32x2){0.f, 0.f};
        {
          u32x4 vA[8], vB[8];
#define PEER_VLOAD(V_, c_, j_, h_)                                                            \
  if (t0 + (j_) < n) {                                                                        \
    const int nb_ = (wave * n + t0 + (j_)) * 128 + (c_) * 16 + (h_) * 8;                      \
    _Pragma("unroll") for (int q_ = 0; q_ < 8; q_++) {                                        \
      unsigned e_ = (unsigned)sE2[nb_ + q_ + vz];                                             \
      V_[q_] = *(const u32x4*)(VB + (e_ * 1024u + (unsigned)(lane * 16)));                    \
    }                                                                                         \
  }
#define PEER_VCOMP(V_, c_, j_, h_)                                                            \
  if (t0 + (j_) < n) {                                                                        \
    const int nb_ = (wave * n + t0 + (j_)) * 128 + (c_) * 16 + (h_) * 8;                      \
    _Pragma("unroll") for (int q_ = 0; q_ < 8; q_++) {                                        \
      float a_ = sGV2[nb_ + q_ + vz];                                                         \
      f32x2 a2_ = (f32x2){a_, a_};                                                            \
      _Pragma("unroll") for (int i_ = 0; i_ < 4; i_++) {                                      \
        f32x2 lo_ = __builtin_amdgcn_cvt_pk_f32_fp8((int)V_[q_][i_], false);                  \
        f32x2 hi_ = __builtin_amdgcn_cvt_pk_f32_fp8((int)V_[q_][i_], true);                   \
        f2[j_][i_ * 2] += lo_ * a2_; f2[j_][i_ * 2 + 1] += hi_ * a2_;                         \
      }                                                                                       \
    }                                                                                         \
  }
          PEER_VLOAD(vA, 0, 0, 0);
#pragma unroll 1
          for (int c = 0; c < 8; c++) {
            PEER_VLOAD(vB, c, 0, 1);
            PEER_VCOMP(vA, c, 0, 0);
            PEER_VLOAD(vA, c, 1, 0);
            PEER_VCOMP(vB, c, 0, 1);
            PEER_VLOAD(vB, c, 1, 1);
            PEER_VCOMP(vA, c, 1, 0);
            if (c + 1 < 8) { PEER_VLOAD(vA, c + 1, 0, 0); }
            PEER_VCOMP(vB, c, 1, 1);
          }
        }
#pragma unroll
        for (int j = 0; j < 2; j++) {
          const int tk = t0 + j;
          if (tk < n) {
            int row = rowb + wave * n + tk;
            float f[16];
#pragma unroll
            for (int i = 0; i < 8; i++) { f[2 * i] = f2[j][i][0]; f[2 * i + 1] = f2[j][i][1]; }
          const float* m = MOD + (size_t)(l * 9 + modrow_of(row)) * 6144;
          float tt[16];
          float* xr = xc + (size_t)row * 1024;
#pragma unroll
          for (int q = 0; q < 4; q++) {
            int c = lane * 16 + q * 4;
            float4 x4 = *(const float4*)(xr + c); float4 g5 = *(const float4*)(m + 5 * 1024 + c);
            tt[q * 4 + 0] = ALPHA * x4.x + g5.x * f[q * 4 + 0];
            tt[q * 4 + 1] = ALPHA * x4.y + g5.y * f[q * 4 + 1];
            tt[q * 4 + 2] = ALPHA * x4.z + g5.z * f[q * 4 + 2];
            tt[q * 4 + 3] = ALPHA * x4.w + g5.w * f[q * 4 + 3];
          }
          float sm = 0.f;
#pragma unroll
          for (int i = 0; i < 16; i++) sm += tt[i];
          float mean = wave_sum(sm) * (1.f / 1024.f);
          float ss = 0.f;
#pragma unroll
          for (int i = 0; i < 16; i++) { float dd = tt[i] - mean; ss += dd * dd; }
          float rinv = rsqrtf(wave_sum(ss) * (1.f / 1024.f) + 1e-5f);
          const float* mn = MOD + (size_t)((l + 1 < 4 ? l + 1 : 3) * 9 + modrow_of(row)) * 6144;
          f32x4 gg4[4], bb4[4], sh4[4], sc4[4];
#pragma unroll
          for (int q = 0; q < 4; q++) {
            int c = lane * 16 + q * 4;
            gg4[q] = *(const f32x4*)(g2 + c); bb4[q] = *(const f32x4*)(b2 + c);
            sh4[q] = *(const f32x4*)(mn + c); sc4[q] = *(const f32x4*)(mn + 1024 + c);
          }
#pragma unroll
          for (int q = 0; q < 4; q++) {
            int c = lane * 16 + q * 4;
            float4 y;
            y.x = (tt[q * 4 + 0] - mean) * rinv * gg4[q][0] + bb4[q][0];
            y.y = (tt[q * 4 + 1] - mean) * rinv * gg4[q][1] + bb4[q][1];
            y.z = (tt[q * 4 + 2] - mean) * rinv * gg4[q][2] + bb4[q][2];
            y.w = (tt[q * 4 + 3] - mean) * rinv * gg4[q][3] + bb4[q][3];
            if (dry) {
            } else if (l == 3) {
              *(float4*)(p.out + (size_t)row * 1024 + c) = y;
            } else {
              *(float4*)(xr + c) = y;
              uint2 o; o.x = pack2(y.x * (1.f + sc4[q][0]) + sh4[q][0], y.y * (1.f + sc4[q][1]) + sh4[q][1]);
              o.y = pack2(y.z * (1.f + sc4[q][2]) + sh4[q][2], y.w * (1.f + sc4[q][3]) + sh4[q][3]);
              *(uint2*)(xm + (size_t)row * 1024 + c) = o;
            }
          }
          }
        }
      }
    }
  }
}

#define XB_TMO      128
#define XB_XCNT(j)  (256  + 64 * (j))
#define XB_XSUB(j)  (1280 + 64 * (j))
#define XB_XGEN(j)  (2304 + 64 * (j))
#define XB_TOP      3328
#define XB_TOPGEN   3392
#define XCD_BAR_WORDS 3456
#define XB_SPIN_CAP (1u << 20)
DEV unsigned xb_ld(unsigned* p) { return __hip_atomic_load(p, __ATOMIC_RELAXED, __HIP_MEMORY_SCOPE_AGENT); }
DEV unsigned xb_add(unsigned* p, unsigned v) { return __hip_atomic_fetch_add(p, v, __ATOMIC_RELAXED, __HIP_MEMORY_SCOPE_AGENT); }
DEV unsigned xb_xcc_id() { return (unsigned)__builtin_amdgcn_s_getreg((3 << 11) | 20) & 0xFu; }
#define XB_SPIN(cond, bar) do { unsigned _sp = 0; while (cond) { __builtin_amdgcn_s_sleep(1); \
    if ((++_sp & 255u) == 0u) { if (xb_ld(&(bar)[XB_TMO])) break; if (_sp > XB_SPIN_CAP) { atomicAdd(&(bar)[XB_TMO], 1u); break; } } } } while (0)
struct XcdBarrier { unsigned* bar; unsigned x; unsigned nloc, nx; };
DEV XcdBarrier xcd_barrier_post(unsigned* bar) {
  XcdBarrier b; b.bar = bar; b.x = xb_xcc_id(); b.nloc = 0u; b.nx = 0u;
  if (threadIdx.x == 0) (void)xb_add(&bar[XB_XCNT(b.x)], 1u);
  return b;
}
DEV void xcd_barrier_complete(unsigned* bar, unsigned x, unsigned& nloc, unsigned& nx) {
  const unsigned G = gridDim.x;
  unsigned sum, cnt, mine, sp = 0u;
  for (;;) {
    sum = 0u; cnt = 0u; mine = 0u;
#pragma unroll
    for (unsigned j = 0; j < 16; ++j) { const unsigned c = xb_ld(&bar[XB_XCNT(j)]); sum += c; cnt += (c > 0u) ? 1u : 0u; mine = (j == x) ? c : mine; }
    if (sum == G) break;
    __builtin_amdgcn_s_sleep(1);
    if ((++sp & 255u) == 0u) { if (xb_ld(&bar[XB_TMO])) break; if (sp > XB_SPIN_CAP) { atomicAdd(&bar[XB_TMO], 1u); break; } }
  }
  nloc = mine > 0u ? mine : 1u; nx = cnt > 0u ? cnt : 1u;
}
DEV void xcd_barrier(XcdBarrier& b) {
  asm volatile("s_waitcnt vmcnt(0)" ::: "memory");
  __syncthreads();
  if (threadIdx.x == 0) {
    unsigned* bar = b.bar;
    __builtin_amdgcn_s_waitcnt(0);
    unsigned nloc = b.nloc, nx = b.nx;
    if (nloc == 0u) { xcd_barrier_complete(bar, b.x, nloc, nx); b.nloc = nloc; b.nx = nx; }
    const unsigned old = xb_add(&bar[XB_XSUB(b.x)], 1u);
    const unsigned gen = old / nloc;
    if (old + 1u == (gen + 1u) * nloc) {
      __builtin_amdgcn_fence(__ATOMIC_RELEASE, "agent");
      asm volatile("s_waitcnt vmcnt(0)" ::: "memory");
      const unsigned og = xb_add(&bar[XB_TOP], 1u);
      const unsigned tg = og / nx;
      if (og + 1u == (tg + 1u) * nx) xb_add(&bar[XB_TOPGEN], 1u);
      else XB_SPIN(xb_ld(&bar[XB_TOPGEN]) == tg, bar);
      __builtin_amdgcn_fence(__ATOMIC_ACQUIRE, "agent");
      xb_add(&bar[XB_XGEN(b.x)], 1u);
      asm volatile("s_waitcnt vmcnt(0)" ::: "memory");
    } else {
      XB_SPIN(xb_ld(&bar[XB_XGEN(b.x)]) == gen, bar);
      __builtin_amdgcn_fence(__ATOMIC_ACQUIRE, "agent");
      asm volatile("s_waitcnt vmcnt(0)" ::: "memory");
    }
  }
  __syncthreads();
}

#define KARGP(z_) ((const P*)(const void*)((const __attribute__((address_space(4))) char*)__builtin_amdgcn_kernarg_segment_ptr() + (z_)))
__global__ void __launch_bounds__(NTHR, 2) mega(P p) {
  cg::grid_group grid = cg::this_grid();
  __shared__ __attribute__((aligned(16))) char smem[65536];
  if (blockIdx.x == 0) { unsigned* bw = (unsigned*)(p.ws + O_BAR); for (int i = threadIdx.x; i < 3456; i += NTHR) bw[i] = 0u; }
  {
    OPAQUE_Z; const P& q = *KARGP(zz);
    ph_mod(q, smem);
    ph_convert(q, smem);
  }
  grid.sync();
  XcdBarrier xb = xcd_barrier_post((unsigned*)(p.ws + O_BAR));
#pragma unroll 1
  for (int st = -1; st < 40; st++) {
    const int l = st < 0 ? 0 : st / 10;
    const int ph = st < 0 ? -1 : st - l * 10;
    const int need_ctx = l < 3;
    const int nrows = need_ctx ? T_ALL : T_LAT;
    switch (ph) {
      case -1: {
        OPAQUE_Z; const P& q = *KARGP(zz);
        ph_fold(q, smem);
        ph_xinit(q);
        break;
      }
      case 0: {
        OPAQUE_Z; const P& q = *KARGP(zz);
        gemm_phase<EPI_BF16>(q, l, (const u16*)(q.ws + O_XMOD), 1024, (const u16*)(q.ws + O_WINT) + (size_t)l * 3072 * 1024, 1024, 1024,
                             T_ALL / 128, 24, (void*)(q.ws + O_P), LDP, smem);
        break;
      }
      case 1: {
        OPAQUE_Z; const P& q = *KARGP(zz);
        gemm_phase<EPI_Q>(q, l, (const u16*)(q.ws + O_P), LDP, (const u16*)(q.ws + O_WUQT) + (size_t)l * 384 * 256, 256, 256,
                          T_ALL / 128, 3, nullptr, 0, smem);
        gemm_phase<EPI_KV>(q, l, (const u16*)(q.ws + O_P) + 256, LDP, (const u16*)(q.ws + O_WUKVT) + (size_t)l * 512 * 128, 128, 128,
                           T_ALL / 128, 4, nullptr, 0, smem);
        ph_prep(q, l, smem);
        break;
      }
      case 2: {
        OPAQUE_Z; const P& q = *KARGP(zz);
        ph_scan1(q, smem);
        break;
      }
      case 3: {
        OPAQUE_Z; const P& q = *KARGP(zz);
        ph_scan2(q);
        ph_attn(q, need_ctx, smem);
        break;
      }
      case 4: {
        OPAQUE_Z; const P& q = *KARGP(zz);
        ph_scan3(q, l, need_ctx, smem);
        break;
      }
      case 5: {
        OPAQUE_Z; const P& q = *KARGP(zz);
        gemm_phase<EPI_OUT>(q, l, (const u16*)(q.ws + O_MIX), 1024, (const u16*)(q.ws + O_WOUTT) + (size_t)l * 1024 * 1024, 1024, 1024,
                            nrows / 128, 8, nullptr, 0, smem);
        break;
      }
      case 6: {
        OPAQUE_Z; const P& q = *KARGP(zz);
        ph_ln1(q, l, nrows);
        break;
      }
      case 7: {
        OPAQUE_Z; const P& q = *KARGP(zz);
        gemm_phase<EPI_BF16>(q, l, (const u16*)(q.ws + O_XMOD), 1024, (const u16*)(q.ws + O_WPT) + (size_t)l * 2048 * 1024, 1024, 1024,
                             nrows / 128, 16, (void*)(q.ws + O_P), 2048, smem);
        break;
      }
      case 8: {
        OPAQUE_Z; const P& q = *KARGP(zz);
        ph_peer(q, l, nrows, smem, 0);
        break;
      }
      default:
        break;
    }
    if (ph != 9) xcd_barrier(xb);
  }
}

extern "C" void kernel_launch(void* const* d_in, const int* in_sizes, int n_in, void* d_out, int out_size, void* d_ws,
                              size_t ws_size, hipStream_t stream) {
  static int grid_blocks = 0;
  if (!grid_blocks) {
    int dev = 0, cus = 0, per_cu = 0;
    (void)hipGetDevice(&dev);
    (void)hipDeviceGetAttribute(&cus, hipDeviceAttributeMultiprocessorCount, dev);
    (void)hipOccupancyMaxActiveBlocksPerMultiprocessor(&per_cu, mega, NTHR, 0);
    if (per_cu > 2) per_cu = 2;
    if (per_cu < 1) per_cu = 1;
    grid_blocks = cus * per_cu;
  }
  if (ws_size < WS_TOTAL) { fprintf(stderr, "workspace too small: %zu < %zu\n", ws_size, (size_t)WS_TOTAL); return; }
  P p{};
  for (int i = 0; i < 34; i++) p.in[i] = (const float*)d_in[i];
  p.out = (float*)d_out;
  p.ws = (char*)d_ws;
  void* args[] = {&p};
  hipError_t e = hipLaunchCooperativeKernel((void*)mega, dim3(grid_blocks), dim3(NTHR), args, 0, stream);
  if (e != hipSuccess) fprintf(stderr, "cooperative launch failed: %s (grid %d)\n", hipGetErrorString(e), grid_blocks);
}
```

```cpp
#include <hip/hip_runtime.h>
#include <hip/hip_cooperative_groups.h>
#include <cstdio>
namespace cg = cooperative_groups;

#define DEV __device__ __forceinline__
typedef unsigned short u16;
typedef unsigned int u32;
typedef short bf16x8 __attribute__((ext_vector_type(8)));
typedef float f32x4 __attribute__((ext_vector_type(4)));
typedef unsigned int u32x4 __attribute__((ext_vector_type(4)));

#define T_ALL 18432
#define T_LAT 16384
#define LDP 3072
#define ALPHA 1.681792830507429f
#define NTHR 256
#ifndef PROBE_REP
#define PROBE_REP 0
#endif

constexpr size_t al(size_t x) { return (x + 255) & ~(size_t)255; }
constexpr size_t O_MOD = 0;
constexpr size_t O_AXC = al(O_MOD + 4ull * 9 * 6144 * 4);
constexpr size_t O_AXS = al(O_AXC + 64 * 8 * 4);
constexpr size_t O_RC = al(O_AXS + 64 * 8 * 4);
constexpr size_t O_RS = al(O_RC + 2048 * 16 * 4);
constexpr size_t O_WINT = al(O_RS + 2048 * 16 * 4);
constexpr size_t O_WUQT = al(O_WINT + 4ull * 3072 * 1024 * 2);
constexpr size_t O_WUKVT = al(O_WUQT + 4ull * 384 * 256 * 2);
constexpr size_t O_WOUTT = al(O_WUKVT + 4ull * 512 * 128 * 2);
constexpr size_t O_WQBF = al(O_WOUTT + 4ull * 1024 * 1024 * 2);
constexpr size_t O_KEYBF = al(O_WQBF + 4ull * 1024 * 2048 * 2);
constexpr size_t O_WPT = al(O_KEYBF + 4ull * 2 * 128 * 128 * 2);
constexpr size_t O_UBF = al(O_WPT + 4ull * 2048 * 1024 * 2);
constexpr size_t O_VBF = al(O_UBF + 4ull * 16384 * 1024);
constexpr size_t O_USC = al(O_VBF + 4ull * 16384 * 1024);
constexpr size_t O_VSC = al(O_USC + 4ull * 16384 * 4);
constexpr size_t O_XCUR = al(O_VSC + 4ull * 16384 * 4);
constexpr size_t O_XMOD = al(O_XCUR + (size_t)T_ALL * 1024 * 4);
constexpr size_t O_MIX = al(O_XMOD + (size_t)T_ALL * 1024 * 2);
constexpr size_t O_P = al(O_MIX + (size_t)T_ALL * 1024 * 2);
constexpr size_t O_QB = al(O_P + (size_t)T_ALL * 2048 * 4);
constexpr size_t O_KN = al(O_QB + (size_t)T_ALL * 384 * 2);
constexpr size_t O_VT = al(O_KN + (size_t)T_ALL * 256 * 2);
constexpr size_t O_KR = al(O_VT + 8ull * 4 * 64 * 2304 * 2);
constexpr size_t O_LGG = al(O_KR + (size_t)T_ALL * 32 * 2);
constexpr size_t O_XBC = al(O_LGG + 2ull * T_ALL * 128 * 4);
constexpr size_t O_DT = al(O_XBC + (size_t)T_ALL * 768 * 2);
constexpr size_t O_LA = al(O_DT + 2ull * T_ALL * 4 * 4);
constexpr size_t O_QKR = al(O_LA + 2ull * T_ALL * 4 * 4);
constexpr size_t O_SLOC = al(O_QKR + (size_t)T_ALL * 256 * 2);
constexpr size_t SLOC_G = 0, SLOC_S = 2304ull * 2048, SLOC_R = SLOC_S + 2304ull * 8192;
constexpr size_t O_DEC = al(O_SLOC + (SLOC_R + 2304ull * 2048) * 4);
constexpr size_t DEC_G = 0, DEC_S = 2304 * 32, DEC_R = DEC_S + 2304;
constexpr size_t O_SIN = al(O_DEC + (DEC_R + 2304) * 4);
constexpr size_t O_SSQ = al(O_SIN + (SLOC_R + 2304ull * 2048) * 2);
constexpr size_t O_BAR = al(O_SSQ + (size_t)T_ALL * 4 * 4);
constexpr size_t WS_TOTAL = al(O_BAR + 3456 * 4);

struct P {
  const float* in[34];
  float* out;
  char* ws;
};

DEV u16 f2bf_sw(float f) { u32 u = __float_as_uint(f); u += 0x7fffu + ((u >> 16) & 1u); return (u16)(u >> 16); }
DEV float bf2f(u16 h) { return __uint_as_float(((u32)h) << 16); }
typedef float f32x2_t __attribute__((ext_vector_type(2)));
typedef __bf16 bf16x2_t __attribute__((ext_vector_type(2)));
DEV u32 pack2(float a, float b) {
  f32x2_t v = {a, b};
  bf16x2_t r = __builtin_convertvector(v, bf16x2_t);
  return __builtin_bit_cast(u32, r);
}
DEV u16 f2bf(float f) { return (u16)(pack2(f, 0.f) & 0xffffu); }
DEV float lo2f(u32 w) { return __uint_as_float(w << 16); }
DEV float hi2f(u32 w) { return __uint_as_float(w & 0xffff0000u); }
DEV float silu_f(float x) { return x / (1.f + __expf(-x)); }
DEV float softplus_f(float x) { return fmaxf(x, 0.f) + log1pf(expf(-fabsf(x))); }
DEV int modrow_of(int row) { return row < T_LAT ? (row >> 11) : 8; }
DEV int tpos_of(int row) { return row < T_LAT ? (row & 2047) : ((row - T_LAT) & 255); }
DEV int chunk_row0(int b, int gc) { return gc < 4 ? (T_LAT + b * 256 + gc * 64) : (b * 2048 + (gc - 4) * 64); }
DEV f32x4 mfma16(bf16x8 a, bf16x8 b, f32x4 c) { return __builtin_amdgcn_mfma_f32_16x16x32_bf16(a, b, c, 0, 0, 0); }
DEV float xor16_sum(float v) {
  v += __shfl_xor(v, 1, 64); v += __shfl_xor(v, 2, 64); v += __shfl_xor(v, 4, 64); v += __shfl_xor(v, 8, 64); return v;
}
DEV float xor16_max(float v) {
  v = fmaxf(v, __shfl_xor(v, 1, 64)); v = fmaxf(v, __shfl_xor(v, 2, 64)); v = fmaxf(v, __shfl_xor(v, 4, 64)); v = fmaxf(v, __shfl_xor(v, 8, 64)); return v;
}
#define OPAQUE_Z int zz; asm volatile("s_mov_b32 %0, 0" : "=s"(zz))
DEV float wave_sum(float v) {
  v += __shfl_xor(v, 1, 64); v += __shfl_xor(v, 2, 64); v += __shfl_xor(v, 4, 64); v += __shfl_xor(v, 8, 64);
  v += __shfl_xor(v, 16, 64); v += __shfl_xor(v, 32, 64); return v;
}

DEV void unpack8(u32x4 w, float* o) {
  o[0] = lo2f(w[0]); o[1] = hi2f(w[0]); o[2] = lo2f(w[1]); o[3] = hi2f(w[1]);
  o[4] = lo2f(w[2]); o[5] = hi2f(w[2]); o[6] = lo2f(w[3]); o[7] = hi2f(w[3]);
}
DEV u32x4 pack8(const float* o) {
  u32x4 w; w[0] = pack2(o[0], o[1]); w[1] = pack2(o[2], o[3]); w[2] = pack2(o[4], o[5]); w[3] = pack2(o[6], o[7]); return w;
}


DEV void sincos_rev(double ang, float& c, float& s) {
  double rev = ang * 0.15915494309189533576888;
  rev -= floor(rev + 0.5);
  double x = rev * 6.28318530717958647692;
  double x2 = x * x;
  double sv = 1.0, cv = 1.0;
  double ts = 1.0, tc = 1.0;
  sv = 0.0; cv = 0.0;
  double term = 1.0;
  double cterm = 1.0, sterm = 1.0;
  cv = 1.0; sv = 1.0;
#pragma unroll
  for (int n = 1; n <= 13; n++) {
    cterm *= -x2 / (double)((2 * n - 1) * (2 * n));
    sterm *= -x2 / (double)((2 * n) * (2 * n + 1));
    cv += cterm; sv += sterm;
  }
  (void)ts; (void)tc; (void)term;
  c = (float)cv; s = (float)(sv * x);
}

__device__ __forceinline__ void ph_mod(const P& p, char* smem) {
  OPAQUE_Z;
  float* MOD = (float*)(p.ws + zz + O_MOD);
  float* sS = (float*)smem;
  float* red = sS + 9 * 1024;
  const int tid = (threadIdx.x + zz);
  for (int i = tid; i < 9 * 1024; i += NTHR) {
    int r = i >> 10, k = i & 1023;
    float v = (r < 8) ? p.in[1][r * 1024 + k] : p.in[3][k];
    sS[i] = v / (1.f + expf(-v));
  }
  __syncthreads();
  for (int task = (blockIdx.x + zz); task < 4 * 96; task += (gridDim.x + zz)) {
    int l = task / 96, n0 = (task % 96) * 64;
    int col = tid & 63, ks = tid >> 6;
    const float* w = p.in[4] + (size_t)l * 1024 * 6144 + (size_t)(ks * 256) * 6144 + n0 + col;
    float acc[9];
#pragma unroll
    for (int r = 0; r < 9; r++) acc[r] = 0.f;
#pragma unroll 16
    for (int k = 0; k < 256; k++) {
      float wv = w[(size_t)k * 6144];
      const float* s = sS + ks * 256 + k;
#pragma unroll
      for (int r = 0; r < 9; r++) acc[r] += s[r * 1024] * wv;
    }
#pragma unroll
    for (int r = 0; r < 9; r++) red[(ks * 9 + r) * 64 + col] = acc[r];
    __syncthreads();
    for (int i = tid; i < 576; i += NTHR) {
      int r = i >> 6, c = i & 63;
      float v = red[(0 * 9 + r) * 64 + c] + red[(1 * 9 + r) * 64 + c] + red[(2 * 9 + r) * 64 + c] + red[(3 * 9 + r) * 64 + c] +
                p.in[5][l * 6144 + n0 + c];
      MOD[(size_t)(l * 9 + r) * 6144 + n0 + c] = v;
    }
    __syncthreads();
  }
  float* AXC = (float*)(p.ws + zz + O_AXC); float* AXS = (float*)(p.ws + zz + O_AXS);
  float* RC = (float*)(p.ws + zz + O_RC); float* RS = (float*)(p.ws + zz + O_RS);
  int gt = (blockIdx.x + zz) * NTHR + tid, gs = (gridDim.x + zz) * NTHR;
  for (int i = gt; i < 64 * 8 + 2048 * 16; i += gs) {
    if (i < 512) {
      int pos = i >> 3, f = i & 7;
      float fr = expf(-9.210340371976184f * (float)f / 8.f);
      float a = (float)pos * fr;
      float c, s; sincos_rev((double)a, c, s);
      AXC[i] = c; AXS[i] = s;
    } else {
      int j = i - 512; int pos = j >> 4, f = j & 15;
      float fr = expf(-9.210340371976184f * (float)f / 16.f);
      float a = (float)pos * fr;
      float c, s; sincos_rev((double)a, c, s);
      RC[j] = c; RS[j] = s;
    }
  }
}

__device__ __forceinline__ void transpose_cvt(const float* src, int K, int N, u16* dst, const float* gk, char* smem, int glo = 0, int ghi = 1 << 30) {
  OPAQUE_Z;
  float* tile = (float*)smem;
  const int tid = (threadIdx.x + zz);
  int nt_n = (N + 63) / 64, nt_k = K / 64;
  for (int t = (blockIdx.x + zz); t < nt_n * nt_k; t += (gridDim.x + zz)) {
    int k0 = (t / nt_n) * 64, n0 = (t % nt_n) * 64;
    float v[16];
#pragma unroll
    for (int it = 0; it < 16; it++) {
      int i = tid + it * NTHR; int kk = i >> 6, nn = i & 63;
      v[it] = (n0 + nn < N) ? src[(size_t)(k0 + kk) * N + n0 + nn] : 0.f;
    }
    __syncthreads();
#pragma unroll
    for (int it = 0; it < 16; it++) {
      int i = tid + it * NTHR; int kk = i >> 6, nn = i & 63;
      float x = v[it];
      if (gk && (k0 + kk) >= glo && (k0 + kk) < ghi) x *= gk[k0 + kk - glo];
      tile[kk * 65 + nn] = x;
    }
    __syncthreads();
#pragma unroll
    for (int it = 0; it < 8; it++) {
      int i = tid + it * NTHR; int nn = i >> 5, kp = (i & 31) * 2;
      if (n0 + nn < N) *(u32*)(dst + (size_t)(n0 + nn) * K + k0 + kp) = pack2(tile[kp * 65 + nn], tile[(kp + 1) * 65 + nn]);
    }
  }
}

__device__ __forceinline__ void cvt_flat(const float* __restrict__ src, u16* __restrict__ dst, size_t n) {
  OPAQUE_Z;
  size_t gt = (size_t)(blockIdx.x + zz) * NTHR + (threadIdx.x + zz), gs = (size_t)(gridDim.x + zz) * NTHR;
  size_t n8 = n >> 3;
#pragma unroll 4
  for (size_t i = gt; i < n8; i += gs) {
    float4 a = ((const float4*)src)[2 * i], b = ((const float4*)src)[2 * i + 1];
    uint4 o; o.x = pack2(a.x, a.y); o.y = pack2(a.z, a.w); o.z = pack2(b.x, b.y); o.w = pack2(b.z, b.w);
    ((uint4*)dst)[i] = o;
  }
}

__device__ __forceinline__ void cvt_fp8_rows(const float* src, unsigned char* dst, float* sc, int nrows) {
  OPAQUE_Z;
  const int lane = (threadIdx.x + zz) & 63;
  int gw = ((blockIdx.x + zz) * NTHR + (threadIdx.x + zz)) >> 6, nw = ((gridDim.x + zz) * NTHR) >> 6;
  for (int row0 = gw; row0 < nrows; row0 += 4 * nw) {
    f32x4 v[4][4];
#pragma unroll
    for (int u = 0; u < 4; u++) {
      int row = row0 + u * nw;
      if (row < nrows) {
        const f32x4* s4 = (const f32x4*)(src + (size_t)row * 1024 + lane * 16);
#pragma unroll
        for (int i = 0; i < 4; i++) v[u][i] = s4[i];
      } else {
#pragma unroll
        for (int i = 0; i < 4; i++) v[u][i] = (f32x4){0.f, 0.f, 0.f, 0.f};
      }
    }
#pragma unroll
    for (int u = 0; u < 4; u++) {
      int row = row0 + u * nw;
      float am = 0.f;
#pragma unroll
      for (int i = 0; i < 4; i++)
#pragma unroll
        for (int e = 0; e < 4; e++) am = fmaxf(am, fabsf(v[u][i][e]));
      am = fmaxf(am, __shfl_xor(am, 1, 64)); am = fmaxf(am, __shfl_xor(am, 2, 64)); am = fmaxf(am, __shfl_xor(am, 4, 64));
      am = fmaxf(am, __shfl_xor(am, 8, 64)); am = fmaxf(am, __shfl_xor(am, 16, 64)); am = fmaxf(am, __shfl_xor(am, 32, 64));
      float q = am > 0.f ? 240.f / am : 1.f;
      float qi = am > 0.f ? am * (1.f / 240.f) : 1.f;
      u32x4 o;
#pragma unroll
      for (int i = 0; i < 4; i++) {
        int w = 0;
        w = __builtin_amdgcn_cvt_pk_fp8_f32(v[u][i][0] * q, v[u][i][1] * q, w, false);
        w = __builtin_amdgcn_cvt_pk_fp8_f32(v[u][i][2] * q, v[u][i][3] * q, w, true);
        o[i] = (u32)w;
      }
      if (row < nrows) {
        *(u32x4*)(dst + (size_t)row * 1024 + lane * 16) = o;
        if (lane == 0) sc[row] = qi;
      }
    }
  }
}

__device__ __forceinline__ void ph_convert(const P& p, char* smem) {
  OPAQUE_Z;
  for (int l = 0; l < 4; l++) {
    transpose_cvt(p.in[6] + (size_t)l * 1024 * 3016, 1024, 3016, (u16*)(p.ws + zz + O_WINT) + (size_t)l * 3072 * 1024, nullptr, smem);
    transpose_cvt(p.in[8] + (size_t)l * 256 * 384, 256, 384, (u16*)(p.ws + zz + O_WUQT) + (size_t)l * 384 * 256, p.in[7] + l * 256, smem);
    transpose_cvt(p.in[10] + (size_t)l * 128 * 256, 128, 256, (u16*)(p.ws + zz + O_WUKVT) + (size_t)l * 512 * 128, p.in[9] + l * 128, smem);
    transpose_cvt(p.in[11] + (size_t)l * 128 * 256, 128, 256, (u16*)(p.ws + zz + O_WUKVT) + (size_t)l * 512 * 128 + 256 * 128, p.in[9] + l * 128, smem);
    transpose_cvt(p.in[25] + (size_t)l * 1024 * 1024, 1024, 1024, (u16*)(p.ws + zz + O_WOUTT) + (size_t)l * 1024 * 1024, p.in[24] + l * 256, smem, 512, 768);
  }
  {
    int gt = (blockIdx.x + zz) * NTHR + (threadIdx.x + zz), gs = (gridDim.x + zz) * NTHR;
    for (int i = gt; i < 4 * 56 * 1024; i += gs) {
      int l = i / (56 * 1024), r = i % (56 * 1024);
      ((u16*)(p.ws + zz + O_WINT))[(size_t)l * 3072 * 1024 + (size_t)3016 * 1024 + r] = 0;
    }
  }
  cvt_flat(p.in[28], (u16*)(p.ws + zz + O_WQBF), 4ull * 1024 * 2048);
  cvt_flat(p.in[29], (u16*)(p.ws + zz + O_KEYBF), 4ull * 2 * 128 * 128);
  cvt_fp8_rows(p.in[30], (unsigned char*)(p.ws + zz + O_UBF), (float*)(p.ws + zz + O_USC), 4 * 16384);
  cvt_fp8_rows(p.in[31], (unsigned char*)(p.ws + zz + O_VBF), (float*)(p.ws + zz + O_VSC), 4 * 16384);
}

template <int HOOK>
__device__ __forceinline__ void gemm_tile(const u16* __restrict__ A, int lda, const u16* __restrict__ B, int ldb, int K, char* smem, const float* ssq = nullptr) {
  OPAQUE_Z;
  u16* sA = (u16*)smem;
  u16* sB = sA + 128 * 72;
  const int tid = (threadIdx.x + zz), lane = tid & 63, wave = tid >> 6;
  const int wm = (wave >> 1) * 64, wn = (wave & 1) * 64;
  const int lr = lane & 15, lq = lane >> 4;
  f32x4 acc[4][4];
#pragma unroll
  for (int i = 0; i < 4; i++)
#pragma unroll
    for (int j = 0; j < 4; j++) acc[i][j] = (f32x4){0.f, 0.f, 0.f, 0.f};
  u32x4 ra[4], rb[4];
  float rs[4];
  if (HOOK) {
#pragma unroll
    for (int i = 0; i < 4; i++) {
      int row = (tid + i * NTHR) >> 3;
      float4 q = *(const float4*)(ssq + (size_t)row * 4);
      rs[i] = rsqrtf((q.x + q.y + q.z + q.w) * (1.f / 256.f) + 1e-6f);
    }
  }
#pragma unroll
  for (int i = 0; i < 4; i++) {
    int id = tid + i * NTHR; int row = id >> 3, ch = id & 7;
    ra[i] = *(const u32x4*)(A + (size_t)row * lda + ch * 8);
    rb[i] = *(const u32x4*)(B + (size_t)row * ldb + ch * 8);
  }
#pragma unroll 1
  for (int k0 = 0; k0 < K; k0 += 64) {
    __syncthreads();
    if (HOOK && k0 >= 512 && k0 < 768) {
#pragma unroll
      for (int i = 0; i < 4; i++) {
        float t8[8];
        unpack8(ra[i], t8);
#pragma unroll
        for (int e = 0; e < 8; e++) t8[e] *= rs[i];
        ra[i] = pack8(t8);
      }
    }
#pragma unroll
    for (int i = 0; i < 4; i++) {
      int id = tid + i * NTHR; int row = id >> 3, ch = id & 7;
      *(u32x4*)(sA + row * 72 + ch * 8) = ra[i];
      *(u32x4*)(sB + row * 72 + ch * 8) = rb[i];
    }
    __syncthreads();
    if (k0 + 64 < K) {
#pragma unroll
      for (int i = 0; i < 4; i++) {
        int id = tid + i * NTHR; int row = id >> 3, ch = id & 7;
        ra[i] = *(const u32x4*)(A + (size_t)row * lda + k0 + 64 + ch * 8);
        rb[i] = *(const u32x4*)(B + (size_t)row * ldb + k0 + 64 + ch * 8);
      }
    }
#pragma unroll
    for (int kk = 0; kk < 64; kk += 32) {
      bf16x8 af[4], bfr[4];
#pragma unroll
      for (int i = 0; i < 4; i++) af[i] = *(const bf16x8*)(sA + (wm + i * 16 + lr) * 72 + kk + lq * 8);
#pragma unroll
      for (int j = 0; j < 4; j++) bfr[j] = *(const bf16x8*)(sB + (wn + j * 16 + lr) * 72 + kk + lq * 8);
      __builtin_amdgcn_s_setprio(1);
#pragma unroll
      for (int i = 0; i < 4; i++)
#pragma unroll
        for (int j = 0; j < 4; j++) acc[i][j] = mfma16(af[i], bfr[j], acc[i][j]);
      __builtin_amdgcn_s_setprio(0);
    }
  }
  __syncthreads();
  float* sC = (float*)smem;
#pragma unroll
  for (int i = 0; i < 4; i++)
#pragma unroll
    for (int j = 0; j < 4; j++)
#pragma unroll
      for (int r = 0; r < 4; r++) sC[(wm + i * 16 + lq * 4 + r) * 128 + wn + j * 16 + lr] = acc[i][j][r];
  __syncthreads();
}

enum { EPI_BF16 = 0, EPI_F32 = 1, EPI_Q = 2, EPI_KV = 3, EPI_OUT = 4 };

template <int EPI>
__device__ __forceinline__ void gemm_phase(const P& p, int l, const u16* A, int lda, const u16* Bt, int ldb, int K, int mtiles, int ntiles,
                           void* outp, int ldo, char* smem, int rot = 0) {
  OPAQUE_Z;
  const int tid = (threadIdx.x + zz);
  float* sC = (float*)smem;
  int bid0 = (int)(blockIdx.x + zz) + rot; if (bid0 >= (int)gridDim.x) bid0 -= (int)gridDim.x;
  for (int t = bid0; t < mtiles * ntiles; t += (gridDim.x + zz)) {
    int mt = t / ntiles, nt = t % ntiles;
    int m0 = mt * 128, n0 = nt * 128;
    gemm_tile<(EPI == EPI_OUT) ? 1 : 0>(A + (size_t)m0 * lda, lda, Bt + (size_t)n0 * ldb, ldb, K, smem, (const float*)(p.ws + zz + O_SSQ) + (size_t)m0 * 4);
    if (EPI == EPI_BF16) {
      u16* out = (u16*)outp;
      for (int i = tid; i < 128 * 32; i += NTHR) {
        int r = i >> 5, c4 = (i & 31) * 4;
        float4 v = *(const float4*)(sC + r * 128 + c4);
        uint2 o; o.x = pack2(v.x, v.y); o.y = pack2(v.z, v.w);
        *(uint2*)(out + (size_t)(m0 + r) * ldo + n0 + c4) = o;
      }
    } else if (EPI == EPI_F32) {
      float* out = (float*)outp;
      for (int i = tid; i < 128 * 32; i += NTHR) {
        int r = i >> 5, c4 = (i & 31) * 4;
        *(float4*)(out + (size_t)(m0 + r) * ldo + n0 + c4) = *(const float4*)(sC + r * 128 + c4);
      }
    } else if (EPI == EPI_OUT) {
      float* xc = (float*)(p.ws + zz + O_XCUR);
      const float* MOD = (const float*)(p.ws + zz + O_MOD);
#pragma unroll 1
      for (int i0 = tid; i0 < 128 * 32; i0 += 4 * NTHR) {
        float4 xv4[4], gg4[4];
#pragma unroll
        for (int u = 0; u < 4; u++) {
          int i = i0 + u * NTHR; int r = i >> 5, c4 = (i & 31) * 4; int row = m0 + r;
          gg4[u] = *(const float4*)(MOD + (size_t)(l * 9 + modrow_of(row)) * 6144 + 2 * 1024 + n0 + c4);
          xv4[u] = *(const float4*)(xc + (size_t)row * 1024 + n0 + c4);
        }
#pragma unroll
        for (int u = 0; u < 4; u++) {
          int i = i0 + u * NTHR; int r = i >> 5, c4 = (i & 31) * 4; int row = m0 + r;
          float4 v = *(const float4*)(sC + r * 128 + c4);
          float4 xv = xv4[u], gg = gg4[u];
          xv.x = ALPHA * xv.x + gg.x * v.x; xv.y = ALPHA * xv.y + gg.y * v.y;
          xv.z = ALPHA * xv.z + gg.z * v.z; xv.w = ALPHA * xv.w + gg.w * v.w;
          *(float4*)(xc + (size_t)row * 1024 + n0 + c4) = xv;
        }
      }
    } else if (EPI == EPI_Q || EPI == EPI_KV) {
      const u16* Pm = (const u16*)(p.ws + zz + O_P);
      for (int i = tid; i < 128 * 32; i += NTHR) {
        int r = i >> 5, sub = i & 31, c4 = sub * 4;
        int row = m0 + r;
        float ss = 0.f;
        if (EPI == EPI_Q) {
          uint4 w = *(const uint4*)(Pm + (size_t)row * LDP + sub * 8);
          float a;
          a = lo2f(w.x); ss += a * a; a = hi2f(w.x); ss += a * a; a = lo2f(w.y); ss += a * a; a = hi2f(w.y); ss += a * a;
          a = lo2f(w.z); ss += a * a; a = hi2f(w.z); ss += a * a; a = lo2f(w.w); ss += a * a; a = hi2f(w.w); ss += a * a;
        } else {
          uint2 w = *(const uint2*)(Pm + (size_t)row * LDP + 256 + sub * 4);
          float a;
          a = lo2f(w.x); ss += a * a; a = hi2f(w.x); ss += a * a; a = lo2f(w.y); ss += a * a; a = hi2f(w.y); ss += a * a;
        }
        ss += __shfl_xor(ss, 1, 64); ss += __shfl_xor(ss, 2, 64); ss += __shfl_xor(ss, 4, 64);
        ss += __shfl_xor(ss, 8, 64); ss += __shfl_xor(ss, 16, 64);
        float rinv = (EPI == EPI_Q) ? rsqrtf(ss * (1.f / 256.f) + 1e-6f) * (0.10206207261596577f * 1.4426950408889634f)
                                    : rsqrtf(ss * (1.f / 128.f) + 1e-6f);
        float4 v = *(float4*)(sC + r * 128 + c4);
        v.x *= rinv; v.y *= rinv; v.z *= rinv; v.w *= rinv;
        *(float4*)(sC + r * 128 + c4) = v;
      }
      __syncthreads();
      if (EPI == EPI_Q) {
        u16* out = (u16*)(p.ws + zz + O_QB);
        const float* AXC = (const float*)(p.ws + zz + O_AXC); const float* AXS = (const float*)(p.ws + zz + O_AXS);
        for (int i = tid; i < 128 * 128; i += NTHR) {
          int r = i >> 7, c = i & 127;
          int row = m0 + r, col = n0 + c;
          float v = sC[r * 128 + c];
          int hc = col % 96;
          if (row < T_LAT && hc >= 64) {
            int d = hc - 64; int sub = d >> 4, dd = d & 15, f = dd & 7; bool first = dd < 8;
            int t = row & 2047;
            int pos = sub == 0 ? (t >> 6) : (t & 63);
            float cs = AXC[pos * 8 + f], sn = AXS[pos * 8 + f];
            float other = sC[r * 128 + (first ? c + 8 : c - 8)];
            v = first ? (v * cs - other * sn) : (other * sn + v * cs);
          }
          out[(size_t)row * 384 + col] = f2bf(v);
        }
      } else {
        if (nt < 2) {
          u16* out = (u16*)(p.ws + zz + O_KN);
          for (int i = tid; i < 128 * 32; i += NTHR) {
            int r = i >> 5, c4 = (i & 31) * 4;
            float4 v = *(const float4*)(sC + r * 128 + c4);
            uint2 o; o.x = pack2(v.x, v.y); o.y = pack2(v.z, v.w);
            *(uint2*)(out + (size_t)(m0 + r) * 256 + n0 + c4) = o;
          }
        } else {
          u16* VT = (u16*)(p.ws + zz + O_VT);
          int b, pos0;
          if (m0 < T_LAT) { b = m0 >> 11; pos0 = 256 + (m0 & 2047); } else { b = (m0 - T_LAT) >> 8; pos0 = (m0 - T_LAT) & 255; }
          for (int i = tid; i < 128 * 16; i += NTHR) {
            int c = i >> 4, r8 = (i & 15) * 8;
            int vc = (nt - 2) * 128 + c; int h = vc >> 6, dv = vc & 63;
            uint4 o;
            o.x = pack2(sC[(r8 + 0) * 128 + c], sC[(r8 + 1) * 128 + c]);
            o.y = pack2(sC[(r8 + 2) * 128 + c], sC[(r8 + 3) * 128 + c]);
            o.z = pack2(sC[(r8 + 4) * 128 + c], sC[(r8 + 5) * 128 + c]);
            o.w = pack2(sC[(r8 + 6) * 128 + c], sC[(r8 + 7) * 128 + c]);
            *(uint4*)(VT + ((size_t)((b * 4 + h) * 64 + dv)) * 2304 + pos0 + r8) = o;
          }
        }
      }
    }
  }
}

__device__ __forceinline__ void ph_fold(const P& p, char* smem) {
  OPAQUE_Z;
  const int tid = (threadIdx.x + zz);
  float* sC = (float*)smem;
  for (int t = (blockIdx.x + zz); t < 4 * 16 * 8; t += (gridDim.x + zz)) {
    int l = t >> 7, hj = (t >> 3) & 15, kt = t & 7;
    int j = hj & 1;
    const u16* A = (const u16*)(p.ws + zz + O_KEYBF) + (size_t)(l * 2 + j) * 128 * 128;
    const u16* B = (const u16*)(p.ws + zz + O_WQBF) + (size_t)l * 1024 * 2048 + (size_t)(kt * 128) * 2048 + hj * 128;
    gemm_tile<0>(A, 128, B, 2048, 128, smem);
    u16* out = (u16*)(p.ws + zz + O_WPT) + (size_t)l * 2048 * 1024 + (size_t)(hj * 128) * 1024 + kt * 128;
    for (int i = tid; i < 128 * 32; i += NTHR) {
      int r = i >> 5, c4 = (i & 31) * 4;
      float4 v = *(const float4*)(sC + r * 128 + c4);
      uint2 o; o.x = pack2(v.x, v.y); o.y = pack2(v.z, v.w);
      *(uint2*)(out + (size_t)r * 1024 + c4) = o;
    }
  }
}

__device__ __forceinline__ void ph_xinit(const P& p) {
  OPAQUE_Z;
  float* xc = (float*)(p.ws + zz + O_XCUR);
  u16* xm = (u16*)(p.ws + zz + O_XMOD);
  const float* MOD = (const float*)(p.ws + zz + O_MOD);
  size_t gt = (size_t)(blockIdx.x + zz) * NTHR + (threadIdx.x + zz), gs = (size_t)(gridDim.x + zz) * NTHR;
  for (size_t i0 = gt; i0 < (size_t)T_ALL * 256; i0 += 4 * gs) {
    float4 vv[4];
#pragma unroll
    for (int u = 0; u < 4; u++) {
      size_t i = i0 + u * gs;
      vv[u] = make_float4(0.f, 0.f, 0.f, 0.f);
      if (i < (size_t)T_ALL * 256) {
        int row = (int)(i >> 8), c4 = (int)(i & 255) * 4;
        vv[u] = (row < T_LAT) ? *(const float4*)(p.in[0] + (size_t)row * 1024 + c4)
                              : *(const float4*)(p.in[2] + (size_t)(row - T_LAT) * 1024 + c4);
      }
    }
#pragma unroll
    for (int u = 0; u < 4; u++) {
      size_t i = i0 + u * gs;
      if (i < (size_t)T_ALL * 256) {
        int row = (int)(i >> 8), c4 = (int)(i & 255) * 4;
        float4 v = vv[u];
        *(float4*)(xc + (size_t)row * 1024 + c4) = v;
        const float* m = MOD + (size_t)(0 * 9 + modrow_of(row)) * 6144;
        float4 sh = *(const float4*)(m + c4), sc = *(const float4*)(m + 1024 + c4);
        uint2 o; o.x = pack2(v.x * (1.f + sc.x) + sh.x, v.y * (1.f + sc.y) + sh.y);
        o.y = pack2(v.z * (1.f + sc.z) + sh.z, v.w * (1.f + sc.w) + sh.w);
        *(uint2*)(xm + (size_t)row * 1024 + c4) = o;
      }
    }
  }
}

__device__ __forceinline__ void ph_prep(const P& p, int l, char* smem) {
  OPAQUE_Z;
  const u16* Pm = (const u16*)(p.ws + zz + O_P);
  const int tid = (threadIdx.x + zz);
  const int gt = (blockIdx.x + zz) * NTHR + tid, gs = (gridDim.x + zz) * NTHR;
  float* sW = (float*)smem;
  float* sBg = sW + 2 * 16 * 128;
  __syncthreads();
  for (int i = tid; i < 2 * 16 * 128; i += NTHR) sW[i] = ((i >> 11) == 0 ? p.in[12] : p.in[14])[l * 2048 + (i & 2047)];
  for (int i = tid; i < 256; i += NTHR) sBg[i] = ((i >> 7) == 0 ? p.in[13] : p.in[15])[l * 128 + (i & 127)];
  __syncthreads();
  {
    float* LG = (float*)(p.ws + zz + O_LGG);
    for (int i0 = gt; i0 < T_ALL * 32; i0 += 2 * gs) {
      u32x4 la[2], lb[2];
#pragma unroll
      for (int u = 0; u < 2; u++) {
        int i = i0 + u * gs;
        la[u] = (u32x4){0u, 0u, 0u, 0u}; lb[u] = la[u];
        if (i < T_ALL * 32) {
          int row = i >> 5, dir = (i >> 4) & 1;
          const u16* lrp = Pm + (size_t)row * LDP + 1184 + dir * 16;
          la[u] = *(const u32x4*)lrp; lb[u] = *(const u32x4*)(lrp + 8);
        }
      }
#pragma unroll
      for (int u = 0; u < 2; u++) {
        int i = i0 + u * gs;
        if (i < T_ALL * 32) {
          int row = i >> 5, dir = (i >> 4) & 1, cg = i & 15;
          float lr[16];
          unpack8(la[u], lr); unpack8(lb[u], lr + 8);
          float z[8];
#pragma unroll
          for (int c = 0; c < 8; c++) z[c] = sBg[dir * 128 + cg * 8 + c];
#pragma unroll
          for (int k = 0; k < 16; k++) {
            const float4 w0 = *(const float4*)(sW + dir * 2048 + k * 128 + cg * 8);
            const float4 w1 = *(const float4*)(sW + dir * 2048 + k * 128 + cg * 8 + 4);
            z[0] += lr[k] * w0.x; z[1] += lr[k] * w0.y; z[2] += lr[k] * w0.z; z[3] += lr[k] * w0.w;
            z[4] += lr[k] * w1.x; z[5] += lr[k] * w1.y; z[6] += lr[k] * w1.z; z[7] += lr[k] * w1.w;
          }
#pragma unroll
          for (int c = 0; c < 8; c++) z[c] = (fminf(z[c], 0.f) - log1pf(__expf(-fabsf(z[c])))) * (1.f / 16.f);
          float* o = LG + (size_t)dir * T_ALL * 128 + (size_t)row * 128 + cg * 8;
          *(float4*)o = make_float4(z[0], z[1], z[2], z[3]);
          *(float4*)(o + 4) = make_float4(z[4], z[5], z[6], z[7]);
        }
      }
    }
  }
  {
    u16* KR = (u16*)(p.ws + zz + O_KR);
    const float* AXC = (const float*)(p.ws + zz + O_AXC); const float* AXS = (const float*)(p.ws + zz + O_AXS);
    for (int row = gt; row < T_ALL; row += gs) {
      const u16* src = Pm + (size_t)row * LDP + 384;
      u32x4 w0 = *(const u32x4*)src, w1 = *(const u32x4*)(src + 8), w2 = *(const u32x4*)(src + 16), w3 = *(const u32x4*)(src + 24);
      if (row < T_LAT) {
        int t = row & 2047;
        float a[8], b[8], c[8], d[8];
        unpack8(w0, a); unpack8(w1, b); unpack8(w2, c); unpack8(w3, d);
        const float* cr = AXC + (t >> 6) * 8; const float* sr = AXS + (t >> 6) * 8;
        const float* cc = AXC + (t & 63) * 8; const float* sc = AXS + (t & 63) * 8;
#pragma unroll
        for (int f = 0; f < 8; f++) {
          float x1 = a[f], x2 = b[f]; a[f] = x1 * cr[f] - x2 * sr[f]; b[f] = x1 * sr[f] + x2 * cr[f];
          float y1 = c[f], y2 = d[f]; c[f] = y1 * cc[f] - y2 * sc[f]; d[f] = y1 * sc[f] + y2 * cc[f];
        }
        w0 = pack8(a); w1 = pack8(b); w2 = pack8(c); w3 = pack8(d);
      }
      u16* dst = KR + (size_t)row * 32;
      *(u32x4*)dst = w0; *(u32x4*)(dst + 8) = w1; *(u32x4*)(dst + 16) = w2; *(u32x4*)(dst + 24) = w3;
    }
  }
  {
    u16* XBC = (u16*)(p.ws + zz + O_XBC);
    const float* cw = p.in[17] + (size_t)l * 3 * 768; const float* cb = p.in[18] + l * 768;
    for (int i0 = gt; i0 < T_ALL * 96; i0 += 2 * gs) {
      u32x4 r0[2], rm[2], rp[2];
      const u32x4 zero = (u32x4){0u, 0u, 0u, 0u};
#pragma unroll
      for (int u = 0; u < 2; u++) {
        int i = i0 + u * gs;
        r0[u] = zero; rm[u] = zero; rp[u] = zero;
        if (i < T_ALL * 96) {
          int row = i / 96, cg = i - row * 96;
          int t = tpos_of(row); int L = row < T_LAT ? 2048 : 256;
          const u16* src = Pm + (size_t)row * LDP + 1472 + cg * 8;
          r0[u] = *(const u32x4*)src;
          if (t > 0) rm[u] = *(const u32x4*)(src - LDP);
          if (t < L - 1) rp[u] = *(const u32x4*)(src + LDP);
        }
      }
#pragma unroll
      for (int u = 0; u < 2; u++) {
        int i = i0 + u * gs;
        if (i < T_ALL * 96) {
          int row = i / 96, cg = i - row * 96;
          float x0[8], xm[8], xp[8];
          unpack8(r0[u], x0); unpack8(rm[u], xm); unpack8(rp[u], xp);
          float y[8];
#pragma unroll
          for (int c = 0; c < 8; c++) {
            float v = cw[cg * 8 + c] * xm[c] + cw[768 + cg * 8 + c] * x0[c] + cw[1536 + cg * 8 + c] * xp[c] + cb[cg * 8 + c];
            y[c] = silu_f(v);
          }
          *(u32x4*)(XBC + (size_t)row * 768 + cg * 8) = pack8(y);
        }
      }
    }
    float* DT = (float*)(p.ws + zz + O_DT); float* LA = (float*)(p.ws + zz + O_LA);
    for (int i = gt; i < 2 * T_ALL * 4; i += gs) {
      int dir = i / (T_ALL * 4); int rem = i - dir * (T_ALL * 4);
      int row = rem >> 2, h = rem & 3;
      float raw = bf2f(Pm[(size_t)row * LDP + 2240 + dir * 4 + h]);
      float bias = (dir == 0 ? p.in[19] : p.in[20])[l * 4 + h];
      float alog = (dir == 0 ? p.in[21] : p.in[22])[l * 4 + h];
      float dt = softplus_f(raw + bias);
      DT[i] = dt; LA[i] = -dt * expf(alog);
    }
  }
  {
    u16* QK = (u16*)(p.ws + zz + O_QKR);
    const float* RC = (const float*)(p.ws + zz + O_RC); const float* RS = (const float*)(p.ws + zz + O_RS);
    for (int i = gt; i < T_ALL * 8; i += gs) {
      int row = i >> 3, which = (i >> 2) & 1, h = i & 3;
      const u16* src = Pm + (size_t)row * LDP + 2248 + which * 128 + h * 32;
      float a[8], b[8], c[8], d[8];
      unpack8(*(const u32x4*)src, a); unpack8(*(const u32x4*)(src + 8), b);
      unpack8(*(const u32x4*)(src + 16), c); unpack8(*(const u32x4*)(src + 24), d);
      float sc = which == 1 ? 0.17677669529663687f : 1.f;
      if (row < T_LAT) {
        int t = row & 2047;
        const float* cs = RC + t * 16; const float* sn = RS + t * 16;
#pragma unroll
        for (int f = 0; f < 8; f++) {
          float x1 = a[f], x2 = c[f]; a[f] = x1 * cs[f] - x2 * sn[f]; c[f] = x1 * sn[f] + x2 * cs[f];
          float y1 = b[f], y2 = d[f]; b[f] = y1 * cs[8 + f] - y2 * sn[8 + f]; d[f] = y1 * sn[8 + f] + y2 * cs[8 + f];
        }
      }
#pragma unroll
      for (int f = 0; f < 8; f++) { a[f] *= sc; b[f] *= sc; c[f] *= sc; d[f] *= sc; }
      u16* dst = QK + (size_t)row * 256 + which * 128 + h * 32;
      *(u32x4*)dst = pack8(a); *(u32x4*)(dst + 8) = pack8(b); *(u32x4*)(dst + 16) = pack8(c); *(u32x4*)(dst + 24) = pack8(d);
    }
  }
}

__device__ __forceinline__ void ph_attn(const P& p, int need_ctx, char* smem) {
  OPAQUE_Z;
  const u16* QB = (const u16*)(p.ws + zz + O_QB);
  const u16* KN = (const u16*)(p.ws + zz + O_KN);
  const u16* KR = (const u16*)(p.ws + zz + O_KR);
  const u16* VT = (const u16*)(p.ws + zz + O_VT);
  u16* MIX = (u16*)(p.ws + zz + O_MIX);
  u16* sK = (u16*)smem;
  u16* sV = sK + 64 * 104;
  const int tid = (threadIdx.x + zz), lane = tid & 63, wave = tid >> 6, lr = lane & 15, lq = lane >> 4;
  int ntask = 8 * 4 * 16 + (need_ctx ? 8 * 4 * 2 : 0);
  for (int task = (blockIdx.x + zz); task < ntask; task += (gridDim.x + zz)) {
    int b, h, qrow0, nkt;
    if (task < 512) { b = task >> 6; h = (task >> 4) & 3; int qt = task & 15; qrow0 = b * 2048 + qt * 128; nkt = 36; }
    else { int t2 = task - 512; b = t2 >> 3; h = (t2 >> 1) & 3; int qt = t2 & 1; qrow0 = T_LAT + b * 256 + qt * 128; nkt = 4; }
    bf16x8 qf[2][3];
#pragma unroll
    for (int qs = 0; qs < 2; qs++) {
      const u16* qp = QB + (size_t)(qrow0 + wave * 32 + qs * 16 + lr) * 384 + h * 96 + lq * 8;
#pragma unroll
      for (int ks = 0; ks < 3; ks++) qf[qs][ks] = *(const bf16x8*)(qp + ks * 32);
    }
    f32x4 o[2][4];
    float m[2], lsum[2];
#pragma unroll
    for (int qs = 0; qs < 2; qs++) {
      m[qs] = -1e30f; lsum[qs] = 0.f;
#pragma unroll
      for (int i = 0; i < 4; i++) o[qs][i] = (f32x4){0.f, 0.f, 0.f, 0.f};
    }
    u32x4 rk[3], rv[2];
#define ATT_LOAD(kt_)                                                                                   \
  {                                                                                                     \
    int pos0_ = (kt_) * 64;                                                                             \
    int krow0_ = (pos0_ < 256) ? (T_LAT + b * 256 + pos0_) : (b * 2048 + pos0_ - 256);                  \
    _Pragma("unroll") for (int i_ = 0; i_ < 3; i_++) {                                                  \
      int id_ = tid + i_ * NTHR; int j_ = id_ / 12, ch_ = id_ - j_ * 12;                                \
      rk[i_] = (ch_ < 8) ? *(const u32x4*)(KN + (size_t)(krow0_ + j_) * 256 + h * 64 + ch_ * 8)         \
                         : *(const u32x4*)(KR + (size_t)(krow0_ + j_) * 32 + (ch_ - 8) * 8);            \
    }                                                                                                   \
    _Pragma("unroll") for (int i_ = 0; i_ < 2; i_++) {                                                  \
      int id_ = tid + i_ * NTHR; int dv_ = id_ >> 3, ch_ = id_ & 7;                                     \
      rv[i_] = *(const u32x4*)(VT + ((size_t)((b * 4 + h) * 64 + dv_)) * 2304 + pos0_ + ch_ * 8);       \
    }                                                                                                   \
  }
    ATT_LOAD(0);
#pragma unroll 1
    for (int kt = 0; kt < nkt; kt++) {
      __syncthreads();
#pragma unroll
      for (int i = 0; i < 3; i++) { int id = tid + i * NTHR; int j = id / 12, ch = id - j * 12; *(u32x4*)(sK + j * 104 + ch * 8) = rk[i]; }
#pragma unroll
      for (int i = 0; i < 2; i++) { int id = tid + i * NTHR; int dv = id >> 3, ch = id & 7; *(u32x4*)(sV + dv * 72 + ch * 8) = rv[i]; }
      __syncthreads();
      if (kt + 1 < nkt) ATT_LOAD(kt + 1);
      f32x4 s[2][4];
      __builtin_amdgcn_s_setprio(1);
#pragma unroll
      for (int nt = 0; nt < 4; nt++) {
        s[0][nt] = (f32x4){0.f, 0.f, 0.f, 0.f}; s[1][nt] = (f32x4){0.f, 0.f, 0.f, 0.f};
#pragma unroll
        for (int ks = 0; ks < 3; ks++) {
          bf16x8 kf = *(const bf16x8*)(sK + (nt * 16 + lr) * 104 + ks * 32 + lq * 8);
          s[0][nt] = mfma16(kf, qf[0][ks], s[0][nt]);
          s[1][nt] = mfma16(kf, qf[1][ks], s[1][nt]);
        }
      }
      __builtin_amdgcn_s_setprio(0);
      bf16x8 pf[2][2];
#pragma unroll
      for (int qs = 0; qs < 2; qs++) {
        float mx = s[qs][0][0];
#pragma unroll
        for (int nt = 0; nt < 4; nt++)
#pragma unroll
          for (int r = 0; r < 4; r++) mx = fmaxf(mx, s[qs][nt][r]);
        mx = fmaxf(mx, __shfl_xor(mx, 16, 64)); mx = fmaxf(mx, __shfl_xor(mx, 32, 64));
        float mn = fmaxf(m[qs], mx);
        float alpha = __builtin_amdgcn_exp2f(m[qs] - mn);
        m[qs] = mn;
        float ps = 0.f;
#pragma unroll
        for (int nt = 0; nt < 4; nt++)
#pragma unroll
          for (int r = 0; r < 4; r++) { float e = __builtin_amdgcn_exp2f(s[qs][nt][r] - mn); s[qs][nt][r] = e; ps += e; }
        lsum[qs] = lsum[qs] * alpha + ps;
#pragma unroll
        for (int nt = 0; nt < 4; nt++)
#pragma unroll
          for (int r = 0; r < 4; r++) o[qs][nt][r] *= alpha;
#pragma unroll
        for (int m2 = 0; m2 < 2; m2++) {
          u32x4 w;
          w[0] = pack2(s[qs][2 * m2][0], s[qs][2 * m2][1]); w[1] = pack2(s[qs][2 * m2][2], s[qs][2 * m2][3]);
          w[2] = pack2(s[qs][2 * m2 + 1][0], s[qs][2 * m2 + 1][1]); w[3] = pack2(s[qs][2 * m2 + 1][2], s[qs][2 * m2 + 1][3]);
          pf[qs][m2] = __builtin_bit_cast(bf16x8, w);
        }
      }
      __builtin_amdgcn_s_setprio(1);
#pragma unroll
      for (int m2 = 0; m2 < 2; m2++) {
#pragma unroll
        for (int nt = 0; nt < 4; nt++) {
          const u16* vp = sV + (nt * 16 + lr) * 72 + 32 * m2 + 4 * lq;
          uint2 lo = *(const uint2*)vp, hi = *(const uint2*)(vp + 16);
          u32x4 w; w[0] = lo.x; w[1] = lo.y; w[2] = hi.x; w[3] = hi.y;
          bf16x8 vf = __builtin_bit_cast(bf16x8, w);
          o[0][nt] = mfma16(vf, pf[0][m2], o[0][nt]);
          o[1][nt] = mfma16(vf, pf[1][m2], o[1][nt]);
        }
      }
      __builtin_amdgcn_s_setprio(0);
    }
#pragma unroll
    for (int qs = 0; qs < 2; qs++) {
      float ls = lsum[qs];
      ls += __shfl_xor(ls, 16, 64); ls += __shfl_xor(ls, 32, 64);
      float inv = 1.f / ls;
      int row = qrow0 + wave * 32 + qs * 16 + lr;
#pragma unroll
      for (int nt = 0; nt < 4; nt++) {
        uint2 w; w.x = pack2(o[qs][nt][0] * inv, o[qs][nt][1] * inv); w.y = pack2(o[qs][nt][2] * inv, o[qs][nt][3] * inv);
        *(uint2*)(MIX + (size_t)row * 1024 + h * 64 + nt * 16 + lq * 4) = w;
      }
    }
  }
}

struct MixDesc {
  const u16 *q, *k, *v;
  int qld, kld, vld, qc, kc, vc;
  int dk, hshift, g;
  float qscale;
  const float* lg;
  const float* ks;
  size_t sloc_off, dec_off;
};

DEV MixDesc get_mix(const P& p, int m) {
  OPAQUE_Z;
  MixDesc d;
  const u16* Pm = (const u16*)(p.ws + zz + O_P);
  if (m == 0) {
    d.q = Pm; d.k = Pm; d.v = Pm; d.qld = d.kld = d.vld = LDP; d.qc = 416; d.kc = 544; d.vc = 672;
    d.dk = 32; d.hshift = 0; d.g = 32; d.qscale = 0.17677669529663687f;
    d.lg = (const float*)(p.ws + zz + O_LGG); d.ks = nullptr; d.sloc_off = SLOC_G; d.dec_off = DEC_G;
  } else if (m == 1) {
    const u16* X = (const u16*)(p.ws + zz + O_XBC);
    d.q = X; d.k = X; d.v = X; d.qld = d.kld = d.vld = 768; d.qc = 512; d.kc = 256; d.vc = 0;
    d.dk = 128; d.hshift = 1; d.g = 1; d.qscale = 1.f;
    d.lg = (const float*)(p.ws + zz + O_LA); d.ks = (const float*)(p.ws + zz + O_DT); d.sloc_off = SLOC_S; d.dec_off = DEC_S;
  } else {
    const u16* X = (const u16*)(p.ws + zz + O_QKR);
    d.q = X; d.k = X; d.v = Pm; d.qld = d.kld = 256; d.vld = LDP; d.qc = 0; d.kc = 128; d.vc = 2504;
    d.dk = 32; d.hshift = 0; d.g = 1; d.qscale = 1.f;
    d.lg = nullptr; d.ks = nullptr; d.sloc_off = SLOC_R; d.dec_off = DEC_R;
  }
  return d;
}

struct StagePre { u32x4 v[2]; f32x4 c4[4]; float c1, k1; };
DEV void stage_pre(const MixDesc& d, int row0, int h, StagePre& r) {
  OPAQUE_Z;
  const int tid = (threadIdx.x + zz);
  const int g = d.g;
  const int vcol = d.vc + h * 64;
#pragma unroll
  for (int it = 0; it < 2; it++) {
    int i = tid + it * NTHR; int j = i >> 3, ch = i & 7;
    r.v[it] = *(const u32x4*)(d.v + (size_t)(row0 + j) * d.vld + vcol + ch * 8);
  }
#pragma unroll
  for (int it = 0; it < 4; it++) {
    r.c4[it] = (f32x4){0.f, 0.f, 0.f, 0.f};
    if (g > 1) {
      int i = tid + it * NTHR; int dir = i >> 9, j = (i >> 3) & 63, c4 = (i & 7) * 4;
      r.c4[it] = *(const f32x4*)(d.lg + (size_t)dir * T_ALL * 128 + (size_t)(row0 + j) * 128 + h * 32 + c4);
    }
  }
  r.c1 = 0.f; r.k1 = 1.f;
  if (tid < 128) {
    int dir = tid >> 6, j = tid & 63;
    if (g == 1) r.c1 = d.lg ? d.lg[(size_t)dir * T_ALL * 4 + (size_t)(row0 + j) * 4 + h] : log1pf(-exp2f(-5.f - (float)h));
    r.k1 = d.ks ? d.ks[(size_t)dir * T_ALL * 4 + (size_t)(row0 + j) * 4 + h] : 1.f;
  }
}
DEV void stage_post(const MixDesc& d, const StagePre& r, u16* sVT, float* sCum, float* sKs) {
  OPAQUE_Z;
  const int tid = (threadIdx.x + zz);
  const int g = d.g;
#pragma unroll
  for (int it = 0; it < 2; it++) {
    int i = tid + it * NTHR; int j = i >> 3, ch = i & 7;
    const u32x4 v = r.v[it];
    u16* dst = sVT + (ch * 8) * 72 + j;
    dst[0 * 72] = (u16)(v[0] & 0xffff); dst[1 * 72] = (u16)(v[0] >> 16);
    dst[2 * 72] = (u16)(v[1] & 0xffff); dst[3 * 72] = (u16)(v[1] >> 16);
    dst[4 * 72] = (u16)(v[2] & 0xffff); dst[5 * 72] = (u16)(v[2] >> 16);
    dst[6 * 72] = (u16)(v[3] & 0xffff); dst[7 * 72] = (u16)(v[3] >> 16);
  }
  if (g > 1) {
#pragma unroll
    for (int it = 0; it < 4; it++) {
      int i = tid + it * NTHR; int dir = i >> 9, j = (i >> 3) & 63, c4 = (i & 7) * 4;
      *(f32x4*)(sCum + dir * 2048 + j * 32 + c4) = r.c4[it];
    }
  } else if (tid < 128) {
    sCum[tid] = r.c1;
  }
  if (tid < 128) sKs[tid] = r.k1;
  __syncthreads();
  if (g > 1) {
    if (tid < 64) {
      int dir = tid >> 5, kk = tid & 31;
      float* c = sCum + dir * 2048 + kk;
      float run = 0.f;
      if (dir == 0) {
#pragma unroll 8
        for (int j = 0; j < 64; j++) { run += c[j * 32]; c[j * 32] = run; }
      } else {
#pragma unroll 8
        for (int j = 63; j >= 0; j--) { run += c[j * 32]; c[j * 32] = run; }
      }
    }
  } else if (tid < 128) {
    int dir = tid >> 6, lane = tid & 63;
    float v = sCum[tid];
#pragma unroll
    for (int off = 1; off < 64; off <<= 1) {
      float o = dir == 0 ? __shfl_up(v, off, 64) : __shfl_down(v, off, 64);
      bool ok = dir == 0 ? (lane >= off) : (lane + off < 64);
      v += ok ? o : 0.f;
    }
    sCum[tid] = v;
  }
  __syncthreads();
}


__device__ __forceinline__ void ph_scan1(const P& p, char* smem) {
  OPAQUE_Z;
  u16* sKraw = (u16*)smem;
  u16* sVT = (u16*)(smem + 16384);
  u16* sKT = (u16*)(smem + 25600);
  float* sCum = (float*)(smem + 44032);
  float* sKs = (float*)(smem + 60416);
  float* SLOC = (float*)(p.ws + zz + O_SLOC);
  float* DEC = (float*)(p.ws + zz + O_DEC);
  const int tid = (threadIdx.x + zz), lane = tid & 63, wave = tid >> 6, lr = lane & 15, lq = lane >> 4;
  for (int task = (blockIdx.x + zz); task < 3 * 8 * 36 * 4; task += (gridDim.x + zz)) {
    int m = task / 1152; int rem = task - m * 1152; int b = rem / 144; int rem2 = rem - b * 144; int gc = rem2 >> 2, h = rem2 & 3;
    MixDesc d = get_mix(p, m);
    const int dk = d.dk, g = d.g;
    int row0 = chunk_row0(b, gc);
    __syncthreads();
    int kcol = d.kc + (h >> d.hshift) * dk;
    int cpr = dk >> 3;
    {
      u32x4 kr[4];
#pragma unroll
      for (int it = 0; it < 4; it++) {
        int i = tid + it * NTHR;
        kr[it] = (u32x4){0u, 0u, 0u, 0u};
        if (i < 64 * cpr) { int j = i / cpr, ch = i - j * cpr; kr[it] = *(const u32x4*)(d.k + (size_t)(row0 + j) * d.kld + kcol + ch * 8); }
      }
      StagePre spre; stage_pre(d, row0, h, spre);
#pragma unroll
      for (int it = 0; it < 4; it++) {
        int i = tid + it * NTHR;
        if (i < 64 * cpr) { int j = i / cpr, ch = i - j * cpr; *(u32x4*)(sKraw + j * dk + ch * 8) = kr[it]; }
      }
      stage_post(d, spre, sVT, sCum, sKs);
    }
#pragma unroll 1
    for (int dir = 0; dir < 2; dir++) {
      const float* cum = sCum + dir * 64 * g;
      const int jl = dir == 0 ? 63 : 0;
      for (int i = tid; i < 64 * cpr; i += NTHR) {
        int j = i & 63, kg = i >> 6;
        float kv[8];
        unpack8(*(const u32x4*)(sKraw + j * dk + kg * 8), kv);
        float ksj = sKs[dir * 64 + j];
        if (g > 1) {
#pragma unroll
          for (int e = 0; e < 8; e++) kv[e] *= ksj * __expf(cum[jl * 32 + kg * 8 + e] - cum[j * 32 + kg * 8 + e]);
        } else {
          float f = ksj * __expf(cum[jl] - cum[j]);
#pragma unroll
          for (int e = 0; e < 8; e++) kv[e] *= f;
        }
#pragma unroll
        for (int e = 0; e < 8; e++) sKT[(kg * 8 + e) * 72 + j] = f2bf(kv[e]);
      }
      __syncthreads();
      size_t seq = (size_t)((b * 4 + h) * 2 + dir) * 36 + gc;
      float* outS = SLOC + d.sloc_off + seq * (size_t)(dk * 64);
      int ntile = (dk >> 4) * 4;
      for (int t = wave; t < ntile; t += 4) {
        int mt = t & 3, nt = t >> 2;
        f32x4 acc = (f32x4){0.f, 0.f, 0.f, 0.f};
#pragma unroll
        for (int ks = 0; ks < 2; ks++) {
          bf16x8 a = *(const bf16x8*)(sVT + (mt * 16 + lr) * 72 + ks * 32 + lq * 8);
          bf16x8 bb = *(const bf16x8*)(sKT + (nt * 16 + lr) * 72 + ks * 32 + lq * 8);
          acc = mfma16(a, bb, acc);
        }
#pragma unroll
        for (int r = 0; r < 4; r++) outS[(mt * 16 + lq * 4 + r) * dk + nt * 16 + lr] = acc[r];
      }
      if (tid < g) DEC[d.dec_off + seq * g + tid] = __expf(cum[jl * g + tid]);
      __syncthreads();
    }
  }
}

__device__ __forceinline__ void ph_scan2(const P& p) {
  OPAQUE_Z;
  const float* SLOC = (const float*)(p.ws + zz + O_SLOC);
  u16* SIN = (u16*)(p.ws + zz + O_SIN);
  const float* DEC = (const float*)(p.ws + zz + O_DEC);
  int gt = (blockIdx.x + zz) * NTHR + (threadIdx.x + zz), gs = (gridDim.x + zz) * NTHR;
  const int NG = 64 * 2048, NS = 64 * 8192;
  for (int i = gt; i < NG + NS + NG; i += gs) {
    int m, rem;
    if (i < NG) { m = 0; rem = i; } else if (i < NG + NS) { m = 1; rem = i - NG; } else { m = 2; rem = i - NG - NS; }
    int dk = m == 1 ? 128 : 32; int g = m == 0 ? 32 : 1;
    size_t so = m == 0 ? SLOC_G : (m == 1 ? SLOC_S : SLOC_R);
    size_t dof = m == 0 ? DEC_G : (m == 1 ? DEC_S : DEC_R);
    int esz = dk * 64;
    int seq = rem / esz, e = rem - seq * esz;
    int dir = seq & 1;
    int kk = e & (dk - 1);
    int gi = g > 1 ? kk : 0;
    float run = 0.f;
#pragma unroll 1
    for (int s0 = 0; s0 < 36; s0 += 18) {
      float loc[18], dd[18]; size_t aa[18];
#pragma unroll
      for (int u = 0; u < 18; u++) {
        int s = s0 + u;
        int gc = dir == 0 ? s : (s < 4 ? 3 - s : 39 - s);
        aa[u] = so + ((size_t)seq * 36 + gc) * esz + e;
        loc[u] = SLOC[aa[u]];
        dd[u] = DEC[dof + ((size_t)seq * 36 + gc) * g + gi];
      }
#pragma unroll
      for (int u = 0; u < 18; u++) { SIN[aa[u]] = f2bf(run); run = dd[u] * run + loc[u]; }
    }
  }
}

__device__ __forceinline__ void ph_scan3(const P& p, int l, int need_ctx, char* smem) {
  OPAQUE_Z;
  const u16* SIN = (const u16*)(p.ws + zz + O_SIN);
  const u16* Pm = (const u16*)(p.ws + zz + O_P);
  const u16* XBC = (const u16*)(p.ws + zz + O_XBC);
  u16* MIX = (u16*)(p.ws + zz + O_MIX);
  float* SSQ = (float*)(p.ws + zz + O_SSQ);
  const int tid = (threadIdx.x + zz), lane = tid & 63, wave = tid >> 6, lr = lane & 15, lq = lane >> 4;
  const int gcn = need_ctx ? 36 : 32, gcb = need_ctx ? 0 : 4;
  const int per_m = 8 * gcn * 4;
  for (int task = (blockIdx.x + zz); task < 3 * per_m; task += (gridDim.x + zz)) {
    int m = task / per_m; int rem = task - m * per_m; int b = rem / (gcn * 4); int rem2 = rem - b * gcn * 4;
    int gc = gcb + (rem2 >> 2), h = rem2 & 3;
    MixDesc d = get_mix(p, m);
    const int dk = d.dk, g = d.g, ldq = dk + 8;
    u16* sQ = (u16*)smem;
    u16* sK = sQ + 64 * ldq;
    u16* sSin = sK + 64 * ldq;
    u16* sVT = sSin + 64 * ldq;
    float* sCum = (float*)(sVT + 64 * 72);
    float* sKs = sCum + 2 * 64 * g;
    u16* sQr = (u16*)(sKs + 128);
    u16* sKr = sQr + 64 * 32;
    u16* sPm = (dk == 128) ? sSin : (sKr + 64 * 32);
    int row0 = chunk_row0(b, gc);
    __syncthreads();
    int qcol = d.qc + (h >> d.hshift) * dk, kcol = d.kc + (h >> d.hshift) * dk;
    int cpr = dk >> 3;
    {
      u32x4 qr[4], kr[4];
#pragma unroll
      for (int it = 0; it < 4; it++) {
        int i = tid + it * NTHR;
        qr[it] = (u32x4){0u, 0u, 0u, 0u}; kr[it] = qr[it];
        if (i < 64 * cpr) {
          int j = i / cpr, ch = i - j * cpr;
          qr[it] = *(const u32x4*)(d.q + (size_t)(row0 + j) * d.qld + qcol + ch * 8);
          kr[it] = *(const u32x4*)(d.k + (size_t)(row0 + j) * d.kld + kcol + ch * 8);
        }
      }
      StagePre spre; stage_pre(d, row0, h, spre);
#pragma unroll
      for (int it = 0; it < 4; it++) {
        int i = tid + it * NTHR;
        if (i < 64 * cpr) {
          int j = i / cpr, ch = i - j * cpr;
          if (g > 1) { *(u32x4*)(sQr + j * 32 + ch * 8) = qr[it]; *(u32x4*)(sKr + j * 32 + ch * 8) = kr[it]; }
          else { *(u32x4*)(sQ + j * ldq + ch * 8) = qr[it]; *(u32x4*)(sK + j * ldq + ch * 8) = kr[it]; }
        }
      }
      stage_post(d, spre, sVT, sCum, sKs);
    }
    f32x4 o[4];
#pragma unroll
    for (int i = 0; i < 4; i++) o[i] = (f32x4){0.f, 0.f, 0.f, 0.f};
#pragma unroll 1
    for (int dir = 0; dir < 2; dir++) {
      const float* cum = sCum + dir * 64 * g;
      {
        size_t seq = (size_t)((b * 4 + h) * 2 + dir) * 36 + gc;
        const u16* S = SIN + d.sloc_off + seq * (size_t)(dk * 64);
        u32x4 sr[4];
#pragma unroll
        for (int it = 0; it < 4; it++) {
          int i = tid + it * NTHR;
          sr[it] = (u32x4){0u, 0u, 0u, 0u};
          if (i < 64 * cpr) { int vv = i / cpr, ch = i - vv * cpr; sr[it] = *(const u32x4*)(S + vv * dk + ch * 8); }
        }
#pragma unroll
        for (int it = 0; it < 4; it++) {
          int i = tid + it * NTHR;
          if (i < 64 * cpr) { int vv = i / cpr, ch = i - vv * cpr; *(u32x4*)(sSin + vv * ldq + ch * 8) = sr[it]; }
        }
      }
      if (g > 1) {
        for (int i = tid; i < 64 * 4; i += NTHR) {
          int j = i >> 2, kg = i & 3;
          float qv[8], kv[8];
          unpack8(*(const u32x4*)(sQr + j * 32 + kg * 8), qv);
          unpack8(*(const u32x4*)(sKr + j * 32 + kg * 8), kv);
#pragma unroll
          for (int e = 0; e < 8; e++) {
            float c = cum[j * 32 + kg * 8 + e];
            qv[e] *= d.qscale * __expf(c); kv[e] *= __expf(-c);
          }
          *(u32x4*)(sQ + j * ldq + kg * 8) = pack8(qv);
          *(u32x4*)(sK + j * ldq + kg * 8) = pack8(kv);
        }
      }
      __syncthreads();
      f32x4 s[4], tmp[4];
#pragma unroll
      for (int nt = 0; nt < 4; nt++) { s[nt] = (f32x4){0.f, 0.f, 0.f, 0.f}; tmp[nt] = (f32x4){0.f, 0.f, 0.f, 0.f}; }
#pragma unroll 1
      for (int ks = 0; ks < dk; ks += 32) {
        bf16x8 a = *(const bf16x8*)(sQ + (wave * 16 + lr) * ldq + ks + lq * 8);
#pragma unroll
        for (int nt = 0; nt < 4; nt++) {
          bf16x8 bk = *(const bf16x8*)(sK + (nt * 16 + lr) * ldq + ks + lq * 8);
          s[nt] = mfma16(a, bk, s[nt]);
          bf16x8 bs = *(const bf16x8*)(sSin + (nt * 16 + lr) * ldq + ks + lq * 8);
          tmp[nt] = mfma16(a, bs, tmp[nt]);
        }
      }
      __syncthreads();
      float ci[4];
#pragma unroll
      for (int r = 0; r < 4; r++) ci[r] = (g > 1) ? 0.f : cum[wave * 16 + lq * 4 + r];
#pragma unroll
      for (int nt = 0; nt < 4; nt++) {
        int j = nt * 16 + lr;
        float cj = (g > 1) ? 0.f : cum[j];
        float ksj = sKs[dir * 64 + j];
#pragma unroll
        for (int r = 0; r < 4; r++) {
          int i = wave * 16 + lq * 4 + r;
          bool valid = dir == 0 ? (j <= i) : (j >= i);
          float val = 0.f;
          if (valid) val = (g > 1) ? s[nt][r] : s[nt][r] * ksj * __expf(ci[r] - cj);
          sPm[i * 72 + j] = f2bf(val);
        }
      }
      __syncthreads();
#pragma unroll
      for (int ks = 0; ks < 2; ks++) {
        bf16x8 a = *(const bf16x8*)(sPm + (wave * 16 + lr) * 72 + ks * 32 + lq * 8);
#pragma unroll
        for (int nt = 0; nt < 4; nt++) {
          bf16x8 bb = *(const bf16x8*)(sVT + (nt * 16 + lr) * 72 + ks * 32 + lq * 8);
          o[nt] = mfma16(a, bb, o[nt]);
        }
      }
#pragma unroll
      for (int r = 0; r < 4; r++) {
        float sc = (g > 1) ? 1.f : __expf(ci[r]);
#pragma unroll
        for (int nt = 0; nt < 4; nt++) o[nt][r] += sc * tmp[nt][r];
      }
      __syncthreads();
    }
    float ga[4][4], gb[4][4];
#pragma unroll
    for (int r = 0; r < 4; r++) {
      int row = row0 + wave * 16 + lq * 4 + r;
#pragma unroll
      for (int nt = 0; nt < 4; nt++) {
        int c = h * 64 + nt * 16 + lr;
        if (m == 0) { ga[r][nt] = bf2f(Pm[(size_t)row * LDP + 928 + c]); gb[r][nt] = p.in[16][l * 256 + c]; }
        else if (m == 2) { ga[r][nt] = bf2f(Pm[(size_t)row * LDP + 2760 + c]); gb[r][nt] = 0.f; }
        else { ga[r][nt] = bf2f(XBC[(size_t)row * 768 + c]); gb[r][nt] = bf2f(Pm[(size_t)row * LDP + 1216 + c]); }
      }
    }
#pragma unroll
    for (int r = 0; r < 4; r++) {
      int row = row0 + wave * 16 + lq * 4 + r;
      if (m == 0) {
        float ss = 0.f;
#pragma unroll
        for (int nt = 0; nt < 4; nt++) ss += o[nt][r] * o[nt][r];
        ss = xor16_sum(ss);
        float rinv = rsqrtf(ss * (1.f / 64.f) + 1e-6f);
#pragma unroll
        for (int nt = 0; nt < 4; nt++) {
          int c = h * 64 + nt * 16 + lr;
          MIX[(size_t)row * 1024 + 256 + c] = f2bf(o[nt][r] * rinv * gb[r][nt] * silu_f(ga[r][nt]));
        }
      } else if (m == 2) {
        float sm = 0.f;
#pragma unroll
        for (int nt = 0; nt < 4; nt++) sm += o[nt][r];
        sm = xor16_sum(sm);
        float mean = sm * (1.f / 64.f);
        float ss = 0.f;
#pragma unroll
        for (int nt = 0; nt < 4; nt++) { float dd = o[nt][r] - mean; ss += dd * dd; }
        ss = xor16_sum(ss);
        float rinv = rsqrtf(ss * (1.f / 64.f) + 1e-6f);
#pragma unroll
        for (int nt = 0; nt < 4; nt++) {
          int c = h * 64 + nt * 16 + lr;
          MIX[(size_t)row * 1024 + 768 + c] = f2bf((o[nt][r] - mean) * rinv * silu_f(ga[r][nt]));
        }
      } else {
        float dsk = p.in[23][l * 4 + h];
        float ss = 0.f;
#pragma unroll
        for (int nt = 0; nt < 4; nt++) {
          int c = h * 64 + nt * 16 + lr;
          float y = (o[nt][r] + dsk * ga[r][nt]) * silu_f(gb[r][nt]);
          u16 yb = f2bf(y);
          float yr = bf2f(yb);
          ss += yr * yr;
          MIX[(size_t)row * 1024 + 512 + c] = yb;
        }
        ss = xor16_sum(ss);
        if (lr == 0) SSQ[(size_t)row * 4 + h] = ss;
      }
    }
  }
}

__device__ __forceinline__ void ph_ln1(const P& p, int l, int nrows) {
  OPAQUE_Z;
  float* xc = (float*)(p.ws + zz + O_XCUR);
  u16* xm = (u16*)(p.ws + zz + O_XMOD);
  const float* MOD = (const float*)(p.ws + zz + O_MOD);
  const int lane = (threadIdx.x + zz) & 63;
  int gw = ((blockIdx.x + zz) * NTHR + (threadIdx.x + zz)) >> 6, nw = ((gridDim.x + zz) * NTHR) >> 6;
  const float* g1 = p.in[26] + l * 1024; const float* b1 = p.in[27] + l * 1024;
  f32x4 gg[4], bb[4];
#pragma unroll
  for (int q = 0; q < 4; q++) { gg[q] = *(const f32x4*)(g1 + q * 256 + lane * 4); bb[q] = *(const f32x4*)(b1 + q * 256 + lane * 4); }
  f32x4 cur[4];
#pragma unroll
  for (int q = 0; q < 4; q++) cur[q] = (gw < nrows) ? *(const f32x4*)(xc + (size_t)gw * 1024 + q * 256 + lane * 4) : (f32x4){0.f, 0.f, 0.f, 0.f};
  for (int row = gw; row < nrows; row += nw) {
    float* xr = xc + (size_t)row * 1024;
    const float* m = MOD + (size_t)(l * 9 + modrow_of(row)) * 6144;
    f32x4 nxt[4], sh[4], sc[4];
    const int rown = row + nw;
#pragma unroll
    for (int q = 0; q < 4; q++) {
      nxt[q] = (rown < nrows) ? *(const f32x4*)(xc + (size_t)rown * 1024 + q * 256 + lane * 4) : (f32x4){0.f, 0.f, 0.f, 0.f};
      sh[q] = *(const f32x4*)(m + 3 * 1024 + q * 256 + lane * 4);
      sc[q] = *(const f32x4*)(m + 4 * 1024 + q * 256 + lane * 4);
    }
    float s = 0.f;
#pragma unroll
    for (int q = 0; q < 4; q++) s += (cur[q][0] + cur[q][1]) + (cur[q][2] + cur[q][3]);
    float mean = wave_sum(s) * (1.f / 1024.f);
    float ss = 0.f;
#pragma unroll
    for (int q = 0; q < 4; q++)
#pragma unroll
      for (int e = 0; e < 4; e++) { float dd = cur[q][e] - mean; ss += dd * dd; }
    float rinv = rsqrtf(wave_sum(ss) * (1.f / 1024.f) + 1e-5f);
#pragma unroll
    for (int q = 0; q < 4; q++) {
      int c = q * 256 + lane * 4;
      f32x4 y;
#pragma unroll
      for (int e = 0; e < 4; e++) y[e] = (cur[q][e] - mean) * rinv * gg[q][e] + bb[q][e];
      *(f32x4*)(xr + c) = y;
      uint2 o; o.x = pack2(y[0] * (1.f + sc[q][0]) + sh[q][0], y[1] * (1.f + sc[q][1]) + sh[q][1]);
      o.y = pack2(y[2] * (1.f + sc[q][2]) + sh[q][2], y[3] * (1.f + sc[q][3]) + sh[q][3]);
      *(uint2*)(xm + (size_t)row * 1024 + c) = o;
    }
#pragma unroll
    for (int q = 0; q < 4; q++) cur[q] = nxt[q];
  }
}

#define TOPK_INSERT(v_, id_)                                   \
  {                                                            \
    float vv_ = (v_); int ii_ = (id_);                         \
    _Pragma("unroll") for (int q_ = 0; q_ < 16; q_++) {        \
      bool gt_ = vv_ > tv[q_];                                 \
      float ov_ = tv[q_]; int oi_ = ti[q_];                    \
      tv[q_] = gt_ ? vv_ : ov_; ti[q_] = gt_ ? ii_ : oi_;      \
      vv_ = gt_ ? ov_ : vv_; ii_ = gt_ ? oi_ : ii_;            \
    }                                                          \
  }

DEV u32 mono_key(float v, u32 mask, int tag) {
  u32 u = __float_as_uint(v);
  u32 k = (u & 0x80000000u) ? ~u : (u | 0x80000000u);
  return (k & ~mask) | (u32)tag;
}
DEV float key_value(u32 k, u32 mask) {
  k &= ~mask;
  u32 u = (k & 0x80000000u) ? (k & 0x7fffffffu) : ~k;
  return __uint_as_float(u);
}
#define MONO_KEY(v_, m_, t_) mono_key((v_), (m_), (t_))
#define KEY_VALUE(k_, m_) key_value((k_), (m_))
#define KEY_INSERT(k_)                                         \
  {                                                            \
    u32 kk_ = (k_);                                            \
    _Pragma("unroll") for (int q_ = 0; q_ < 16; q_++) {        \
      u32 hi_ = max(tk[q_], kk_);                              \
      kk_ = min(tk[q_], kk_);                                  \
      tk[q_] = hi_;                                            \
    }                                                          \
  }
typedef float f32x2 __attribute__((ext_vector_type(2)));
#define DOT8(acc_, w_, x0_, x1_, x2_, x3_)                                          \
  {                                                                                 \
    f32x2 lo_ = __builtin_amdgcn_cvt_pk_f32_fp8((int)(w_), false);                  \
    f32x2 hi_ = __builtin_amdgcn_cvt_pk_f32_fp8((int)(w_), true);                   \
    acc_ += x0_ * lo_[0]; acc_ += x1_ * lo_[1]; acc_ += x2_ * hi_[0]; acc_ += x3_ * hi_[1]; \
  }
#define AXPY8(a_, w_, f0_, f1_, f2_, f3_)                                           \
  {                                                                                 \
    f32x2 lo_ = __builtin_amdgcn_cvt_pk_f32_fp8((int)(w_), false);                  \
    f32x2 hi_ = __builtin_amdgcn_cvt_pk_f32_fp8((int)(w_), true);                   \
    f0_ += a_ * lo_[0]; f1_ += a_ * lo_[1]; f2_ += a_ * hi_[0]; f3_ += a_ * hi_[1]; \
  }
#define PEER_LOAD(U_, V_, G_, SU_, SV_, e0_)                                        \
  _Pragma("unroll") for (int q_ = 0; q_ < 4; q_++) {                                \
    int e_ = sE[tok * 128 + (e0_) + q_];                                            \
    G_[q_] = sG[tok * 128 + (e0_) + q_];                                            \
    SU_[q_] = sSU[tok * 128 + (e0_) + q_];                                          \
    SV_[q_] = sSV[tok * 128 + (e0_) + q_];                                          \
    U_[q_] = *(const u32x4*)(UB + (size_t)e_ * 1024 + lane * 16);                   \
    V_[q_] = *(const u32x4*)(VB + (size_t)e_ * 1024 + lane * 16);                   \
  }
#define PEER_COMPUTE(U_, V_, G_, SU_, SV_)                                          \
  _Pragma("unroll") for (int q_ = 0; q_ < 4; q_++) {                                \
    float d_ = 0.f;                                                                 \
    DOT8(d_, U_[q_][0], xv[0], xv[1], xv[2], xv[3]);                                \
    DOT8(d_, U_[q_][1], xv[4], xv[5], xv[6], xv[7]);                                \
    DOT8(d_, U_[q_][2], xv[8], xv[9], xv[10], xv[11]);                              \
    DOT8(d_, U_[q_][3], xv[12], xv[13], xv[14], xv[15]);                            \
    d_ = wave_sum(d_) * SU_[q_];                                                    \
    float act_ = 0.5f * d_ * (1.f + erff(d_ * 0.7071067811865476f)) * G_[q_] * SV_[q_]; \
    AXPY8(act_, V_[q_][0], f[0], f[1], f[2], f[3]);                                 \
    AXPY8(act_, V_[q_][1], f[4], f[5], f[6], f[7]);                                 \
    AXPY8(act_, V_[q_][2], f[8], f[9], f[10], f[11]);                               \
    AXPY8(act_, V_[q_][3], f[12], f[13], f[14], f[15]);                             \
  }

__device__ __forceinline__ void ph_peer(const P& p, int l, int nrows, char* smem, int dryc) {
  OPAQUE_Z;
  const int dry = zz + dryc;
  const u16* SC = (const u16*)(p.ws + zz + O_P);
  float* xc = (float*)(p.ws + zz + O_XCUR);
  u16* xm = (u16*)(p.ws + zz + O_XMOD);
  const float* MOD = (const float*)(p.ws + zz + O_MOD);
  const unsigned char* UB = (const unsigned char*)(p.ws + zz + O_UBF) + (size_t)l * 16384 * 1024;
  const unsigned char* VB = (const unsigned char*)(p.ws + zz + O_VBF) + (size_t)l * 16384 * 1024;
  const float* USC = (const float*)(p.ws + zz + O_USC) + l * 16384;
  const float* VSC = (const float*)(p.ws + zz + O_VSC) + l * 16384;
  float* sLV = (float*)smem;
  int* sLI = (int*)(smem + 16384);
  int* sE = (int*)(smem + 32768);
  float* sG = (float*)(smem + 40960);
  float* sSU = (float*)(smem + 49152);
  float* sSV = (float*)(smem + 57344);
  const int tid = (threadIdx.x + zz), lane = tid & 63, wave = tid >> 6;
  const float* g2 = p.in[32] + l * 1024; const float* b2 = p.in[33] + l * 1024;
  const int ntok = (nrows == T_ALL) ? 12 : 16;
  const int ngroups = nrows / ntok;
  for (int grp = (blockIdx.x + zz); grp < ngroups; grp += (gridDim.x + zz)) {
    int rowb = grp * ntok;
    __syncthreads();
    if (tid < ntok * 16) {
      int tok = tid >> 4, lst = tid & 15;
      const u32x4* s4 = (const u32x4*)(SC + (size_t)(rowb + tok) * 2048 + lst * 128);
      u32 tk[16];
#pragma unroll
      for (int q = 0; q < 16; q++) tk[q] = 0u;
      u32x4 cur[4], nxt[4];
#pragma unroll
      for (int q = 0; q < 4; q++) { cur[q] = s4[q]; nxt[q] = cur[q]; }
#pragma unroll 1
      for (int c0 = 0; c0 < 16; c0 += 4) {
        if (c0 + 4 < 16) {
#pragma unroll
          for (int q = 0; q < 4; q++) nxt[q] = s4[c0 + 4 + q];
        }
#pragma unroll
        for (int q = 0; q < 4; q++) {
          const int c = c0 + q;
          const u32x4 sv = cur[q];
#pragma unroll
          for (int e = 0; e < 4; e++) {
            KEY_INSERT(MONO_KEY(lo2f(sv[e]), 127u, 127 - (c * 8 + e * 2 + 0)));
            KEY_INSERT(MONO_KEY(hi2f(sv[e]), 127u, 127 - (c * 8 + e * 2 + 1)));
          }
        }
#pragma unroll
        for (int q = 0; q < 4; q++) cur[q] = nxt[q];
      }
#pragma unroll
      for (int q = 0; q < 16; q++) { sLV[tid * 16 + q] = KEY_VALUE(tk[q], 127u); sLI[tid * 16 + q] = 127 - (int)(tk[q] & 127u); }
    }
    __syncthreads();
    if (tid < ntok * 8) {
      int tok = tid >> 3, h = tid & 7;
      const float* v1 = sLV + (tok * 16 + h * 2) * 16; const float* v2 = v1 + 16;
      const int* i1 = sLI + (tok * 16 + h * 2) * 16; const int* i2 = i1 + 16;
      float a1[16], a2[16];
#pragma unroll
      for (int q = 0; q < 16; q++) { a1[q] = v1[q]; a2[q] = v2[q]; }
      u32 tk[16];
#pragma unroll
      for (int q = 0; q < 16; q++) tk[q] = 0u;
#pragma unroll
      for (int a = 0; a < 16; a++) {
#pragma unroll
        for (int bq = 0; bq < 16; bq++) {
          if ((a + 1) * (bq + 1) <= 16) { KEY_INSERT(MONO_KEY(a1[a] + a2[bq], 255u, 255 - (a * 16 + bq))); }
        }
      }
      float mx = KEY_VALUE(tk[0], 255u); float sum = 0.f; float ex[16];
#pragma unroll
      for (int q = 0; q < 16; q++) { ex[q] = __expf(KEY_VALUE(tk[q], 255u) - mx); sum += ex[q]; }
      float inv = 1.f / sum;
#pragma unroll
      for (int q = 0; q < 16; q++) {
        int ci = 255 - (int)(tk[q] & 255u);
        int e = i1[ci >> 4] * 128 + i2[ci & 15];
        sE[tok * 128 + h * 16 + q] = e;
        sG[tok * 128 + h * 16 + q] = ex[q] * inv;
        sSU[tok * 128 + h * 16 + q] = USC[e];
        sSV[tok * 128 + h * 16 + q] = VSC[e];
      }
    }
    __syncthreads();
    int* sE2 = (int*)smem;
    float* sGV2 = (float*)(smem + 8192);
    float* sSU2 = (float*)(smem + 16384);
    int* sCnt = (int*)(smem + 24576);
    {
#pragma unroll 1
      for (int i = tid; i < ntok * 128; i += NTHR) {
        int key = sE[i] >> 11;
#pragma unroll
        for (int sl = 0; sl < 8; sl++) {
          unsigned long long mk = __ballot(key == sl);
          if (lane == sl) sCnt[(i >> 6) * 8 + sl] = __popcll(mk);
        }
      }
      __syncthreads();
#pragma unroll 1
      for (int i = tid; i < ntok * 128; i += NTHR) {
        int tok = i >> 7, half = (i >> 6) & 1;
        int e = sE[i]; int key = e >> 11;
        int within = 0;
#pragma unroll
        for (int sl = 0; sl < 8; sl++) {
          unsigned long long mk = __ballot(key == sl);
          if (key == sl) within = __popcll(mk & ((1ull << lane) - 1ull));
        }
        const int* c0 = sCnt + tok * 16; const int* c1 = c0 + 8;
        int base = half ? c0[key] : 0;
#pragma unroll
        for (int sl = 0; sl < 8; sl++) base += (sl < key) ? (c0[sl] + c1[sl]) : 0;
        int dst = tok * 128 + base + within;
        sE2[dst] = e; sGV2[dst] = sG[i] * sSV[i]; sSU2[dst] = sSU[i];
      }
    }
    __syncthreads();
    {
      const int n = ntok >> 2;
      unsigned char* sX8 = (unsigned char*)(smem + 32768);
      const int lr = lane & 15, lq = lane >> 4;
      int vz; asm volatile("v_mov_b32 %0, 0" : "=v"(vz));
      float* sQinv = (float*)(smem + 24576 + 1024);
#pragma unroll 1
      for (int tk = 0; tk < n; tk++) {
        int row = rowb + wave * n + tk;
        float xv[16];
        u32x4 a = *(const u32x4*)(xm + (size_t)row * 1024 + lane * 16);
        u32x4 bq = *(const u32x4*)(xm + (size_t)row * 1024 + lane * 16 + 8);
        unpack8(a, xv); unpack8(bq, xv + 8);
        float am = 0.f;
#pragma unroll
        for (int i = 0; i < 16; i++) am = fmaxf(am, fabsf(xv[i]));
        am = fmaxf(am, __shfl_xor(am, 1, 64)); am = fmaxf(am, __shfl_xor(am, 2, 64)); am = fmaxf(am, __shfl_xor(am, 4, 64));
        am = fmaxf(am, __shfl_xor(am, 8, 64)); am = fmaxf(am, __shfl_xor(am, 16, 64)); am = fmaxf(am, __shfl_xor(am, 32, 64));
        float qs = am > 0.f ? 240.f / am : 1.f;
        if (lane == 0) sQinv[wave * 4 + tk] = am > 0.f ? am * (1.f / 240.f) : 1.f;
        u32x4 x8; int w;
#pragma unroll
        for (int i = 0; i < 4; i++) {
          w = 0;
          w = __builtin_amdgcn_cvt_pk_fp8_f32(xv[i * 4 + 0] * qs, xv[i * 4 + 1] * qs, w, false);
          w = __builtin_amdgcn_cvt_pk_fp8_f32(xv[i * 4 + 2] * qs, xv[i * 4 + 3] * qs, w, true);
          x8[i] = (u32)w;
        }
        *(u32x4*)(sX8 + (wave * 4 + tk) * 1024 + lane * 16) = x8;
      }
#define PEER_ACCV(V_, q0_)                                                            \
  _Pragma("unroll") for (int q_ = 0; q_ < 8; q_++) {                                  \
    float a_ = sGV2[nb + (q0_) + q_ + vz];                                            \
    f32x2 a2_ = (f32x2){a_, a_};                                                      \
    _Pragma("unroll") for (int i_ = 0; i_ < 4; i_++) {                                \
      f32x2 lo_ = __builtin_amdgcn_cvt_pk_f32_fp8((int)V_[q_][i_], false);            \
      f32x2 hi_ = __builtin_amdgcn_cvt_pk_f32_fp8((int)V_[q_][i_], true);             \
      f2[j][i_ * 2] += lo_ * a2_; f2[j][i_ * 2 + 1] += hi_ * a2_;                     \
    }                                                                                 \
  }
      {
        const int nit = 8 * n;
        u32x4 bA[16], bB[16];
#define PEER_ULOAD(B_, it_)                                                                   \
  {                                                                                           \
    const int c_ = (it_) / n, tk_ = (it_) - c_ * n;                                           \
    const int nb_ = (wave * n + tk_) * 128 + c_ * 16;                                         \
    const unsigned ub_ = (unsigned)sE2[nb_ + lr] * 1024u + (unsigned)(lq * 16);               \
    _Pragma("unroll") for (int kc_ = 0; kc_ < 16; kc_++) B_[kc_] = *(const u32x4*)(UB + (ub_ + (unsigned)(kc_ * 64))); \
  }
#define PEER_UCOMP(B_, it_)                                                                   \
  {                                                                                           \
    const int c_ = (it_) / n, tk_ = (it_) - c_ * n;                                           \
    const int nb_ = (wave * n + tk_) * 128 + c_ * 16;                                         \
    f32x4 acc_ = (f32x4){0.f, 0.f, 0.f, 0.f};                                                 \
    const unsigned char* xa_ = sX8 + (wave * 4 + tk_) * 1024 + lq * 16;                       \
    _Pragma("unroll") for (int kc_ = 0; kc_ < 16; kc_++) {                                    \
      u32x4 a_ = *(const u32x4*)(xa_ + kc_ * 64);                                             \
      long alo_ = (long)(((unsigned long)a_[1] << 32) | (unsigned long)a_[0]);                \
      long ahi_ = (long)(((unsigned long)a_[3] << 32) | (unsigned long)a_[2]);                \
      long blo_ = (long)(((unsigned long)B_[kc_][1] << 32) | (unsigned long)B_[kc_][0]);      \
      long bhi_ = (long)(((unsigned long)B_[kc_][3] << 32) | (unsigned long)B_[kc_][2]);      \
      acc_ = __builtin_amdgcn_mfma_f32_16x16x32_fp8_fp8(alo_, blo_, acc_, 0, 0, 0);           \
      acc_ = __builtin_amdgcn_mfma_f32_16x16x32_fp8_fp8(ahi_, bhi_, acc_, 0, 0, 0);           \
    }                                                                                         \
    float d_ = acc_[0] * sQinv[wave * 4 + tk_] * sSU2[nb_ + lr];                              \
    float act_ = 0.5f * d_ * (1.f + erff(d_ * 0.7071067811865476f)) * sGV2[nb_ + lr];         \
    if (lq == 0) sGV2[nb_ + lr] = act_;                                                       \
  }
        PEER_ULOAD(bA, 0);
#pragma unroll 1
        for (int it = 0; it < nit; it += 2) {
          PEER_ULOAD(bB, it + 1);
          PEER_UCOMP(bA, it);
          if (it + 2 < nit) { PEER_ULOAD(bA, it + 2); }
          PEER_UCOMP(bB, it + 1);
        }
      }
#pragma unroll 1
      for (int t0 = 0; t0 < n; t0 += 2) {
        f32x2 f2[2][8];
#pragma unroll
        for (int j = 0; j < 2; j++)
#pragma unroll
          for (int i = 0; i < 8; i++) f2[j][i] = (f32x2){0.f, 0.f};
        {
          u32x4 vA[8], vB[8];
#define PEER_VLOAD(V_, c_, j_, h_)                                                            \
  if (t0 + (j_) < n) {                                                                        \
    const int nb_ = (wave * n + t0 + (j_)) * 128 + (c_) * 16 + (h_) * 8;                      \
    _Pragma("unroll") for (int q_ = 0; q_ < 8; q_++) {                                        \
      unsigned e_ = (unsigned)sE2[nb_ + q_ + vz];                                             \
      V_[q_] = *(const u32x4*)(VB + (e_ * 1024u + (unsigned)(lane * 16)));                    \
    }                                                                                         \
  }
#define PEER_VCOMP(V_, c_, j_, h_)                                                            \
  if (t0 + (j_) < n) {                                                                        \
    const int nb_ = (wave * n + t0 + (j_)) * 128 + (c_) * 16 + (h_) * 8;                      \
    _Pragma("unroll") for (int q_ = 0; q_ < 8; q_++) {                                        \
      float a_ = sGV2[nb_ + q_ + vz];                                                         \
      f32x2 a2_ = (f32x2){a_, a_};                                                            \
      _Pragma("unroll") for (int i_ = 0; i_ < 4; i_++) {                                      \
        f32x2 lo_ = __builtin_amdgcn_cvt_pk_f32_fp8((int)V_[q_][i_], false);                  \
        f32x2 hi_ = __builtin_amdgcn_cvt_pk_f32_fp8((int)V_[q_][i_], true);                   \
        f2[j_][i_ * 2] += lo_ * a2_; f2[j_][i_ * 2 + 1] += hi_ * a2_;                         \
      }                                                                                       \
    }                                                                                         \
  }
          PEER_VLOAD(vA, 0, 0, 0);
#pragma unroll 1
          for (int c = 0; c < 8; c++) {
            PEER_VLOAD(vB, c, 0, 1);
            PEER_VCOMP(vA, c, 0, 0);
            PEER_VLOAD(vA, c, 1, 0);
            PEER_VCOMP(vB, c, 0, 1);
            PEER_VLOAD(vB, c, 1, 1);
            PEER_VCOMP(vA, c, 1, 0);
            if (c + 1 < 8) { PEER_VLOAD(vA, c + 1, 0, 0); }
            PEER_VCOMP(vB, c, 1, 1);
          }
        }
#pragma unroll
        for (int j = 0; j < 2; j++) {
          const int tk = t0 + j;
          if (tk < n) {
            int row = rowb + wave * n + tk;
            float f[16];
#pragma unroll
            for (int i = 0; i < 8; i++) { f[2 * i] = f2[j][i][0]; f[2 * i + 1] = f2[j][i][1]; }
          const float* m = MOD + (size_t)(l * 9 + modrow_of(row)) * 6144;
          float tt[16];
          float* xr = xc + (size_t)row * 1024;
#pragma unroll
          for (int q = 0; q < 4; q++) {
            int c = lane * 16 + q * 4;
            float4 x4 = *(const float4*)(xr + c); float4 g5 = *(const float4*)(m + 5 * 1024 + c);
            tt[q * 4 + 0] = ALPHA * x4.x + g5.x * f[q * 4 + 0];
            tt[q * 4 + 1] = ALPHA * x4.y + g5.y * f[q * 4 + 1];
            tt[q * 4 + 2] = ALPHA * x4.z + g5.z * f[q * 4 + 2];
            tt[q * 4 + 3] = ALPHA * x4.w + g5.w * f[q * 4 + 3];
          }
          float sm = 0.f;
#pragma unroll
          for (int i = 0; i < 16; i++) sm += tt[i];
          float mean = wave_sum(sm) * (1.f / 1024.f);
          float ss = 0.f;
#pragma unroll
          for (int i = 0; i < 16; i++) { float dd = tt[i] - mean; ss += dd * dd; }
          float rinv = rsqrtf(wave_sum(ss) * (1.f / 1024.f) + 1e-5f);
          const float* mn = MOD + (size_t)((l + 1 < 4 ? l + 1 : 3) * 9 + modrow_of(row)) * 6144;
          f32x4 gg4[4], bb4[4], sh4[4], sc4[4];
#pragma unroll
          for (int q = 0; q < 4; q++) {
            int c = lane * 16 + q * 4;
            gg4[q] = *(const f32x4*)(g2 + c); bb4[q] = *(const f32x4*)(b2 + c);
            sh4[q] = *(const f32x4*)(mn + c); sc4[q] = *(const f32x4*)(mn + 1024 + c);
          }
#pragma unroll
          for (int q = 0; q < 4; q++) {
            int c = lane * 16 + q * 4;
            float4 y;
            y.x = (tt[q * 4 + 0] - mean) * rinv * gg4[q][0] + bb4[q][0];
            y.y = (tt[q * 4 + 1] - mean) * rinv * gg4[q][1] + bb4[q][1];
            y.z = (tt[q * 4 + 2] - mean) * rinv * gg4[q][2] + bb4[q][2];
            y.w = (tt[q * 4 + 3] - mean) * rinv * gg4[q][3] + bb4[q][3];
            if (dry) {
            } else if (l == 3) {
              *(float4*)(p.out + (size_t)row * 1024 + c) = y;
            } else {
              *(float4*)(xr + c) = y;
              uint2 o; o.x = pack2(y.x * (1.f + sc4[q][0]) + sh4[q][0], y.y * (1.f + sc4[q][1]) + sh4[q][1]);
              o.y = pack2(y.z * (1.f + sc4[q][2]) + sh4[q][2], y.w * (1.f + sc4[q][3]) + sh4[q][3]);
              *(uint2*)(xm + (size_t)row * 1024 + c) = o;
            }
          }
          }
        }
      }
    }
  }
}

#define XB_TMO      128
#define XB_XCNT(j)  (256  + 64 * (j))
#define XB_XSUB(j)  (1280 + 64 * (j))
#define XB_XGEN(j)  (2304 + 64 * (j))
#define XB_TOP      3328
#define XB_TOPGEN   3392
#define XCD_BAR_WORDS 3456
#define XB_SPIN_CAP (1u << 20)
DEV unsigned xb_ld(unsigned* p) { return __hip_atomic_load(p, __ATOMIC_RELAXED, __HIP_MEMORY_SCOPE_AGENT); }
DEV unsigned xb_add(unsigned* p, unsigned v) { return __hip_atomic_fetch_add(p, v, __ATOMIC_RELAXED, __HIP_MEMORY_SCOPE_AGENT); }
DEV unsigned xb_xcc_id() { return (unsigned)__builtin_amdgcn_s_getreg((3 << 11) | 20) & 0xFu; }
#define XB_SPIN(cond, bar) do { unsigned _sp = 0; while (cond) { __builtin_amdgcn_s_sleep(1); \
    if ((++_sp & 255u) == 0u) { if (xb_ld(&(bar)[XB_TMO])) break; if (_sp > XB_SPIN_CAP) { atomicAdd(&(bar)[XB_TMO], 1u); break; } } } } while (0)
struct XcdBarrier { unsigned* bar; unsigned x; unsigned nloc, nx; };
DEV XcdBarrier xcd_barrier_post(unsigned* bar) {
  XcdBarrier b; b.bar = bar; b.x = xb_xcc_id(); b.nloc = 0u; b.nx = 0u;
  if (threadIdx.x == 0) (void)xb_add(&bar[XB_XCNT(b.x)], 1u);
  return b;
}
DEV void xcd_barrier_complete(unsigned* bar, unsigned x, unsigned& nloc, unsigned& nx) {
  const unsigned G = gridDim.x;
  unsigned sum, cnt, mine, sp = 0u;
  for (;;) {
    sum = 0u; cnt = 0u; mine = 0u;
#pragma unroll
    for (unsigned j = 0; j < 16; ++j) { const unsigned c = xb_ld(&bar[XB_XCNT(j)]); sum += c; cnt += (c > 0u) ? 1u : 0u; mine = (j == x) ? c : mine; }
    if (sum == G) break;
    __builtin_amdgcn_s_sleep(1);
    if ((++sp & 255u) == 0u) { if (xb_ld(&bar[XB_TMO])) break; if (sp > XB_SPIN_CAP) { atomicAdd(&bar[XB_TMO], 1u); break; } }
  }
  nloc = mine > 0u ? mine : 1u; nx = cnt > 0u ? cnt : 1u;
}
DEV void xcd_barrier(XcdBarrier& b) {
  asm volatile("s_waitcnt vmcnt(0)" ::: "memory");
  __syncthreads();
  if (threadIdx.x == 0) {
    unsigned* bar = b.bar;
    __builtin_amdgcn_s_waitcnt(0);
    unsigned nloc = b.nloc, nx = b.nx;
    if (nloc == 0u) { xcd_barrier_complete(bar, b.x, nloc, nx); b.nloc = nloc; b.nx = nx; }
    const unsigned old = xb_add(&bar[XB_XSUB(b.x)], 1u);
    const unsigned gen = old / nloc;
    if (old + 1u == (gen + 1u) * nloc) {
      __builtin_amdgcn_fence(__ATOMIC_RELEASE, "agent");
      asm volatile("s_waitcnt vmcnt(0)" ::: "memory");
      const unsigned og = xb_add(&bar[XB_TOP], 1u);
      const unsigned tg = og / nx;
      if (og + 1u == (tg + 1u) * nx) xb_add(&bar[XB_TOPGEN], 1u);
      else XB_SPIN(xb_ld(&bar[XB_TOPGEN]) == tg, bar);
      __builtin_amdgcn_fence(__ATOMIC_ACQUIRE, "agent");
      xb_add(&bar[XB_XGEN(b.x)], 1u);
      asm volatile("s_waitcnt vmcnt(0)" ::: "memory");
    } else {
      XB_SPIN(xb_ld(&bar[XB_XGEN(b.x)]) == gen, bar);
      __builtin_amdgcn_fence(__ATOMIC_ACQUIRE, "agent");
      asm volatile("s_waitcnt vmcnt(0)" ::: "memory");
    }
  }
  __syncthreads();
}

#define KARGP(z_) ((const P*)(const void*)((const __attribute__((address_space(4))) char*)__builtin_amdgcn_kernarg_segment_ptr() + (z_)))
__global__ void __launch_bounds__(NTHR, 2) mega(P p) {
  cg::grid_group grid = cg::this_grid();
  __shared__ __attribute__((aligned(16))) char smem[65536];
  if (blockIdx.x == 0) { unsigned* bw = (unsigned*)(p.ws + O_BAR); for (int i = threadIdx.x; i < 3456; i += NTHR) bw[i] = 0u; }
  {
    OPAQUE_Z; const P& q = *KARGP(zz);
    ph_mod(q, smem);
    ph_convert(q, smem);
  }
  grid.sync();
  XcdBarrier xb = xcd_barrier_post((unsigned*)(p.ws + O_BAR));
#pragma unroll 1
  for (int st = -1; st < 40; st++) {
    const int l = st < 0 ? 0 : st / 10;
    const int ph = st < 0 ? -1 : st - l * 10;
    const int need_ctx = l < 3;
    const int nrows = need_ctx ? T_ALL : T_LAT;
    switch (ph) {
      case -1: {
        OPAQUE_Z; const P& q = *KARGP(zz);
        ph_fold(q, smem);
        ph_xinit(q);
        break;
      }
      case 0: {
        OPAQUE_Z; const P& q = *KARGP(zz);
        gemm_phase<EPI_BF16>(q, l, (const u16*)(q.ws + O_XMOD), 1024, (const u16*)(q.ws + O_WINT) + (size_t)l * 3072 * 1024, 1024, 1024,
                             T_ALL / 128, 24, (void*)(q.ws + O_P), LDP, smem);
        break;
      }
      case 1: {
        OPAQUE_Z; const P& q = *KARGP(zz);
        gemm_phase<EPI_Q>(q, l, (const u16*)(q.ws + O_P), LDP, (const u16*)(q.ws + O_WUQT) + (size_t)l * 384 * 256, 256, 256,
                          T_ALL / 128, 3, nullptr, 0, smem);
        gemm_phase<EPI_KV>(q, l, (const u16*)(q.ws + O_P) + 256, LDP, (const u16*)(q.ws + O_WUKVT) + (size_t)l * 512 * 128, 128, 128,
                           T_ALL / 128, 4, nullptr, 0, smem, (int)gridDim.x - (int)((T_ALL / 128 * 3) % gridDim.x));
        ph_prep(q, l, smem);
        break;
      }
      case 2: {
        OPAQUE_Z; const P& q = *KARGP(zz);
        ph_scan1(q, smem);
        break;
      }
      case 3: {
        OPAQUE_Z; const P& q = *KARGP(zz);
        ph_scan2(q);
        ph_attn(q, need_ctx, smem);
        break;
      }
      case 4: {
        OPAQUE_Z; const P& q = *KARGP(zz);
        ph_scan3(q, l, need_ctx, smem);
        break;
      }
      case 5: {
        OPAQUE_Z; const P& q = *KARGP(zz);
        gemm_phase<EPI_OUT>(q, l, (const u16*)(q.ws + O_MIX), 1024, (const u16*)(q.ws + O_WOUTT) + (size_t)l * 1024 * 1024, 1024, 1024,
                            nrows / 128, 8, nullptr, 0, smem);
        break;
      }
      case 6: {
        OPAQUE_Z; const P& q = *KARGP(zz);
        ph_ln1(q, l, nrows);
        break;
      }
      case 7: {
        OPAQUE_Z; const P& q = *KARGP(zz);
        gemm_phase<EPI_BF16>(q, l, (const u16*)(q.ws + O_XMOD), 1024, (const u16*)(q.ws + O_WPT) + (size_t)l * 2048 * 1024, 1024, 1024,
                             nrows / 128, 16, (void*)(q.ws + O_P), 2048, smem);
        break;
      }
      case 8: {
        OPAQUE_Z; const P& q = *KARGP(zz);
        ph_peer(q, l, nrows, smem, 0);
        break;
      }
      default:
        break;
    }
    if (ph != 9) xcd_barrier(xb);
  }
}

extern "C" void kernel_launch(void* const* d_in, const int* in_sizes, int n_in, void* d_out, int out_size, void* d_ws,
                              size_t ws_size, hipStream_t stream) {
  static int grid_blocks = 0;
  if (!grid_blocks) {
    int dev = 0, cus = 0, per_cu = 0;
    (void)hipGetDevice(&dev);
    (void)hipDeviceGetAttribute(&cus, hipDeviceAttributeMultiprocessorCount, dev);
    (void)hipOccupancyMaxActiveBlocksPerMultiprocessor(&per_cu, mega, NTHR, 0);
    if (per_cu > 2) per_cu = 2;
    if (per_cu < 1) per_cu = 1;
    grid_blocks = cus * per_cu;
  }
  if (ws_size < WS_TOTAL) { fprintf(stderr, "workspace too small: %zu < %zu\n", ws_size, (size_t)WS_TOTAL); return; }
  P p{};
  for (int i = 0; i < 34; i++) p.in[i] = (const float*)d_in[i];
  p.out = (float*)d_out;
  p.ws = (char*)d_ws;
  void* args[] = {&p};
  hipError_t e = hipLaunchCooperativeKernel((void*)mega, dim3(grid_blocks), dim3(NTHR), args, 0, stream);
  if (e != hipSuccess) fprintf(stderr, "cooperative launch failed: %s (grid %d)\n", hipGetErrorString(e), grid_blocks);
}
```
